# Optimizing an MI355X kernel written in HIP

```python
import math
import jax, jax.numpy as jnp
from jax import lax
import numpy as np

D_MODEL = 2048
BATCH = 4
SEQ = 4096
DEPTH = 1

D_MIX = D_MODEL
GLA_WIDTH = D_MIX // 2
GLA_HEADS = 4
GLA_KEY_WIDTH = GLA_WIDTH // 2
GLA_HEAD_K = GLA_KEY_WIDTH // GLA_HEADS
GLA_HEAD_V = GLA_WIDTH // GLA_HEADS
GLA_GATE_RANK = 16
GLA_GATE_TAU = 16.0
GLA_CHUNK = 64
SSD_WIDTH = D_MIX - GLA_WIDTH
SSD_HEAD_DIM = 64
SSD_HEADS = SSD_WIDTH // SSD_HEAD_DIM
SSD_GROUPS = 4
SSD_HEADS_PER_GROUP = SSD_HEADS // SSD_GROUPS
SSD_STATE = 128
SSD_CONV = 4
SSD_CHUNK = 128
XBC_DIM = SSD_WIDTH + 2 * SSD_GROUPS * SSD_STATE
IN_SIZES = (GLA_KEY_WIDTH, GLA_KEY_WIDTH, GLA_WIDTH, GLA_WIDTH, GLA_GATE_RANK,
            SSD_WIDTH, XBC_DIM, SSD_HEADS)
IN_DIM = sum(IN_SIZES)
IN_SPLITS = tuple(int(v) for v in np.cumsum(IN_SIZES)[:-1])
MOE_GROUPS = 4
EXPERTS_PER_GROUP = 8
N_EXPERTS = MOE_GROUPS * EXPERTS_PER_GROUP
TOP_K = 2
D_EXPERT = D_MODEL // 4
EPS = 1e-6

kernel_name = "hymba_gla_ssd_hiermoe"


def rmsnorm(x, w):
    xf = x.astype(jnp.float32)
    y = xf * lax.rsqrt(jnp.mean(xf * xf, axis=-1, keepdims=True) + EPS)
    return (y * w.astype(jnp.float32)).astype(x.dtype)


def gla_chunked(q, k, v, log_a):
    b, s, h, dk = q.shape
    dv = v.shape[-1]
    n = s // GLA_CHUNK
    q = q * (dk ** -0.5)

    def to_chunks(t):
        return t.reshape(b, n, GLA_CHUNK, h, t.shape[-1]).transpose(1, 0, 3, 2, 4)

    qc, kc, vc = to_chunks(q), to_chunks(k), to_chunks(v)
    gc = to_chunks(log_a.astype(jnp.float32))
    causal = jnp.tril(jnp.ones((GLA_CHUNK, GLA_CHUNK), bool))[:, :, None]

    def step(state, inp):
        qi, ki, vi, gi = inp
        G = jnp.cumsum(gi, axis=2)
        diff = G[:, :, :, None, :] - G[:, :, None, :, :]
        decay = jnp.exp(jnp.where(causal, diff, -jnp.inf))
        scores = jnp.einsum('bhid,bhjd,bhijd->bhij', qi, ki, decay)
        o_intra = jnp.einsum('bhij,bhjv->bhiv', scores, vi)
        o_inter = jnp.einsum('bhid,bhdv->bhiv', qi * jnp.exp(G), state)
        G_last = G[:, :, -1:, :]
        k_dec = ki * jnp.exp(G_last - G)
        state = state * jnp.exp(G_last[:, :, 0, :])[..., None] + jnp.einsum('bhjd,bhjv->bhdv', k_dec, vi)
        return state, o_intra + o_inter

    state0 = jnp.zeros((b, h, dk, dv), jnp.float32)
    _, o = lax.scan(step, state0, (qc, kc, vc, gc))
    return o.transpose(1, 0, 3, 2, 4).reshape(b, s, h, dv)


def segsum(a):
    T = a.shape[-1]
    rep = jnp.broadcast_to(a[..., :, None], a.shape + (T,))
    strict = jnp.tril(jnp.ones((T, T), bool), -1)
    cs = jnp.cumsum(jnp.where(strict, rep, 0.0), axis=-2)
    return jnp.where(jnp.tril(jnp.ones((T, T), bool)), cs, -jnp.inf)


def ssd_chunked(x, dt, a, bm, cm):
    b, s, g, r, p = x.shape
    nst = bm.shape[-1]
    c = s // SSD_CHUNK
    l = SSD_CHUNK
    xs = (x * dt[..., None]).reshape(b, c, l, g, r, p)
    dA = (dt * a).astype(jnp.float32).reshape(b, c, l, g, r).transpose(0, 3, 4, 1, 2)
    bm = bm.reshape(b, c, l, g, nst)
    cm = cm.reshape(b, c, l, g, nst)
    A_cs = jnp.cumsum(dA, axis=-1)
    L = jnp.exp(segsum(dA))
    cb = jnp.einsum('bclgn,bcsgn->bgcls', cm, bm)
    y_diag = jnp.einsum('bgrcls,bcsgrp->bclgrp', cb[:, :, None] * L, xs)
    decay_states = jnp.exp(A_cs[..., -1:] - A_cs).transpose(0, 3, 4, 1, 2)
    states = jnp.einsum('bclgn,bclgrp->bcgrpn', bm, xs * decay_states[..., None])
    states = jnp.concatenate([jnp.zeros_like(states[:, :1]), states], axis=1)
    chunk_decay = jnp.exp(segsum(jnp.pad(A_cs[..., -1], ((0, 0), (0, 0), (0, 0), (1, 0)))))
    new_states = jnp.einsum('bgrzc,bcgrpn->bzgrpn', chunk_decay, states)[:, :-1]
    out_decay = jnp.exp(A_cs).transpose(0, 3, 4, 1, 2)
    y_off = jnp.einsum('bclgn,bcgrpn->bclgrp', cm, new_states) * out_decay[..., None]
    return (y_diag + y_off).reshape(b, s, g, r, p)


def causal_depthwise_conv(u, w, bias):
    out = lax.conv_general_dilated(
        u, w[:, None, :].astype(u.dtype), window_strides=(1,),
        padding=[(SSD_CONV - 1, 0)], dimension_numbers=('NWC', 'WIO', 'NWC'),
        feature_group_count=u.shape[-1])
    return out + bias.astype(u.dtype)


def mixer_block(h, w_in, w_gk_up, b_gk, w_gla_norm, w_conv, b_conv, dt_bias, a_log,
                d_skip, w_ssd_norm, w_out):
    b, s, _ = h.shape
    proj = h @ w_in
    q, k, v, g_out, gk_lr, z, xbc, dt_raw = jnp.split(proj, IN_SPLITS, axis=-1)
    log_a = jax.nn.log_sigmoid((gk_lr @ w_gk_up + b_gk).astype(jnp.float32)) / GLA_GATE_TAU
    o = gla_chunked(q.reshape(b, s, GLA_HEADS, GLA_HEAD_K),
                    k.reshape(b, s, GLA_HEADS, GLA_HEAD_K),
                    v.reshape(b, s, GLA_HEADS, GLA_HEAD_V),
                    log_a.reshape(b, s, GLA_HEADS, GLA_HEAD_K)).astype(h.dtype)
    o = rmsnorm(o, w_gla_norm) * jax.nn.silu(g_out).reshape(b, s, GLA_HEADS, GLA_HEAD_V)
    o = o.reshape(b, s, GLA_WIDTH)
    xbc = jax.nn.silu(causal_depthwise_conv(xbc, w_conv, b_conv))
    xs, bm, cm = jnp.split(xbc, (SSD_WIDTH, SSD_WIDTH + SSD_GROUPS * SSD_STATE), axis=-1)
    dt = jax.nn.softplus((dt_raw + dt_bias).astype(jnp.float32))
    a = -jnp.exp(a_log.astype(jnp.float32))
    shp = (b, s, SSD_GROUPS, SSD_HEADS_PER_GROUP)
    xh = xs.reshape(shp + (SSD_HEAD_DIM,))
    y = ssd_chunked(xh, dt.reshape(shp), a.reshape(SSD_GROUPS, SSD_HEADS_PER_GROUP),
                    bm.reshape(b, s, SSD_GROUPS, SSD_STATE), cm.reshape(b, s, SSD_GROUPS, SSD_STATE))
    y = y + d_skip.reshape(SSD_GROUPS, SSD_HEADS_PER_GROUP)[..., None] * xh
    y = y.astype(h.dtype).reshape(b, s, SSD_WIDTH) * jax.nn.silu(z)
    y = rmsnorm(y.reshape(b, s, SSD_GROUPS, SSD_WIDTH // SSD_GROUPS),
                w_ssd_norm.reshape(SSD_GROUPS, SSD_WIDTH // SSD_GROUPS)).reshape(b, s, SSD_WIDTH)
    return jnp.concatenate([o, y], axis=-1) @ w_out


def hier_moe(h, w_rg, b_rg, w_re, b_re, w_gate, w_up, w_down):
    shape = h.shape
    t = h.reshape(-1, shape[-1])
    T = t.shape[0]
    g_prob = jax.nn.softmax((t @ w_rg + b_rg).astype(jnp.float32), axis=-1)
    g_w, g_idx = lax.top_k(g_prob, 1)
    e_logits = (t @ w_re + b_re).astype(jnp.float32).reshape(T, MOE_GROUPS, EXPERTS_PER_GROUP)
    e_sel = e_logits[jnp.arange(T), g_idx[:, 0]]
    e_prob = jax.nn.softmax(e_sel, axis=-1)
    e_w, e_idx = lax.top_k(e_prob, TOP_K)
    weights = g_w * e_w / jnp.sum(e_w, axis=-1, keepdims=True)
    expert = g_idx * EXPERTS_PER_GROUP + e_idx
    flat_e = expert.reshape(-1)
    flat_w = weights.reshape(-1)
    flat_tok = jnp.repeat(jnp.arange(T), TOP_K)
    order = jnp.argsort(flat_e)
    sorted_tok = flat_tok[order]
    group_sizes = jnp.bincount(flat_e, length=N_EXPERTS).astype(jnp.int32)
    xs = t[sorted_tok]
    hg = lax.ragged_dot(xs, w_gate, group_sizes)
    hu = lax.ragged_dot(xs, w_up, group_sizes)
    y = lax.ragged_dot(jax.nn.silu(hg) * hu, w_down, group_sizes)
    y = y * flat_w[order][:, None].astype(y.dtype)
    out = jnp.zeros((T, shape[-1]), y.dtype).at[sorted_tok].add(y)
    return out.astype(h.dtype).reshape(shape)


def setup_inputs(seed: int = 0) -> dict:
    key = jax.random.key(seed)
    ks = jax.random.split(key, 24)
    f32 = jnp.float32
    D = D_MODEL

    def nrm(k, shape, fan_in):
        return jax.random.normal(k, shape, f32) * (fan_in ** -0.5)

    def gain(k, shape):
        return 1.0 + 0.02 * jax.random.normal(k, shape, f32)

    dt0 = jnp.exp(jax.random.uniform(ks[8], (DEPTH, SSD_HEADS), f32, math.log(1e-3), math.log(1e-1)))
    return {
        "x": jax.random.normal(ks[0], (BATCH, SEQ, D), f32),
        "w_norm_mix": gain(ks[1], (DEPTH, D)),
        "w_in": nrm(ks[2], (DEPTH, D, IN_DIM), D),
        "w_gk_up": nrm(ks[3], (DEPTH, GLA_GATE_RANK, GLA_KEY_WIDTH), GLA_GATE_RANK),
        "b_gk": 0.1 * jax.random.normal(ks[4], (DEPTH, GLA_KEY_WIDTH), f32),
        "w_gla_norm": gain(ks[5], (DEPTH, GLA_HEAD_V)),
        "w_conv": nrm(ks[6], (DEPTH, SSD_CONV, XBC_DIM), SSD_CONV),
        "b_conv": 0.02 * jax.random.normal(ks[7], (DEPTH, XBC_DIM), f32),
        "dt_bias": dt0 + jnp.log(-jnp.expm1(-dt0)),
        "a_log": jnp.log(jax.random.uniform(ks[9], (DEPTH, SSD_HEADS), f32, 1.0, 16.0)),
        "d_skip": 1.0 + 0.02 * jax.random.normal(ks[10], (DEPTH, SSD_HEADS), f32),
        "w_ssd_norm": gain(ks[11], (DEPTH, SSD_WIDTH)),
        "w_out": nrm(ks[12], (DEPTH, D_MIX, D), D_MIX),
        "w_norm_ffn": gain(ks[13], (DEPTH, D)),
        "w_router_group": nrm(ks[14], (DEPTH, D, MOE_GROUPS), D),
        "b_router_group": 0.01 * jax.random.normal(ks[15], (DEPTH, MOE_GROUPS), f32),
        "w_router_expert": nrm(ks[16], (DEPTH, D, N_EXPERTS), D),
        "b_router_expert": 0.01 * jax.random.normal(ks[17], (DEPTH, N_EXPERTS), f32),
        "w_gate": nrm(ks[18], (DEPTH, N_EXPERTS, D, D_EXPERT), D),
        "w_up": nrm(ks[19], (DEPTH, N_EXPERTS, D, D_EXPERT), D),
        "w_down": nrm(ks[20], (DEPTH, N_EXPERTS, D_EXPERT, D), D_EXPERT),
        "w_final_norm": gain(ks[21], (D,)),
    }


def reference(x, w_norm_mix, w_in, w_gk_up, b_gk, w_gla_norm, w_conv, b_conv, dt_bias, a_log,
              d_skip, w_ssd_norm, w_out, w_norm_ffn, w_router_group, b_router_group,
              w_router_expert, b_router_expert, w_gate, w_up, w_down, w_final_norm):
    for layer in range(DEPTH):
        h = rmsnorm(x, w_norm_mix[layer])
        x = x + mixer_block(h, w_in[layer], w_gk_up[layer], b_gk[layer], w_gla_norm[layer],
                            w_conv[layer], b_conv[layer], dt_bias[layer], a_log[layer],
                            d_skip[layer], w_ssd_norm[layer], w_out[layer])
        h = rmsnorm(x, w_norm_ffn[layer])
        x = x + hier_moe(h, w_router_group[layer], b_router_group[layer], w_router_expert[layer],
                         b_router_expert[layer], w_gate[layer], w_up[layer], w_down[layer])
    return rmsnorm(x, w_final_norm)
```

```cpp
#include <hip/hip_runtime.h>
#include <cstdio>
#include <cstdint>

typedef unsigned short bf16_t;

constexpr int T_TOK = 16384, SEQ = 4096, NB = 4, DM = 2048;
constexpr int IN_DIM = 6176;
constexpr int PJ = 6144;
constexpr int PQ = 0, PK = 512, PV = 1024, PG = 2048, PZ = 3072, PX = 4096, PB = 5120, PC = 5632;
constexpr int WI_GK = 3072, WI_Z = 3088, WI_XBC = 4112, WI_DT = 6160;
constexpr int NEXP = 32, DEXP = 512;
constexpr float EPS = 1e-6f;

__device__ __forceinline__ float bf2f(bf16_t b) { return __uint_as_float(((unsigned)b) << 16); }
__device__ __forceinline__ bf16_t f2bf(float f) { unsigned u = __float_as_uint(f); u += 0x7FFFu + ((u >> 16) & 1u); return (bf16_t)(u >> 16); }
__device__ __forceinline__ float siluf(float v) { return v / (1.f + __expf(-v)); }
__device__ __forceinline__ float softplusf(float v) { return v > 20.f ? v : log1pf(__expf(v)); }
__device__ __forceinline__ float logsigmoidf(float v) { return fminf(v, 0.f) - log1pf(__expf(-fabsf(v))); }
__device__ __forceinline__ int win_col(int j) { return j < 3072 ? j : (j < 4096 ? j - 3072 + WI_Z : j - 4096 + WI_XBC); }
__device__ __forceinline__ int win_col_small(int j) { return j < 16 ? WI_GK + j : WI_DT + (j - 16); }

constexpr size_t MiB = 1024 * 1024;
constexpr size_t WS_CTL = 0;
constexpr size_t WS_SMALL = 1 * MiB;
constexpr size_t WS_TOKE = WS_SMALL + 2 * MiB;
constexpr size_t WS_TOKW = WS_TOKE + MiB / 8;
constexpr size_t WS_LIST = WS_TOKW + MiB / 8;
constexpr size_t WS_HA = 8 * MiB;
constexpr size_t WS_PROJ = WS_HA + 64 * MiB;
constexpr size_t WS_SCR = WS_PROJ + 192 * MiB;
constexpr size_t WS_Y = WS_SCR;
constexpr size_t WS_HMID = WS_SCR + 128 * MiB;
constexpr size_t WS_END = WS_HMID + 48 * MiB;

__global__ void __launch_bounds__(256) n_rmsnorm_bf16(const float* __restrict__ x, const float* __restrict__ w, bf16_t* __restrict__ out) {
    __shared__ float red[4];
    const int t = blockIdx.x, tid = threadIdx.x;
    const float* xr = x + (size_t)t * DM;
    float v[8]; float s = 0.f;
    for (int i = 0; i < 8; ++i) { v[i] = xr[tid + i * 256]; s += v[i] * v[i]; }
    for (int o = 32; o > 0; o >>= 1) s += __shfl_xor(s, o);
    if ((tid & 63) == 0) red[tid >> 6] = s;
    __syncthreads();
    s = red[0] + red[1] + red[2] + red[3];
    const float r = rsqrtf(s / DM + EPS);
    for (int i = 0; i < 8; ++i) out[(size_t)t * DM + tid + i * 256] = f2bf(v[i] * r * w[tid + i * 256]);
}

template <class AL, class BL, class EP>
__device__ __forceinline__ void ngemm_tile(int m0, int n0, int K, AL aload, BL bload, EP epi) {
    __shared__ float As[16][65], Bs[16][65];
    const int tid = threadIdx.x, tx = tid & 15, ty = tid >> 4;
    float acc[4][4];
    for (int i = 0; i < 4; ++i) for (int j = 0; j < 4; ++j) acc[i][j] = 0.f;
    for (int k0 = 0; k0 < K; k0 += 16) {
        for (int i = 0; i < 4; ++i) { const int idx = tid + i * 256; const int r = idx >> 4, kk = idx & 15; As[kk][r] = aload(m0 + r, k0 + kk); }
        for (int i = 0; i < 4; ++i) { const int idx = tid + i * 256; const int kk = idx >> 6, c = idx & 63; Bs[kk][c] = bload(k0 + kk, n0 + c); }
        __syncthreads();
#pragma unroll
        for (int kk = 0; kk < 16; ++kk) {
            float a[4], b[4];
            for (int i = 0; i < 4; ++i) a[i] = As[kk][ty * 4 + i];
            for (int j = 0; j < 4; ++j) b[j] = Bs[kk][tx * 4 + j];
            for (int i = 0; i < 4; ++i) for (int j = 0; j < 4; ++j) acc[i][j] += a[i] * b[j];
        }
        __syncthreads();
    }
    for (int i = 0; i < 4; ++i) for (int j = 0; j < 4; ++j) epi(m0 + ty * 4 + i, n0 + tx * 4 + j, acc[i][j]);
}

__global__ void __launch_bounds__(256) n_inproj(const bf16_t* __restrict__ hA, const float* __restrict__ w_in, bf16_t* __restrict__ proj, float* __restrict__ small) {
    const int nt = blockIdx.x, m0 = blockIdx.y * 64;
    auto al = [&](int m, int k) { return bf2f(hA[(size_t)m * DM + k]); };
    if (nt < 96) {
        auto bl = [&](int k, int n) { return w_in[(size_t)k * IN_DIM + win_col(n)]; };
        auto ep = [&](int m, int n, float v) { proj[(size_t)m * PJ + n] = f2bf(v); };
        ngemm_tile(m0, nt * 64, DM, al, bl, ep);
    } else {
        auto bl = [&](int k, int n) { return n < 32 ? w_in[(size_t)k * IN_DIM + win_col_small(n)] : 0.f; };
        auto ep = [&](int m, int n, float v) { if (n < 32) small[(size_t)m * 32 + n] = v; };
        ngemm_tile(m0, 0, DM, al, bl, ep);
    }
}

__global__ void __launch_bounds__(256) n_gla_rec(const bf16_t* __restrict__ proj, const float* __restrict__ small, const float* __restrict__ w_gk_up,
                                                 const float* __restrict__ b_gk, float* __restrict__ o  ) {
    __shared__ float sq[128], sk[128], sa[128], sv[32], red[8][32];
    const int es = blockIdx.x, h = blockIdx.y, b = blockIdx.z, tid = threadIdx.x;
    const int dg = tid >> 5, e = tid & 31;
    float st[16];
    for (int i = 0; i < 16; ++i) st[i] = 0.f;
    const float scale = 0.08838834764831845f;
    for (int s = 0; s < SEQ; ++s) {
        const size_t t = (size_t)b * SEQ + s;
        if (tid < 128) {
            const int d = tid;
            float g = b_gk[h * 128 + d];
            for (int r = 0; r < 16; ++r) g += small[t * 32 + r] * w_gk_up[r * 512 + h * 128 + d];
            sa[d] = __expf(logsigmoidf(g) * (1.f / 16.f));
            sq[d] = bf2f(proj[t * PJ + PQ + h * 128 + d]) * scale;
            sk[d] = bf2f(proj[t * PJ + PK + h * 128 + d]);
        } else if (tid < 160) {
            sv[tid - 128] = bf2f(proj[t * PJ + PV + h * 256 + es * 32 + (tid - 128)]);
        }
        __syncthreads();
        float part = 0.f; const float v = sv[e];
#pragma unroll
        for (int i = 0; i < 16; ++i) { const int d = dg * 16 + i; st[i] = st[i] * sa[d] + sk[d] * v; part += sq[d] * st[i]; }
        red[dg][e] = part;
        __syncthreads();
        if (tid < 32) { float a = 0.f; for (int i = 0; i < 8; ++i) a += red[i][tid]; o[t * DM + h * 256 + es * 32 + tid] = a; }
        __syncthreads();
    }
}

__global__ void __launch_bounds__(256) n_gla_out(const float* __restrict__ o, const bf16_t* __restrict__ proj, const float* __restrict__ w_gla_norm, bf16_t* __restrict__ mix) {
    __shared__ float red[4];
    const int t = blockIdx.x, tid = threadIdx.x;
    for (int h = 0; h < 4; ++h) {
        const float v = o[(size_t)t * DM + h * 256 + tid];
        float s = v * v;
        for (int of = 32; of > 0; of >>= 1) s += __shfl_xor(s, of);
        __syncthreads();
        if ((tid & 63) == 0) red[tid >> 6] = s;
        __syncthreads();
        s = red[0] + red[1] + red[2] + red[3];
        const float r = rsqrtf(s / 256.f + EPS);
        const float g = bf2f(proj[(size_t)t * PJ + PG + h * 256 + tid]);
        mix[(size_t)t * DM + h * 256 + tid] = f2bf(v * r * w_gla_norm[tid] * siluf(g));
    }
}

__global__ void __launch_bounds__(256) n_ssd_rec(const bf16_t* __restrict__ proj, const float* __restrict__ small, const float* __restrict__ w_conv, const float* __restrict__ b_conv,
                                                 const float* __restrict__ dt_bias, const float* __restrict__ a_log, const float* __restrict__ d_skip, float* __restrict__ y  ) {
    __shared__ float sx[64], sB[128], sC[128];
    const int head = blockIdx.x, b = blockIdx.y, tid = threadIdx.x, g = head >> 2;
    const int p = tid >> 2, ng = tid & 3;
    float st[32];
    for (int i = 0; i < 32; ++i) st[i] = 0.f;
    const float a = -__expf(a_log[head]), dsk = d_skip[head], dtb = dt_bias[head];
    for (int s = 0; s < SEQ; ++s) {
        const size_t t = (size_t)b * SEQ + s;
        for (int c = tid; c < 320; c += 256) {
            const int ch = c < 64 ? head * 64 + c : (c < 192 ? 1024 + g * 128 + (c - 64) : 1536 + g * 128 + (c - 192));
            float acc = b_conv[ch];
            for (int k = 0; k < 4; ++k) { const int ss = s - 3 + k; if (ss >= 0) acc += w_conv[k * 2048 + ch] * bf2f(proj[((size_t)b * SEQ + ss) * PJ + PX + ch]); }
            acc = siluf(acc);
            if (c < 64) sx[c] = acc; else if (c < 192) sB[c - 64] = acc; else sC[c - 192] = acc;
        }
        __syncthreads();
        const float dt = softplusf(small[t * 32 + 16 + head] + dtb);
        const float dA = __expf(dt * a);
        const float xv = sx[p], xdt = xv * dt;
        float part = 0.f;
#pragma unroll
        for (int i = 0; i < 32; ++i) { const int n = ng * 32 + i; st[i] = st[i] * dA + xdt * sB[n]; part += sC[n] * st[i]; }
        part += __shfl_xor(part, 1); part += __shfl_xor(part, 2);
        if (ng == 0) y[t * DM + 1024 + head * 64 + p] = part + dsk * xv;
        __syncthreads();
    }
}

__global__ void __launch_bounds__(256) n_ssd_out(const float* __restrict__ y, const bf16_t* __restrict__ proj, const float* __restrict__ w_ssd_norm, bf16_t* __restrict__ mix) {
    __shared__ float red[4];
    const int t = blockIdx.x, tid = threadIdx.x;
    for (int g = 0; g < 4; ++g) {
        const int c = g * 256 + tid;
        const float v = y[(size_t)t * DM + 1024 + c] * siluf(bf2f(proj[(size_t)t * PJ + PZ + c]));
        float s = v * v;
        for (int of = 32; of > 0; of >>= 1) s += __shfl_xor(s, of);
        __syncthreads();
        if ((tid & 63) == 0) red[tid >> 6] = s;
        __syncthreads();
        s = red[0] + red[1] + red[2] + red[3];
        const float r = rsqrtf(s / 256.f + EPS);
        mix[(size_t)t * DM + 1024 + c] = f2bf(v * r * w_ssd_norm[c]);
    }
}

__global__ void __launch_bounds__(256) n_outproj(const bf16_t* __restrict__ mix, const float* __restrict__ w_out, const float* __restrict__ x, float* __restrict__ x1) {
    auto al = [&](int m, int k) { return bf2f(mix[(size_t)m * DM + k]); };
    auto bl = [&](int k, int n) { return w_out[(size_t)k * DM + n]; };
    auto ep = [&](int m, int n, float v) { x1[(size_t)m * DM + n] = x[(size_t)m * DM + n] + v; };
    ngemm_tile(blockIdx.y * 64, blockIdx.x * 64, DM, al, bl, ep);
}

__global__ void __launch_bounds__(256) n_router(const float* __restrict__ x1, const float* __restrict__ w_norm, const float* __restrict__ w_rg, const float* __restrict__ b_rg,
                                                const float* __restrict__ w_re, const float* __restrict__ b_re, bf16_t* __restrict__ h2, int* __restrict__ tok_e, float* __restrict__ tok_w,
                                                int* __restrict__ cnt, int* __restrict__ list) {
    __shared__ float red[4][36]; __shared__ float sred[4];
    const int t = blockIdx.x, tid = threadIdx.x;
    float v[8]; float s = 0.f;
    for (int i = 0; i < 8; ++i) { v[i] = x1[(size_t)t * DM + tid + i * 256]; s += v[i] * v[i]; }
    for (int o = 32; o > 0; o >>= 1) s += __shfl_xor(s, o);
    if ((tid & 63) == 0) sred[tid >> 6] = s;
    __syncthreads();
    s = sred[0] + sred[1] + sred[2] + sred[3];
    const float r = rsqrtf(s / DM + EPS);
    float lg[36];
    for (int j = 0; j < 36; ++j) lg[j] = 0.f;
    for (int i = 0; i < 8; ++i) {
        const int k = tid + i * 256; const float hv = v[i] * r * w_norm[k];
        h2[(size_t)t * DM + k] = f2bf(hv);
        for (int j = 0; j < 4; ++j) lg[j] += hv * w_rg[k * 4 + j];
        for (int j = 0; j < 32; ++j) lg[4 + j] += hv * w_re[k * 32 + j];
    }
    for (int j = 0; j < 36; ++j) { float a = lg[j]; for (int o = 32; o > 0; o >>= 1) a += __shfl_xor(a, o); if ((tid & 63) == 0) red[tid >> 6][j] = a; }
    __syncthreads();
    if (tid == 0) {
        float gl[4]; int gi = 0; float gm = -1e30f;
        for (int j = 0; j < 4; ++j) { gl[j] = red[0][j] + red[1][j] + red[2][j] + red[3][j] + b_rg[j]; if (gl[j] > gm) { gm = gl[j]; gi = j; } }
        float gs = 0.f; for (int j = 0; j < 4; ++j) gs += __expf(gl[j] - gm);
        const float gw = 1.f / gs;
        float el[8]; int i0 = 0; float m0 = -1e30f;
        for (int j = 0; j < 8; ++j) { const int c = 4 + gi * 8 + j; el[j] = red[0][c] + red[1][c] + red[2][c] + red[3][c] + b_re[gi * 8 + j]; if (el[j] > m0) { m0 = el[j]; i0 = j; } }
        int i1 = -1; float m1 = -1e30f;
        for (int j = 0; j < 8; ++j) if (j != i0 && el[j] > m1) { m1 = el[j]; i1 = j; }
        const float e1 = __expf(m1 - m0);
        const float w0 = gw / (1.f + e1), w1 = gw * e1 / (1.f + e1);
        const int ex0 = gi * 8 + i0, ex1 = gi * 8 + i1;
        tok_e[t * 2] = ex0; tok_e[t * 2 + 1] = ex1; tok_w[t * 2] = w0; tok_w[t * 2 + 1] = w1;
        int p0 = atomicAdd(&cnt[ex0], 1); list[ex0 * T_TOK + p0] = t * 2;
        int p1 = atomicAdd(&cnt[ex1], 1); list[ex1 * T_TOK + p1] = t * 2 + 1;
    }
}

__device__ __forceinline__ int moe_off(const int* cnt, int e) { int o = 0; for (int i = 0; i < e; ++i) o += (cnt[i] + 255) & ~255; return o; }

__global__ void __launch_bounds__(256) n_moe_up(const bf16_t* __restrict__ h2, const float* __restrict__ w_gate, const float* __restrict__ w_up, const int* __restrict__ cnt,
                                                const int* __restrict__ list, bf16_t* __restrict__ hmid, float* __restrict__ tmp  ) {
    const int e = blockIdx.z, m0 = blockIdx.y * 64, n0 = blockIdx.x * 64, ne = cnt[e];
    if (m0 >= ne) return;
    const int off = moe_off(cnt, e);
    const int* le = list + (size_t)e * T_TOK;
    __shared__ float gsave[64][65];
    auto al = [&](int m, int k) { return m < ne ? bf2f(h2[(size_t)(le[m] >> 1) * DM + k]) : 0.f; };
    auto blg = [&](int k, int n) { return w_gate[((size_t)e * DM + k) * DEXP + n]; };
    auto blu = [&](int k, int n) { return w_up[((size_t)e * DM + k) * DEXP + n]; };
    auto epg = [&](int m, int n, float v) { gsave[m - m0][n - n0] = v; };
    ngemm_tile(m0, n0, DM, al, blg, epg);
    auto epu = [&](int m, int n, float v) { if (m < ne) hmid[(size_t)(off + m) * DEXP + n] = f2bf(siluf(gsave[m - m0][n - n0]) * v); };
    ngemm_tile(m0, n0, DM, al, blu, epu);
}

__global__ void __launch_bounds__(256) n_moe_down(const bf16_t* __restrict__ hmid, const float* __restrict__ w_down, const int* __restrict__ cnt, const int* __restrict__ list, bf16_t* __restrict__ y) {
    const int e = blockIdx.z, m0 = blockIdx.y * 64, n0 = blockIdx.x * 64, ne = cnt[e];
    if (m0 >= ne) return;
    const int off = moe_off(cnt, e);
    const int* le = list + (size_t)e * T_TOK;
    auto al = [&](int m, int k) { return m < ne ? bf2f(hmid[(size_t)(off + m) * DEXP + k]) : 0.f; };
    auto bl = [&](int k, int n) { return w_down[((size_t)e * DEXP + k) * DM + n]; };
    auto ep = [&](int m, int n, float v) { if (m < ne) y[(size_t)le[m] * DM + n] = f2bf(v); };
    ngemm_tile(m0, n0, DEXP, al, bl, ep);
}

__global__ void __launch_bounds__(256) n_final(const float* __restrict__ x1, const bf16_t* __restrict__ y, const float* __restrict__ tok_w, const float* __restrict__ w, float* __restrict__ out) {
    __shared__ float red[4];
    const int t = blockIdx.x, tid = threadIdx.x;
    const float w0 = tok_w[t * 2], w1 = tok_w[t * 2 + 1];
    float v[8]; float s = 0.f;
    for (int i = 0; i < 8; ++i) { const int k = tid + i * 256;
        v[i] = x1[(size_t)t * DM + k] + w0 * bf2f(y[((size_t)t * 2) * DM + k]) + w1 * bf2f(y[((size_t)t * 2 + 1) * DM + k]); s += v[i] * v[i]; }
    for (int o = 32; o > 0; o >>= 1) s += __shfl_xor(s, o);
    if ((tid & 63) == 0) red[tid >> 6] = s;
    __syncthreads();
    s = red[0] + red[1] + red[2] + red[3];
    const float r = rsqrtf(s / DM + EPS);
    for (int i = 0; i < 8; ++i) { const int k = tid + i * 256; out[(size_t)t * DM + k] = v[i] * r * w[k]; }
}

extern "C" void kernel_launch(void* const* d_in, const int* in_sizes, int n_in, void* d_out, int out_size, void* d_ws, size_t ws_size, hipStream_t stream) {
    if (ws_size < WS_END) { fprintf(stderr, "kernel_launch: workspace too small: %zu < %zu\n", ws_size, (size_t)WS_END); return; }
    const float* x = (const float*)d_in[0];
    const float* w_norm_mix = (const float*)d_in[1];
    const float* w_in = (const float*)d_in[2];
    const float* w_gk_up = (const float*)d_in[3];
    const float* b_gk = (const float*)d_in[4];
    const float* w_gla_norm = (const float*)d_in[5];
    const float* w_conv = (const float*)d_in[6];
    const float* b_conv = (const float*)d_in[7];
    const float* dt_bias = (const float*)d_in[8];
    const float* a_log = (const float*)d_in[9];
    const float* d_skip = (const float*)d_in[10];
    const float* w_ssd_norm = (const float*)d_in[11];
    const float* w_out = (const float*)d_in[12];
    const float* w_norm_ffn = (const float*)d_in[13];
    const float* w_rg = (const float*)d_in[14];
    const float* b_rg = (const float*)d_in[15];
    const float* w_re = (const float*)d_in[16];
    const float* b_re = (const float*)d_in[17];
    const float* w_gate = (const float*)d_in[18];
    const float* w_up = (const float*)d_in[19];
    const float* w_down = (const float*)d_in[20];
    const float* w_final = (const float*)d_in[21];
    char* ws = (char*)d_ws;
    float* out = (float*)d_out;
    int* cnt = (int*)(ws + WS_CTL);
    float* small = (float*)(ws + WS_SMALL);
    int* tok_e = (int*)(ws + WS_TOKE);
    float* tok_w = (float*)(ws + WS_TOKW);
    int* list = (int*)(ws + WS_LIST);
    bf16_t* hA = (bf16_t*)(ws + WS_HA);
    bf16_t* proj = (bf16_t*)(ws + WS_PROJ);
    bf16_t* ybuf = (bf16_t*)(ws + WS_Y);
    bf16_t* hmid = (bf16_t*)(ws + WS_HMID);
    bf16_t* mix = hA;
    bf16_t* h2 = hA;
    float* x1 = (float*)(ws + WS_PROJ);
    float* oy = out;

    hipMemsetAsync(ws + WS_CTL, 0, 65536, stream);
    n_rmsnorm_bf16<<<T_TOK, 256, 0, stream>>>(x, w_norm_mix, hA);
    n_inproj<<<dim3(97, T_TOK / 64), 256, 0, stream>>>(hA, w_in, proj, small);
    n_gla_rec<<<dim3(8, 4, NB), 256, 0, stream>>>(proj, small, w_gk_up, b_gk, oy);
    n_ssd_rec<<<dim3(16, NB), 256, 0, stream>>>(proj, small, w_conv, b_conv, dt_bias, a_log, d_skip, oy);
    n_gla_out<<<T_TOK, 256, 0, stream>>>(oy, proj, w_gla_norm, mix);
    n_ssd_out<<<T_TOK, 256, 0, stream>>>(oy, proj, w_ssd_norm, mix);
    n_outproj<<<dim3(32, T_TOK / 64), 256, 0, stream>>>(mix, w_out, x, x1);
    n_router<<<T_TOK, 256, 0, stream>>>(x1, w_norm_ffn, w_rg, b_rg, w_re, b_re, h2, tok_e, tok_w, cnt, list);
    n_moe_up<<<dim3(8, 256, 32), 256, 0, stream>>>(h2, w_gate, w_up, cnt, list, hmid, nullptr);
    n_moe_down<<<dim3(32, 256, 32), 256, 0, stream>>>(hmid, w_down, cnt, list, ybuf);
    n_final<<<T_TOK, 256, 0, stream>>>(x1, ybuf, tok_w, w_final, out);
}
```

```cpp
#include <hip/hip_runtime.h>
#include <cstdio>
#include <cstdint>

typedef unsigned short bf16_t;

constexpr int T_TOK = 16384, SEQ = 4096, NB = 4, DM = 2048;
constexpr int IN_DIM = 6176;
constexpr int PJ = 6144;
constexpr int PQ = 0, PK = 512, PV = 1024, PG = 2048, PZ = 3072, PX = 4096, PB = 5120, PC = 5632;
constexpr int WI_GK = 3072, WI_Z = 3088, WI_XBC = 4112, WI_DT = 6160;
constexpr int NEXP = 32, DEXP = 512;
constexpr float EPS = 1e-6f;

__device__ __forceinline__ float bf2f(bf16_t b) { return __uint_as_float(((unsigned)b) << 16); }
__device__ __forceinline__ bf16_t f2bf(float f) { unsigned u = __float_as_uint(f); u += 0x7FFFu + ((u >> 16) & 1u); return (bf16_t)(u >> 16); }
__device__ __forceinline__ float siluf(float v) { return v / (1.f + __expf(-v)); }
__device__ __forceinline__ float softplusf(float v) { return v > 20.f ? v : log1pf(__expf(v)); }
__device__ __forceinline__ float logsigmoidf(float v) { return fminf(v, 0.f) - log1pf(__expf(-fabsf(v))); }
__device__ __forceinline__ int win_col(int j) { return j < 3072 ? j : (j < 4096 ? j - 3072 + WI_Z : j - 4096 + WI_XBC); }
__device__ __forceinline__ int win_col_small(int j) { return j < 16 ? WI_GK + j : WI_DT + (j - 16); }

constexpr size_t MiB = 1024 * 1024;
constexpr size_t WS_CTL = 0;
constexpr size_t WS_SMALL = 1 * MiB;
constexpr size_t WS_TOKE = WS_SMALL + 2 * MiB;
constexpr size_t WS_TOKW = WS_TOKE + MiB / 8;
constexpr size_t WS_LIST = WS_TOKW + MiB / 8;
constexpr size_t WS_HA = 8 * MiB;
constexpr size_t WS_PROJ = WS_HA + 64 * MiB;
constexpr size_t WS_SCR = WS_PROJ + 192 * MiB;
constexpr size_t WS_Y = WS_SCR;
constexpr size_t WS_HMID = WS_SCR + 128 * MiB;
constexpr size_t WS_END = WS_HMID + 48 * MiB;

__global__ void __launch_bounds__(256) n_rmsnorm_bf16(const float* __restrict__ x, const float* __restrict__ w, bf16_t* __restrict__ out) {
    __shared__ float red[4];
    const int t = blockIdx.x, tid = threadIdx.x;
    const float* xr = x + (size_t)t * DM;
    float v[8]; float s = 0.f;
    for (int i = 0; i < 8; ++i) { v[i] = xr[tid + i * 256]; s += v[i] * v[i]; }
    for (int o = 32; o > 0; o >>= 1) s += __shfl_xor(s, o);
    if ((tid & 63) == 0) red[tid >> 6] = s;
    __syncthreads();
    s = red[0] + red[1] + red[2] + red[3];
    const float r = rsqrtf(s / DM + EPS);
    for (int i = 0; i < 8; ++i) out[(size_t)t * DM + tid + i * 256] = f2bf(v[i] * r * w[tid + i * 256]);
}

template <class AL, class BL, class EP>
__device__ __forceinline__ void ngemm_tile(int m0, int n0, int K, AL aload, BL bload, EP epi) {
    __shared__ float As[16][65], Bs[16][65];
    const int tid = threadIdx.x, tx = tid & 15, ty = tid >> 4;
    float acc[4][4];
    for (int i = 0; i < 4; ++i) for (int j = 0; j < 4; ++j) acc[i][j] = 0.f;
    for (int k0 = 0; k0 < K; k0 += 16) {
        for (int i = 0; i < 4; ++i) { const int idx = tid + i * 256; const int r = idx >> 4, kk = idx & 15; As[kk][r] = aload(m0 + r, k0 + kk); }
        for (int i = 0; i < 4; ++i) { const int idx = tid + i * 256; const int kk = idx >> 6, c = idx & 63; Bs[kk][c] = bload(k0 + kk, n0 + c); }
        __syncthreads();
#pragma unroll
        for (int kk = 0; kk < 16; ++kk) {
            float a[4], b[4];
            for (int i = 0; i < 4; ++i) a[i] = As[kk][ty * 4 + i];
            for (int j = 0; j < 4; ++j) b[j] = Bs[kk][tx * 4 + j];
            for (int i = 0; i < 4; ++i) for (int j = 0; j < 4; ++j) acc[i][j] += a[i] * b[j];
        }
        __syncthreads();
    }
    for (int i = 0; i < 4; ++i) for (int j = 0; j < 4; ++j) epi(m0 + ty * 4 + i, n0 + tx * 4 + j, acc[i][j]);
}

__global__ void __launch_bounds__(256) n_inproj(const bf16_t* __restrict__ hA, const float* __restrict__ w_in, bf16_t* __restrict__ proj, float* __restrict__ small) {
    const int nt = blockIdx.x, m0 = blockIdx.y * 64;
    auto al = [&](int m, int k) { return bf2f(hA[(size_t)m * DM + k]); };
    if (nt < 96) {
        auto bl = [&](int k, int n) { return w_in[(size_t)k * IN_DIM + win_col(n)]; };
        auto ep = [&](int m, int n, float v) { proj[(size_t)m * PJ + n] = f2bf(v); };
        ngemm_tile(m0, nt * 64, DM, al, bl, ep);
    } else {
        auto bl = [&](int k, int n) { return n < 32 ? w_in[(size_t)k * IN_DIM + win_col_small(n)] : 0.f; };
        auto ep = [&](int m, int n, float v) { if (n < 32) small[(size_t)m * 32 + n] = v; };
        ngemm_tile(m0, 0, DM, al, bl, ep);
    }
}

__global__ void __launch_bounds__(256) n_gla_rec(const bf16_t* __restrict__ proj, const float* __restrict__ small, const float* __restrict__ w_gk_up,
                                                 const float* __restrict__ b_gk, float* __restrict__ o  ) {
    __shared__ float sq[128], sk[128], sa[128], sv[32], red[8][32];
    const int es = blockIdx.x, h = blockIdx.y, b = blockIdx.z, tid = threadIdx.x;
    const int dg = tid >> 5, e = tid & 31;
    float st[16];
    for (int i = 0; i < 16; ++i) st[i] = 0.f;
    const float scale = 0.08838834764831845f;
    for (int s = 0; s < SEQ; ++s) {
        const size_t t = (size_t)b * SEQ + s;
        if (tid < 128) {
            const int d = tid;
            float g = b_gk[h * 128 + d];
            for (int r = 0; r < 16; ++r) g += small[t * 32 + r] * w_gk_up[r * 512 + h * 128 + d];
            sa[d] = __expf(logsigmoidf(g) * (1.f / 16.f));
            sq[d] = bf2f(proj[t * PJ + PQ + h * 128 + d]) * scale;
            sk[d] = bf2f(proj[t * PJ + PK + h * 128 + d]);
        } else if (tid < 160) {
            sv[tid - 128] = bf2f(proj[t * PJ + PV + h * 256 + es * 32 + (tid - 128)]);
        }
        __syncthreads();
        float part = 0.f; const float v = sv[e];
#pragma unroll
        for (int i = 0; i < 16; ++i) { const int d = dg * 16 + i; st[i] = st[i] * sa[d] + sk[d] * v; part += sq[d] * st[i]; }
        red[dg][e] = part;
        __syncthreads();
        if (tid < 32) { float a = 0.f; for (int i = 0; i < 8; ++i) a += red[i][tid]; o[t * DM + h * 256 + es * 32 + tid] = a; }
        __syncthreads();
    }
}

__global__ void __launch_bounds__(256) n_gla_out(const float* __restrict__ o, const bf16_t* __restrict__ proj, const float* __restrict__ w_gla_norm, bf16_t* __restrict__ mix) {
    __shared__ float red[4];
    const int t = blockIdx.x, tid = threadIdx.x;
    for (int h = 0; h < 4; ++h) {
        const float v = o[(size_t)t * DM + h * 256 + tid];
        float s = v * v;
        for (int of = 32; of > 0; of >>= 1) s += __shfl_xor(s, of);
        __syncthreads();
        if ((tid & 63) == 0) red[tid >> 6] = s;
        __syncthreads();
        s = red[0] + red[1] + red[2] + red[3];
        const float r = rsqrtf(s / 256.f + EPS);
        const float g = bf2f(proj[(size_t)t * PJ + PG + h * 256 + tid]);
        mix[(size_t)t * DM + h * 256 + tid] = f2bf(v * r * w_gla_norm[tid] * siluf(g));
    }
}

__global__ void __launch_bounds__(256) n_ssd_rec(const bf16_t* __restrict__ proj, const float* __restrict__ small, const float* __restrict__ w_conv, const float* __restrict__ b_conv,
                                                 const float* __restrict__ dt_bias, const float* __restrict__ a_log, const float* __restrict__ d_skip, float* __restrict__ y  ) {
    __shared__ float sx[64], sB[128], sC[128];
    const int head = blockIdx.x, b = blockIdx.y, tid = threadIdx.x, g = head >> 2;
    const int p = tid >> 2, ng = tid & 3;
    float st[32];
    for (int i = 0; i < 32; ++i) st[i] = 0.f;
    const float a = -__expf(a_log[head]), dsk = d_skip[head], dtb = dt_bias[head];
    for (int s = 0; s < SEQ; ++s) {
        const size_t t = (size_t)b * SEQ + s;
        for (int c = tid; c < 320; c += 256) {
            const int ch = c < 64 ? head * 64 + c : (c < 192 ? 1024 + g * 128 + (c - 64) : 1536 + g * 128 + (c - 192));
            float acc = b_conv[ch];
            for (int k = 0; k < 4; ++k) { const int ss = s - 3 + k; if (ss >= 0) acc += w_conv[k * 2048 + ch] * bf2f(proj[((size_t)b * SEQ + ss) * PJ + PX + ch]); }
            acc = siluf(acc);
            if (c < 64) sx[c] = acc; else if (c < 192) sB[c - 64] = acc; else sC[c - 192] = acc;
        }
        __syncthreads();
        const float dt = softplusf(small[t * 32 + 16 + head] + dtb);
        const float dA = __expf(dt * a);
        const float xv = sx[p], xdt = xv * dt;
        float part = 0.f;
#pragma unroll
        for (int i = 0; i < 32; ++i) { const int n = ng * 32 + i; st[i] = st[i] * dA + xdt * sB[n]; part += sC[n] * st[i]; }
        part += __shfl_xor(part, 1); part += __shfl_xor(part, 2);
        if (ng == 0) y[t * DM + 1024 + head * 64 + p] = part + dsk * xv;
        __syncthreads();
    }
}

__global__ void __launch_bounds__(256) n_ssd_out(const float* __restrict__ y, const bf16_t* __restrict__ proj, const float* __restrict__ w_ssd_norm, bf16_t* __restrict__ mix) {
    __shared__ float red[4];
    const int t = blockIdx.x, tid = threadIdx.x;
    for (int g = 0; g < 4; ++g) {
        const int c = g * 256 + tid;
        const float v = y[(size_t)t * DM + 1024 + c] * siluf(bf2f(proj[(size_t)t * PJ + PZ + c]));
        float s = v * v;
        for (int of = 32; of > 0; of >>= 1) s += __shfl_xor(s, of);
        __syncthreads();
        if ((tid & 63) == 0) red[tid >> 6] = s;
        __syncthreads();
        s = red[0] + red[1] + red[2] + red[3];
        const float r = rsqrtf(s / 256.f + EPS);
        mix[(size_t)t * DM + 1024 + c] = f2bf(v * r * w_ssd_norm[c]);
    }
}

__global__ void __launch_bounds__(256) n_outproj(const bf16_t* __restrict__ mix, const float* __restrict__ w_out, const float* __restrict__ x, float* __restrict__ x1) {
    auto al = [&](int m, int k) { return bf2f(mix[(size_t)m * DM + k]); };
    auto bl = [&](int k, int n) { return w_out[(size_t)k * DM + n]; };
    auto ep = [&](int m, int n, float v) { x1[(size_t)m * DM + n] = x[(size_t)m * DM + n] + v; };
    ngemm_tile(blockIdx.y * 64, blockIdx.x * 64, DM, al, bl, ep);
}

__global__ void __launch_bounds__(256) n_router(const float* __restrict__ x1, const float* __restrict__ w_norm, const float* __restrict__ w_rg, const float* __restrict__ b_rg,
                                                const float* __restrict__ w_re, const float* __restrict__ b_re, bf16_t* __restrict__ h2, int* __restrict__ tok_e, float* __restrict__ tok_w,
                                                int* __restrict__ cnt, int* __restrict__ list) {
    __shared__ float red[4][36]; __shared__ float sred[4];
    const int t = blockIdx.x, tid = threadIdx.x;
    float v[8]; float s = 0.f;
    for (int i = 0; i < 8; ++i) { v[i] = x1[(size_t)t * DM + tid + i * 256]; s += v[i] * v[i]; }
    for (int o = 32; o > 0; o >>= 1) s += __shfl_xor(s, o);
    if ((tid & 63) == 0) sred[tid >> 6] = s;
    __syncthreads();
    s = sred[0] + sred[1] + sred[2] + sred[3];
    const float r = rsqrtf(s / DM + EPS);
    float lg[36];
    for (int j = 0; j < 36; ++j) lg[j] = 0.f;
    for (int i = 0; i < 8; ++i) {
        const int k = tid + i * 256; const float hv = v[i] * r * w_norm[k];
        h2[(size_t)t * DM + k] = f2bf(hv);
        for (int j = 0; j < 4; ++j) lg[j] += hv * w_rg[k * 4 + j];
        for (int j = 0; j < 32; ++j) lg[4 + j] += hv * w_re[k * 32 + j];
    }
    for (int j = 0; j < 36; ++j) { float a = lg[j]; for (int o = 32; o > 0; o >>= 1) a += __shfl_xor(a, o); if ((tid & 63) == 0) red[tid >> 6][j] = a; }
    __syncthreads();
    if (tid == 0) {
        float gl[4]; int gi = 0; float gm = -1e30f;
        for (int j = 0; j < 4; ++j) { gl[j] = red[0][j] + red[1][j] + red[2][j] + red[3][j] + b_rg[j]; if (gl[j] > gm) { gm = gl[j]; gi = j; } }
        float gs = 0.f; for (int j = 0; j < 4; ++j) gs += __expf(gl[j] - gm);
        const float gw = 1.f / gs;
        float el[8]; int i0 = 0; float m0 = -1e30f;
        for (int j = 0; j < 8; ++j) { const int c = 4 + gi * 8 + j; el[j] = red[0][c] + red[1][c] + red[2][c] + red[3][c] + b_re[gi * 8 + j]; if (el[j] > m0) { m0 = el[j]; i0 = j; } }
        int i1 = -1; float m1 = -1e30f;
        for (int j = 0; j < 8; ++j) if (j != i0 && el[j] > m1) { m1 = el[j]; i1 = j; }
        const float e1 = __expf(m1 - m0);
        const float w0 = gw / (1.f + e1), w1 = gw * e1 / (1.f + e1);
        const int ex0 = gi * 8 + i0, ex1 = gi * 8 + i1;
        tok_e[t * 2] = ex0; tok_e[t * 2 + 1] = ex1; tok_w[t * 2] = w0; tok_w[t * 2 + 1] = w1;
        int p0 = atomicAdd(&cnt[ex0], 1); list[ex0 * T_TOK + p0] = t * 2;
        int p1 = atomicAdd(&cnt[ex1], 1); list[ex1 * T_TOK + p1] = t * 2 + 1;
    }
}

__device__ __forceinline__ int moe_off(const int* cnt, int e) { int o = 0; for (int i = 0; i < e; ++i) o += (cnt[i] + 255) & ~255; return o; }

__global__ void __launch_bounds__(256) n_moe_up(const bf16_t* __restrict__ h2, const float* __restrict__ w_gate, const float* __restrict__ w_up, const int* __restrict__ cnt,
                                                const int* __restrict__ list, bf16_t* __restrict__ hmid, float* __restrict__ tmp  ) {
    const int e = blockIdx.z, m0 = blockIdx.y * 64, n0 = blockIdx.x * 64, ne = cnt[e];
    if (m0 >= ne) return;
    const int off = moe_off(cnt, e);
    const int* le = list + (size_t)e * T_TOK;
    __shared__ float gsave[64][65];
    auto al = [&](int m, int k) { return m < ne ? bf2f(h2[(size_t)(le[m] >> 1) * DM + k]) : 0.f; };
    auto blg = [&](int k, int n) { return w_gate[((size_t)e * DM + k) * DEXP + n]; };
    auto blu = [&](int k, int n) { return w_up[((size_t)e * DM + k) * DEXP + n]; };
    auto epg = [&](int m, int n, float v) { gsave[m - m0][n - n0] = v; };
    ngemm_tile(m0, n0, DM, al, blg, epg);
    auto epu = [&](int m, int n, float v) { if (m < ne) hmid[(size_t)(off + m) * DEXP + n] = f2bf(siluf(gsave[m - m0][n - n0]) * v); };
    ngemm_tile(m0, n0, DM, al, blu, epu);
}

__global__ void __launch_bounds__(256) n_moe_down(const bf16_t* __restrict__ hmid, const float* __restrict__ w_down, const int* __restrict__ cnt, const int* __restrict__ list, bf16_t* __restrict__ y) {
    const int e = blockIdx.z, m0 = blockIdx.y * 64, n0 = blockIdx.x * 64, ne = cnt[e];
    if (m0 >= ne) return;
    const int off = moe_off(cnt, e);
    const int* le = list + (size_t)e * T_TOK;
    auto al = [&](int m, int k) { return m < ne ? bf2f(hmid[(size_t)(off + m) * DEXP + k]) : 0.f; };
    auto bl = [&](int k, int n) { return w_down[((size_t)e * DEXP + k) * DM + n]; };
    auto ep = [&](int m, int n, float v) { if (m < ne) y[(size_t)le[m] * DM + n] = f2bf(v); };
    ngemm_tile(m0, n0, DEXP, al, bl, ep);
}

__global__ void __launch_bounds__(256) n_final(const float* __restrict__ x1, const bf16_t* __restrict__ y, const float* __restrict__ tok_w, const float* __restrict__ w, float* __restrict__ out) {
    __shared__ float red[4];
    const int t = blockIdx.x, tid = threadIdx.x;
    const float w0 = tok_w[t * 2], w1 = tok_w[t * 2 + 1];
    float v[8]; float s = 0.f;
    for (int i = 0; i < 8; ++i) { const int k = tid + i * 256;
        v[i] = x1[(size_t)t * DM + k] + w0 * bf2f(y[((size_t)t * 2) * DM + k]) + w1 * bf2f(y[((size_t)t * 2 + 1) * DM + k]); s += v[i] * v[i]; }
    for (int o = 32; o > 0; o >>= 1) s += __shfl_xor(s, o);
    if ((tid & 63) == 0) red[tid >> 6] = s;
    __syncthreads();
    s = red[0] + red[1] + red[2] + red[3];
    const float r = rsqrtf(s / DM + EPS);
    for (int i = 0; i < 8; ++i) { const int k = tid + i * 256; out[(size_t)t * DM + k] = v[i] * r * w[k]; }
}

#include <hip/hip_cooperative_groups.h>
namespace cg = cooperative_groups;
#define LAS __attribute__((address_space(3)))
#define GAS __attribute__((address_space(1)))
typedef short bf16x8 __attribute__((ext_vector_type(8)));
typedef float f32x4 __attribute__((ext_vector_type(4)));
typedef float f32x2 __attribute__((ext_vector_type(2)));
typedef unsigned u32x4 __attribute__((ext_vector_type(4)));
typedef unsigned u32x2 __attribute__((ext_vector_type(2)));
#define LDS_WAIT() asm volatile("s_waitcnt lgkmcnt(0)" ::: "memory")
#define VM_WAIT() asm volatile("s_waitcnt vmcnt(0)" ::: "memory")
__device__ __forceinline__ unsigned cvt_pk_bf16(float lo, float hi) { unsigned r; asm volatile("v_cvt_pk_bf16_f32 %0, %1, %2" : "=v"(r) : "v"(lo), "v"(hi)); return r; }

namespace pg8 {
constexpr int BM = 256, BK = 64, HALF = 128, HTB = HALF * BK * 2, STAGE_BYTES = 8 * HTB, NXCD = 8, WGM = 8;
__host__ __device__ __forceinline__ int lds_byte(int r, int c) { const int st = (r >> 4) * 2 + (c >> 5), rr = r & 15, cc = c & 31, ob = rr * 64 + cc * 2; return st * 1024 + (ob ^ (((ob >> 9) & 1) << 5)); }
__host__ __device__ __forceinline__ void stage_rc(int b, int& R, int& C) { const int st = b / 1024, sb = b % 1024, swz = sb ^ (((sb >> 9) & 1) << 5); R = (st >> 1) * 16 + swz / 64; C = (st & 1) * 32 + (swz % 64) / 2; }
__host__ __device__ __forceinline__ int perm32(int rho) { const int n = rho >> 4, i = rho & 15; return 8 * (i >> 2) + 4 * n + (i & 3); }

struct Unit { int pm, pn, e, row0, ne; };

struct StaticOrder {
    static constexpr bool GATHER = false;
    const char* A; const char* Bt; size_t tstep;
    int nM, nN, nwg, G, c;
    __device__ void init(const bf16_t* A_, const bf16_t* Bt_, int M, int N, int K, int G_, int c_) { A = (const char*)A_; Bt = (const char*)Bt_; tstep = (size_t)BM * K * 2; nM = M / BM; nN = N / BM; nwg = nM * nN; G = G_; c = c_; }
    __device__ bool next(int i, Unit& u) const {
        const long L = (long)i * G + c; if (L >= nwg) return false;
        int wgid = (int)L; { const int q = nwg / NXCD, r = nwg % NXCD, xcd = wgid % NXCD, off = wgid / NXCD; wgid = (xcd < r ? xcd * (q + 1) : r * (q + 1) + (xcd - r) * q) + off; }
        const int nig = WGM * nN, gid = wgid / nig, fm = gid * WGM, gsz = (nM - fm) < WGM ? (nM - fm) : WGM;
        u.pm = fm + ((wgid % nig) % gsz); u.pn = (wgid % nig) / gsz; u.e = 0; u.row0 = 0; u.ne = 0; return true;
    }
    __device__ __forceinline__ const char* a_ptr(const Unit& u) const { return A + (size_t)u.pm * tstep; }
    __device__ __forceinline__ const char* b_ptr(const Unit& u) const { return Bt + (size_t)u.pn * tstep; }
    __device__ __forceinline__ int a_row(const Unit&, int) const { return 0; }
};

template <class Epi, class Sched, bool ALIGN_EPI = true, bool SP2 = true>
__device__ __forceinline__ void gemm_phase(LAS unsigned char* lds, const int K, const Sched& S, const Epi& E) {
    const int tid = threadIdx.x, wid = __builtin_amdgcn_readfirstlane(tid >> 6), lane = tid & 63, wr = wid >> 2, wc = wid & 3, fr = lane & 15, fq = lane >> 4;
    const int nt = K / BK;
    unsigned voffA[2], voffB[2]; int RA[2];
#pragma unroll
    for (int i = 0; i < 2; ++i) { int R, C; stage_rc(tid * 16 + i * 8192, R, C); const int Rb = Epi::PERM ? ((R & ~31) + perm32(R & 31)) : R;
        voffA[i] = Sched::GATHER ? (unsigned)(C * 2) : (unsigned)(R * K + C) * 2u; voffB[i] = (unsigned)(Rb * K + C) * 2u; RA[i] = R; }
    const size_t kstep = (size_t)(BK * 2);
    const size_t hstep = (size_t)HALF * K * 2;
    const size_t hstepA = Sched::GATHER ? 0 : hstep;
    const unsigned ldsw = (unsigned)wid * 1024u;
    const int aoff = lds_byte(wr * 64 + fr, fq * 8), boff = lds_byte(wc * 32 + fr, fq * 8);
#define PG8_SA(b, h) (((b) * 2 + (h)) * HTB)
#define PG8_SB(b, h) ((4 + (b) * 2 + (h)) * HTB)
#define PG8_STAGE(bufoff, gbase, voff) do { _Pragma("unroll") for (int _i = 0; _i < 2; ++_i) \
        __builtin_amdgcn_global_load_lds((const unsigned*)((const char*)(gbase) + (voff)[_i]), (LAS unsigned*)(lds + (bufoff) + ldsw + _i * 8192), 16, 0, 0); } while (0)
#define PG8_LDA(dst, b, h) do { _Pragma("unroll") for (int m = 0; m < 4; ++m) _Pragma("unroll") for (int k = 0; k < 2; ++k) dst[m][k] = *(const LAS bf16x8*)(lds + PG8_SA(b, h) + aoff + m * 2048 + k * 1024); } while (0)
#define PG8_LDB(dst, b, h) do { _Pragma("unroll") for (int n = 0; n < 2; ++n) _Pragma("unroll") for (int k = 0; k < 2; ++k) dst[n][k] = *(const LAS bf16x8*)(lds + PG8_SB(b, h) + boff + n * 2048 + k * 1024); } while (0)
#define PG8_MMA(ai, bj, At, Bt) do { __builtin_amdgcn_s_setprio(1); _Pragma("unroll") for (int m = 0; m < 4; ++m) _Pragma("unroll") for (int n = 0; n < 2; ++n) _Pragma("unroll") for (int k = 0; k < 2; ++k) \
        acc[ai][bj][m][n] = __builtin_amdgcn_mfma_f32_16x16x32_bf16(Bt[n][k], At[m][k], acc[ai][bj][m][n], 0, 0, 0); __builtin_amdgcn_s_setprio(0); } while (0)
#define PG8_WAIT_V(n) asm volatile("s_waitcnt vmcnt(" #n ")" ::: "memory")
#define PG8_WAIT_L(n) asm volatile("s_waitcnt lgkmcnt(" #n ")" ::: "memory")
#define PG8_BAR __builtin_amdgcn_s_barrier()
#define PG8_SCHED __builtin_amdgcn_sched_barrier(0)
    Unit cur, nxt; int ui = 0;
    if (!S.next(0, cur)) return;
    f32x4 acc[2][2][4][2];
#pragma unroll
    for (int a = 0; a < 2; ++a)
#pragma unroll
        for (int b = 0; b < 2; ++b)
#pragma unroll
            for (int m = 0; m < 4; ++m)
#pragma unroll
                for (int n = 0; n < 2; ++n) acc[a][b][m][n] = (f32x4){0.f, 0.f, 0.f, 0.f};
    bf16x8 At[4][2], B0[2][2], B1[2][2];
    const char* cA = S.a_ptr(cur); const char* cB = S.b_ptr(cur);
    unsigned gC0[2], gC1[2], gN0[2], gN1[2];
#pragma unroll
    for (int i = 0; i < 2; ++i) {
        if constexpr (Sched::GATHER) { gC0[i] = voffA[i] + (unsigned)S.a_row(cur, RA[i]) * (unsigned)(K * 2); gC1[i] = voffA[i] + (unsigned)S.a_row(cur, HALF + RA[i]) * (unsigned)(K * 2); }
        else { gC0[i] = voffA[i]; gC1[i] = voffA[i]; }
        gN0[i] = gC0[i]; gN1[i] = gC1[i];
    }
    if constexpr (SP2) {
        PG8_STAGE(PG8_SB(0, 0), cB, voffB); PG8_STAGE(PG8_SB(0, 1), cB + hstep, voffB); PG8_STAGE(PG8_SA(0, 0), cA, gC0); PG8_STAGE(PG8_SA(0, 1), cA + hstepA, gC1);
        if (wr == 1) PG8_BAR;
        PG8_WAIT_V(2); PG8_BAR;
        PG8_STAGE(PG8_SB(1, 0), cB + kstep, voffB); PG8_STAGE(PG8_SA(1, 0), cA + kstep, gC0); PG8_STAGE(PG8_SB(1, 1), cB + hstep + kstep, voffB);
        PG8_WAIT_V(6); PG8_BAR;
    } else {
        PG8_STAGE(PG8_SB(0, 0), cB, voffB); PG8_STAGE(PG8_SA(0, 0), cA, gC0); PG8_STAGE(PG8_SB(0, 1), cB + hstep, voffB); PG8_STAGE(PG8_SA(0, 1), cA + hstepA, gC1);
        if (wr == 1) PG8_BAR;
        PG8_WAIT_V(4); PG8_BAR;
        PG8_STAGE(PG8_SB(1, 0), cB + kstep, voffB); PG8_STAGE(PG8_SA(1, 0), cA + kstep, gC0); PG8_STAGE(PG8_SB(1, 1), cB + hstep + kstep, voffB);
        PG8_WAIT_V(6); PG8_BAR;
    }
    for (;;) {
        const bool has_next = S.next(ui + 1, nxt);
        const char* nA = has_next ? S.a_ptr(nxt) : cA; const char* nB = has_next ? S.b_ptr(nxt) : cB;
        if constexpr (Sched::GATHER) {
#pragma unroll
            for (int i = 0; i < 2; ++i) {
                if (has_next) { gN0[i] = voffA[i] + (unsigned)S.a_row(nxt, RA[i]) * (unsigned)(K * 2); gN1[i] = voffA[i] + (unsigned)S.a_row(nxt, HALF + RA[i]) * (unsigned)(K * 2); }
                else { gN0[i] = gC0[i]; gN1[i] = gC1[i]; }
            }
        }
        for (int t = 0; t < nt; t += 2) {
            const bool last = (t == nt - 2);
            const char* a1 = cA + (size_t)(t + 1) * kstep;
            const char* a2 = last ? nA : cA + (size_t)(t + 2) * kstep; const char* b2 = last ? nB : cB + (size_t)(t + 2) * kstep;
            const char* a3 = a2 + kstep; const char* b3 = b2 + kstep;
            unsigned s0[2], s1[2];
#pragma unroll
            for (int i = 0; i < 2; ++i) { if constexpr (Sched::GATHER) { s0[i] = last ? gN0[i] : gC0[i]; s1[i] = last ? gN1[i] : gC1[i]; } else { s0[i] = gC0[i]; s1[i] = gC1[i]; } }
            if constexpr (SP2) {
            PG8_LDB(B0, 0, 0); PG8_LDB(B1, 0, 1); PG8_SCHED; PG8_LDA(At, 0, 0); PG8_STAGE(PG8_SA(1, 1), a1 + hstepA, gC1);
            PG8_WAIT_V(8); PG8_WAIT_L(0); PG8_BAR; PG8_MMA(0, 0, At, B0); PG8_MMA(0, 1, At, B1); PG8_BAR; PG8_SCHED;
            PG8_LDA(At, 0, 1); PG8_STAGE(PG8_SB(0, 0), b2, voffB); PG8_STAGE(PG8_SB(0, 1), b2 + hstep, voffB); PG8_STAGE(PG8_SA(0, 0), a2, s0);
            PG8_WAIT_V(8); PG8_WAIT_L(0); PG8_BAR; PG8_MMA(1, 0, At, B0); PG8_MMA(1, 1, At, B1); PG8_BAR; PG8_SCHED;
            PG8_LDB(B0, 1, 0); PG8_LDB(B1, 1, 1); PG8_SCHED; PG8_LDA(At, 1, 0); PG8_STAGE(PG8_SA(0, 1), a2 + hstepA, s1);
            PG8_WAIT_V(8); PG8_WAIT_L(0); PG8_BAR; PG8_MMA(0, 0, At, B0); PG8_MMA(0, 1, At, B1); PG8_BAR; PG8_SCHED;
            PG8_LDA(At, 1, 1); PG8_STAGE(PG8_SB(1, 0), b3, voffB); PG8_STAGE(PG8_SB(1, 1), b3 + hstep, voffB); PG8_STAGE(PG8_SA(1, 0), a3, s0);
            PG8_WAIT_V(8); PG8_WAIT_L(0); PG8_BAR; PG8_MMA(1, 0, At, B0); PG8_MMA(1, 1, At, B1); PG8_BAR; PG8_SCHED;
            } else {
            PG8_LDB(B0, 0, 0); PG8_SCHED; PG8_LDA(At, 0, 0); PG8_STAGE(PG8_SA(1, 1), a1 + hstepA, gC1);
            PG8_WAIT_L(8); PG8_BAR; PG8_WAIT_L(0); PG8_MMA(0, 0, At, B0); PG8_BAR; PG8_SCHED;
            PG8_LDB(B1, 0, 1); PG8_STAGE(PG8_SB(0, 0), b2, voffB);
            PG8_BAR; PG8_WAIT_L(0); PG8_MMA(0, 1, At, B1); PG8_BAR;
            PG8_LDA(At, 0, 1); PG8_STAGE(PG8_SA(0, 0), a2, s0);
            PG8_BAR; PG8_WAIT_L(0); PG8_MMA(1, 0, At, B0); PG8_BAR; PG8_SCHED;
            PG8_STAGE(PG8_SB(0, 1), b2 + hstep, voffB);
            PG8_WAIT_V(6); PG8_BAR; PG8_MMA(1, 1, At, B1); PG8_BAR;
            PG8_LDB(B0, 1, 0); PG8_SCHED; PG8_LDA(At, 1, 0); PG8_STAGE(PG8_SA(0, 1), a2 + hstepA, s1);
            PG8_WAIT_L(8); PG8_BAR; PG8_WAIT_L(0); PG8_MMA(0, 0, At, B0); PG8_BAR; PG8_SCHED;
            PG8_LDB(B1, 1, 1); PG8_STAGE(PG8_SB(1, 0), b3, voffB);
            PG8_BAR; PG8_WAIT_L(0); PG8_MMA(0, 1, At, B1); PG8_BAR;
            PG8_LDA(At, 1, 1); PG8_STAGE(PG8_SA(1, 0), a3, s0);
            PG8_BAR; PG8_WAIT_L(0); PG8_MMA(1, 0, At, B0); PG8_BAR; PG8_SCHED;
            PG8_STAGE(PG8_SB(1, 1), b3 + hstep, voffB);
            PG8_WAIT_V(6); PG8_BAR; PG8_MMA(1, 1, At, B1); PG8_BAR;
            }
        }
        if constexpr (ALIGN_EPI) { if (wr == 0) PG8_BAR; }
        E(acc, cur, wr, wc, fr, fq);
        if (!has_next) break;
#pragma unroll
        for (int a = 0; a < 2; ++a)
#pragma unroll
            for (int b = 0; b < 2; ++b)
#pragma unroll
                for (int m = 0; m < 4; ++m)
#pragma unroll
                    for (int n = 0; n < 2; ++n) acc[a][b][m][n] = (f32x4){0.f, 0.f, 0.f, 0.f};
        cur = nxt; cA = nA; cB = nB; ++ui;
#pragma unroll
        for (int i = 0; i < 2; ++i) { gC0[i] = gN0[i]; gC1[i] = gN1[i]; }
        if constexpr (ALIGN_EPI) { if (wr == 1) PG8_BAR; }
    }
    PG8_WAIT_V(0);
    if constexpr (!ALIGN_EPI) { if (wr == 0) PG8_BAR; }
    PG8_BAR;
#undef PG8_SA
#undef PG8_SB
#undef PG8_STAGE
#undef PG8_LDA
#undef PG8_LDB
#undef PG8_MMA
#undef PG8_WAIT_V
#undef PG8_WAIT_L
#undef PG8_BAR
#undef PG8_SCHED
}

struct EpiBf16 {
    static constexpr bool PERM = true;
    bf16_t* O; int ldc;
    __device__ __forceinline__ void operator()(const f32x4 (&acc)[2][2][4][2], const Unit& u, int wr, int wc, int fr, int fq) const {
        const int row0 = u.pm * BM + wr * 64 + fr, col0 = u.pn * BM + wc * 32 + 8 * fq;
#pragma unroll
        for (int ai = 0; ai < 2; ++ai)
#pragma unroll
            for (int m = 0; m < 4; ++m) { bf16_t* rowp = O + (size_t)(row0 + ai * HALF + m * 16) * ldc + col0;
#pragma unroll
                for (int bj = 0; bj < 2; ++bj) { const f32x4 v0 = acc[ai][bj][m][0], v1 = acc[ai][bj][m][1];
                    u32x4 w; w.x = cvt_pk_bf16(v0[0], v0[1]); w.y = cvt_pk_bf16(v0[2], v0[3]); w.z = cvt_pk_bf16(v1[0], v1[1]); w.w = cvt_pk_bf16(v1[2], v1[3]);
                    *(u32x4*)(rowp + bj * HALF) = w; } }
    }
};
struct EpiResF32 {
    static constexpr bool PERM = false;
    const float* base; float* C; int ldc;
    __device__ __forceinline__ void operator()(const f32x4 (&acc)[2][2][4][2], const Unit& u, int wr, int wc, int fr, int fq) const {
        const int row0 = u.pm * BM + wr * 64 + fr, col0 = u.pn * BM + wc * 32 + 4 * fq;
#pragma unroll
        for (int ai = 0; ai < 2; ++ai)
#pragma unroll
            for (int m = 0; m < 4; ++m) { const size_t off = (size_t)(row0 + ai * HALF + m * 16) * ldc + col0;
#pragma unroll
                for (int bj = 0; bj < 2; ++bj)
#pragma unroll
                    for (int n = 0; n < 2; ++n) *(f32x4*)(C + off + bj * HALF + n * 16) = *(const f32x4*)(base + off + bj * HALF + n * 16) + acc[ai][bj][m][n]; }
    }
};
}
constexpr int NWAVES = 8, NTHREADS = 512;
constexpr int LDS_BYTES = 147456;
constexpr int NPHASES = 10;

constexpr size_t WS_WINT = WS_END;
constexpr size_t WS_WST = WS_WINT + 24 * MiB;
constexpr size_t WS_WOUTT = WS_WST + 1 * MiB;
constexpr size_t WS_END2 = WS_WOUTT + 8 * MiB;

struct MkArgs {
    const float* in[22]; float* out; unsigned char* ws; int ph_lo, ph_hi;
};

__device__ __forceinline__ float wave_sum(float v) {
#pragma unroll
    for (int o = 1; o < 64; o <<= 1) v += __shfl_xor(v, o);
    return v;
}

__device__ __forceinline__ void transpose_item(const float* __restrict__ W, int ldw, int k0, int colA, int colB, bf16_t* __restrict__ WT, int Kdst, int drow0, LAS float* scr, int lane) {
    const int j = lane & 31; const int sc = j < 16 ? colA + j : colB + j - 16;
#pragma unroll 8
    for (int i = 0; i < 32; ++i) { const int kk = 2 * i + (lane >> 5); scr[kk * 33 + j] = W[(size_t)(k0 + kk) * ldw + sc]; }
    LDS_WAIT();
    const int c = lane & 7;
#pragma unroll
    for (int jj = 0; jj < 4; ++jj) { const int n = (lane >> 3) + 8 * jj; const LAS float* s = scr + (8 * c) * 33 + n;
        u32x4 o; o.x = cvt_pk_bf16(s[0 * 33], s[1 * 33]); o.y = cvt_pk_bf16(s[2 * 33], s[3 * 33]); o.z = cvt_pk_bf16(s[4 * 33], s[5 * 33]); o.w = cvt_pk_bf16(s[6 * 33], s[7 * 33]);
        *(u32x4*)(WT + (size_t)(drow0 + n) * Kdst + k0 + 8 * c) = o; }
    LDS_WAIT();
}

__device__ __forceinline__ void rms_row_to_bf16(const float* __restrict__ xrow, const float* __restrict__ w, bf16_t* __restrict__ orow, int lane) {
    const f32x4* xr = (const f32x4*)xrow + lane; const f32x4* wr = (const f32x4*)w + lane;
    f32x4 v[8]; float s = 0.f;
#pragma unroll
    for (int j = 0; j < 8; ++j) { v[j] = xr[64 * j]; s += (v[j].x * v[j].x + v[j].y * v[j].y) + (v[j].z * v[j].z + v[j].w * v[j].w); }
    const float r = rsqrtf(wave_sum(s) * (1.f / DM) + EPS);
    u32x2* o8 = (u32x2*)orow + lane;
#pragma unroll
    for (int j = 0; j < 8; ++j) { const f32x4 ww = wr[64 * j]; u32x2 o; o.x = cvt_pk_bf16(v[j].x * r * ww.x, v[j].y * r * ww.y); o.y = cvt_pk_bf16(v[j].z * r * ww.z, v[j].w * r * ww.w); o8[64 * j] = o; }
}

__device__ __forceinline__ void phase0(const MkArgs& a, LAS unsigned char* lds, int wave, int lane) {
    unsigned char* ws = a.ws;
    LAS float* scr = (LAS float*)(lds + wave * 16384);
    const int gw = blockIdx.x * NWAVES + wave, NGW = gridDim.x * NWAVES;
    bf16_t* WinT = (bf16_t*)(ws + WS_WINT); bf16_t* WsT = (bf16_t*)(ws + WS_WST); bf16_t* WoutT = (bf16_t*)(ws + WS_WOUTT);
    constexpr int I_IN = 32 * 192, I_S = 32, I_OUT = 32 * 64, NITEMS = I_IN + I_S + I_OUT;
    for (int it = gw; it < NITEMS; it += NGW) {
        int r = it;
        if (r < I_IN) { const int kb = r / 192, nb = r % 192, n0 = nb * 32; const int sc = win_col(n0); transpose_item(a.in[2], IN_DIM, kb * 64, sc, sc + 16, WinT, DM, n0, scr, lane); continue; } r -= I_IN;
        if (r < I_S) { transpose_item(a.in[2], IN_DIM, r * 64, WI_GK, WI_DT, WsT, DM, 0, scr, lane); continue; } r -= I_S;
        { const int kb = r / 64, nb = r % 64; transpose_item(a.in[12], DM, kb * 64, nb * 32, nb * 32 + 16, WoutT, DM, nb * 32, scr, lane); }
    }
    bf16_t* hA = (bf16_t*)(ws + WS_HA);
    for (int m = gw; m < T_TOK; m += NGW) rms_row_to_bf16(a.in[0] + (size_t)m * DM, a.in[1], hA + (size_t)m * DM, lane);
}

__device__ __forceinline__ void skinny32_phase(const bf16_t* __restrict__ A, const bf16_t* __restrict__ BsT, float* __restrict__ out, LAS unsigned char* lds, int wave, int lane) {
    const int fr = lane & 15, fq = lane >> 4, mi = wave & 3, kh = wave >> 2;
    LAS f32x4* red = (LAS f32x4*)lds;
    for (int mt = blockIdx.x; mt < T_TOK / 64; mt += gridDim.x) {
        const bf16_t* ap = A + (size_t)(mt * 64 + mi * 16 + fr) * DM + kh * 1024 + fq * 8;
        const bf16_t* bp0 = BsT + (size_t)fr * DM + kh * 1024 + fq * 8;
        const bf16_t* bp1 = bp0 + (size_t)16 * DM;
        f32x4 acc0 = {0.f, 0.f, 0.f, 0.f}, acc1 = {0.f, 0.f, 0.f, 0.f};
#pragma unroll 8
        for (int ks = 0; ks < 32; ++ks) {
            const bf16x8 av = *(const bf16x8*)(ap + ks * 32), b0 = *(const bf16x8*)(bp0 + ks * 32), b1 = *(const bf16x8*)(bp1 + ks * 32);
            acc0 = __builtin_amdgcn_mfma_f32_16x16x32_bf16(av, b0, acc0, 0, 0, 0);
            acc1 = __builtin_amdgcn_mfma_f32_16x16x32_bf16(av, b1, acc1, 0, 0, 0);
        }
        if (kh == 1) { red[(mi * 2 + 0) * 64 + lane] = acc0; red[(mi * 2 + 1) * 64 + lane] = acc1; }
        __syncthreads();
        if (kh == 0) {
            acc0 += red[(mi * 2 + 0) * 64 + lane]; acc1 += red[(mi * 2 + 1) * 64 + lane];
#pragma unroll
            for (int j = 0; j < 4; ++j) { float* o = out + (size_t)(mt * 64 + mi * 16 + 4 * fq + j) * 32; o[fr] = acc0[j]; o[16 + fr] = acc1[j]; }
        }
        __syncthreads();
    }
}

__device__ __forceinline__ void phase1(const MkArgs& a, LAS unsigned char* lds, int wave, int lane) {
    unsigned char* ws = a.ws;
    const bf16_t* hA = (const bf16_t*)(ws + WS_HA);
    skinny32_phase(hA, (const bf16_t*)(ws + WS_WST), (float*)(ws + WS_SMALL), lds, wave, lane);
    pg8::StaticOrder S; S.init(hA, (const bf16_t*)(ws + WS_WINT), T_TOK, PJ, DM, gridDim.x, blockIdx.x);
    pg8::EpiBf16 E{(bf16_t*)(ws + WS_PROJ), PJ};
    pg8::gemm_phase<pg8::EpiBf16, pg8::StaticOrder>(lds, DM, S, E);
}

__device__ __forceinline__ void phase5(const MkArgs& a, LAS unsigned char* lds, float* x1) {
    unsigned char* ws = a.ws;
    pg8::StaticOrder S; S.init((const bf16_t*)(ws + WS_HA), (const bf16_t*)(ws + WS_WOUTT), T_TOK, DM, DM, gridDim.x, blockIdx.x);
    pg8::EpiResF32 E{a.in[0], x1, DM};
    pg8::gemm_phase<pg8::EpiResF32, pg8::StaticOrder>(lds, DM, S, E);
}

__global__ void __launch_bounds__(NTHREADS, 2) mk_fwd(MkArgs a) {
    extern __shared__ __attribute__((aligned(16))) unsigned char lds_raw[];
    LAS unsigned char* lds = (LAS unsigned char*)lds_raw;
    const int tid = threadIdx.x, lane = tid & 63, wave = __builtin_amdgcn_readfirstlane(tid >> 6);
    const int lo = a.ph_lo, hi = a.ph_hi;
#define IN(k) (lo <= (k) && (k) < hi)
#define SEAM(k) do { if (IN(k) && IN((k) + 1)) { cg::this_grid().sync(); } } while (0)
    if (IN(0)) { phase0(a, lds, wave, lane); }
    SEAM(0);
    if (IN(1)) { phase1(a, lds, wave, lane); }
    SEAM(1);
    if (IN(5)) { phase5(a, lds, (float*)(a.ws + WS_PROJ)); }
#undef IN
#undef SEAM
}
static int g_grid = 0;
static void launch_mk(MkArgs a, int lo, int hi, hipStream_t stream) {
    if (g_grid == 0) {
        int dev = 0, cus = 0, per_cu = 0;
        hipGetDevice(&dev);
        hipDeviceGetAttribute(&cus, hipDeviceAttributeMultiprocessorCount, dev);
        hipFuncSetAttribute((const void*)mk_fwd, hipFuncAttributeMaxDynamicSharedMemorySize, LDS_BYTES);
        hipOccupancyMaxActiveBlocksPerMultiprocessor(&per_cu, (const void*)mk_fwd, NTHREADS, LDS_BYTES);
        if (per_cu < 1) { fprintf(stderr, "kernel_launch: occupancy query says %d blocks/CU\n", per_cu); per_cu = 1; }
        g_grid = cus * per_cu;
        fprintf(stderr, "kernel_launch: grid %d (%d CUs x %d)\n", g_grid, cus, per_cu);
    }
    a.ph_lo = lo; a.ph_hi = hi;
    void* args[] = {&a};
    hipError_t e = hipLaunchCooperativeKernel((const void*)mk_fwd, dim3(g_grid), dim3(NTHREADS), args, LDS_BYTES, stream);
    if (e != hipSuccess) fprintf(stderr, "cooperative launch failed: %s (grid %d)\n", hipGetErrorString(e), g_grid);
}

extern "C" void kernel_launch(void* const* d_in, const int* in_sizes, int n_in, void* d_out, int out_size, void* d_ws, size_t ws_size, hipStream_t stream) {
    if (ws_size < WS_END2) { fprintf(stderr, "kernel_launch: workspace too small: %zu < %zu\n", ws_size, (size_t)WS_END2); return; }
    const float* x = (const float*)d_in[0];
    const float* w_gk_up = (const float*)d_in[3];
    const float* b_gk = (const float*)d_in[4];
    const float* w_gla_norm = (const float*)d_in[5];
    const float* w_conv = (const float*)d_in[6];
    const float* b_conv = (const float*)d_in[7];
    const float* dt_bias = (const float*)d_in[8];
    const float* a_log = (const float*)d_in[9];
    const float* d_skip = (const float*)d_in[10];
    const float* w_ssd_norm = (const float*)d_in[11];
    const float* w_norm_ffn = (const float*)d_in[13];
    const float* w_rg = (const float*)d_in[14];
    const float* b_rg = (const float*)d_in[15];
    const float* w_re = (const float*)d_in[16];
    const float* b_re = (const float*)d_in[17];
    const float* w_gate = (const float*)d_in[18];
    const float* w_up = (const float*)d_in[19];
    const float* w_down = (const float*)d_in[20];
    const float* w_final = (const float*)d_in[21];
    char* ws = (char*)d_ws;
    float* out = (float*)d_out;
    int* cnt = (int*)(ws + WS_CTL);
    float* small = (float*)(ws + WS_SMALL);
    int* tok_e = (int*)(ws + WS_TOKE);
    float* tok_w = (float*)(ws + WS_TOKW);
    int* list = (int*)(ws + WS_LIST);
    bf16_t* hA = (bf16_t*)(ws + WS_HA);
    bf16_t* proj = (bf16_t*)(ws + WS_PROJ);
    bf16_t* ybuf = (bf16_t*)(ws + WS_Y);
    bf16_t* hmid = (bf16_t*)(ws + WS_HMID);
    bf16_t* mix = hA;
    bf16_t* h2 = hA;
    float* x1 = (float*)(ws + WS_PROJ);
    float* oy = out;
    MkArgs a{};
    for (int i = 0; i < 22; ++i) a.in[i] = (const float*)d_in[i];
    a.out = out; a.ws = (unsigned char*)d_ws;

    (void)hipMemsetAsync(ws + WS_CTL, 0, 65536, stream);
    launch_mk(a, 0, 2, stream);
    n_gla_rec<<<dim3(8, 4, NB), 256, 0, stream>>>(proj, small, w_gk_up, b_gk, oy);
    n_ssd_rec<<<dim3(16, NB), 256, 0, stream>>>(proj, small, w_conv, b_conv, dt_bias, a_log, d_skip, oy);
    n_gla_out<<<T_TOK, 256, 0, stream>>>(oy, proj, w_gla_norm, mix);
    n_ssd_out<<<T_TOK, 256, 0, stream>>>(oy, proj, w_ssd_norm, mix);
    launch_mk(a, 5, 6, stream);
    n_router<<<T_TOK, 256, 0, stream>>>(x1, w_norm_ffn, w_rg, b_rg, w_re, b_re, h2, tok_e, tok_w, cnt, list);
    n_moe_up<<<dim3(8, 256, 32), 256, 0, stream>>>(h2, w_gate, w_up, cnt, list, hmid, nullptr);
    n_moe_down<<<dim3(32, 256, 32), 256, 0, stream>>>(hmid, w_down, cnt, list, ybuf);
    n_final<<<T_TOK, 256, 0, stream>>>(x1, ybuf, tok_w, w_final, out);
}
```

```cpp
#include <hip/hip_runtime.h>
#include <cstdio>
#include <cstdint>

typedef unsigned short bf16_t;

constexpr int T_TOK = 16384, SEQ = 4096, NB = 4, DM = 2048;
constexpr int IN_DIM = 6176;
constexpr int PJ = 6144;
constexpr int PQ = 0, PK = 512, PV = 1024, PG = 2048, PZ = 3072, PX = 4096, PB = 5120, PC = 5632;
constexpr int WI_GK = 3072, WI_Z = 3088, WI_XBC = 4112, WI_DT = 6160;
constexpr int NEXP = 32, DEXP = 512;
constexpr float EPS = 1e-6f;

__device__ __forceinline__ float bf2f(bf16_t b) { return __uint_as_float(((unsigned)b) << 16); }
__device__ __forceinline__ bf16_t f2bf(float f) { unsigned u = __float_as_uint(f); u += 0x7FFFu + ((u >> 16) & 1u); return (bf16_t)(u >> 16); }
__device__ __forceinline__ float siluf(float v) { return v / (1.f + __expf(-v)); }
__device__ __forceinline__ float softplusf(float v) { return v > 20.f ? v : log1pf(__expf(v)); }
__device__ __forceinline__ float logsigmoidf(float v) { return fminf(v, 0.f) - log1pf(__expf(-fabsf(v))); }
__device__ __forceinline__ int win_col(int j) { return j < 3072 ? j : (j < 4096 ? j - 3072 + WI_Z : j - 4096 + WI_XBC); }
__device__ __forceinline__ int win_col_small(int j) { return j < 16 ? WI_GK + j : WI_DT + (j - 16); }

constexpr size_t MiB = 1024 * 1024;
constexpr size_t WS_CTL = 0;
constexpr size_t WS_BAR = 65536;
constexpr size_t WS_SMALL = 1 * MiB;
constexpr size_t WS_TOKE = WS_SMALL + 2 * MiB;
constexpr size_t WS_TOKW = WS_TOKE + MiB / 8;
constexpr size_t WS_LIST = WS_TOKW + MiB / 8;
constexpr size_t WS_RSTD = 6 * MiB;
constexpr size_t WS_WRT = 7 * MiB;
constexpr size_t WS_HA = 8 * MiB;
constexpr size_t WS_PROJ = WS_HA + 64 * MiB;
constexpr size_t WS_SCR = WS_PROJ + 192 * MiB;
constexpr size_t WS_Y = WS_SCR;
constexpr size_t WS_HMID = WS_SCR + 128 * MiB;
constexpr size_t WS_QT = WS_SCR;
constexpr size_t WS_KT = WS_QT + 16 * MiB;
constexpr size_t WS_GS = WS_KT + 16 * MiB;
constexpr size_t WS_GDEC = WS_GS + 64 * MiB;
constexpr size_t WS_XC = WS_GDEC + 1 * MiB;
constexpr size_t WS_BC = WS_XC + 32 * MiB;
constexpr size_t WS_CC = WS_BC + 16 * MiB;
constexpr size_t WS_SS = WS_CC + 16 * MiB;
constexpr size_t WS_DT = WS_SS + 32 * MiB;
constexpr size_t WS_ACS = WS_DT + 1 * MiB;
static_assert(WS_ACS + 1 * MiB <= WS_SCR + 200 * MiB, "mixer scratch");
constexpr size_t WS_WINT = WS_SCR + 200 * MiB;
constexpr size_t WS_WST = WS_WINT + 24 * MiB;
constexpr size_t WS_WOUTT = WS_WST + 1 * MiB;
constexpr size_t WS_END = WS_WOUTT + 8 * MiB;
constexpr size_t WS_WGUT = WS_PROJ;
constexpr size_t WS_WDT = WS_PROJ + 128 * MiB;

__global__ void __launch_bounds__(256) n_rmsnorm_bf16(const float* __restrict__ x, const float* __restrict__ w, bf16_t* __restrict__ out) {
    __shared__ float red[4];
    const int t = blockIdx.x, tid = threadIdx.x;
    const float* xr = x + (size_t)t * DM;
    float v[8]; float s = 0.f;
    for (int i = 0; i < 8; ++i) { v[i] = xr[tid + i * 256]; s += v[i] * v[i]; }
    for (int o = 32; o > 0; o >>= 1) s += __shfl_xor(s, o);
    if ((tid & 63) == 0) red[tid >> 6] = s;
    __syncthreads();
    s = red[0] + red[1] + red[2] + red[3];
    const float r = rsqrtf(s / DM + EPS);
    for (int i = 0; i < 8; ++i) out[(size_t)t * DM + tid + i * 256] = f2bf(v[i] * r * w[tid + i * 256]);
}

template <class AL, class BL, class EP>
__device__ __forceinline__ void ngemm_tile(int m0, int n0, int K, AL aload, BL bload, EP epi) {
    __shared__ float As[16][65], Bs[16][65];
    const int tid = threadIdx.x, tx = tid & 15, ty = tid >> 4;
    float acc[4][4];
    for (int i = 0; i < 4; ++i) for (int j = 0; j < 4; ++j) acc[i][j] = 0.f;
    for (int k0 = 0; k0 < K; k0 += 16) {
        for (int i = 0; i < 4; ++i) { const int idx = tid + i * 256; const int r = idx >> 4, kk = idx & 15; As[kk][r] = aload(m0 + r, k0 + kk); }
        for (int i = 0; i < 4; ++i) { const int idx = tid + i * 256; const int kk = idx >> 6, c = idx & 63; Bs[kk][c] = bload(k0 + kk, n0 + c); }
        __syncthreads();
#pragma unroll
        for (int kk = 0; kk < 16; ++kk) {
            float a[4], b[4];
            for (int i = 0; i < 4; ++i) a[i] = As[kk][ty * 4 + i];
            for (int j = 0; j < 4; ++j) b[j] = Bs[kk][tx * 4 + j];
            for (int i = 0; i < 4; ++i) for (int j = 0; j < 4; ++j) acc[i][j] += a[i] * b[j];
        }
        __syncthreads();
    }
    for (int i = 0; i < 4; ++i) for (int j = 0; j < 4; ++j) epi(m0 + ty * 4 + i, n0 + tx * 4 + j, acc[i][j]);
}

__global__ void __launch_bounds__(256) n_inproj(const bf16_t* __restrict__ hA, const float* __restrict__ w_in, bf16_t* __restrict__ proj, float* __restrict__ small) {
    const int nt = blockIdx.x, m0 = blockIdx.y * 64;
    auto al = [&](int m, int k) { return bf2f(hA[(size_t)m * DM + k]); };
    if (nt < 96) {
        auto bl = [&](int k, int n) { return w_in[(size_t)k * IN_DIM + win_col(n)]; };
        auto ep = [&](int m, int n, float v) { proj[(size_t)m * PJ + n] = f2bf(v); };
        ngemm_tile(m0, nt * 64, DM, al, bl, ep);
    } else {
        auto bl = [&](int k, int n) { return n < 32 ? w_in[(size_t)k * IN_DIM + win_col_small(n)] : 0.f; };
        auto ep = [&](int m, int n, float v) { if (n < 32) small[(size_t)m * 32 + n] = v; };
        ngemm_tile(m0, 0, DM, al, bl, ep);
    }
}

__global__ void __launch_bounds__(256) n_gla_rec(const bf16_t* __restrict__ proj, const float* __restrict__ small, const float* __restrict__ w_gk_up,
                                                 const float* __restrict__ b_gk, float* __restrict__ o  ) {
    __shared__ float sq[128], sk[128], sa[128], sv[32], red[8][32];
    const int es = blockIdx.x, h = blockIdx.y, b = blockIdx.z, tid = threadIdx.x;
    const int dg = tid >> 5, e = tid & 31;
    float st[16];
    for (int i = 0; i < 16; ++i) st[i] = 0.f;
    const float scale = 0.08838834764831845f;
    for (int s = 0; s < SEQ; ++s) {
        const size_t t = (size_t)b * SEQ + s;
        if (tid < 128) {
            const int d = tid;
            float g = b_gk[h * 128 + d];
            for (int r = 0; r < 16; ++r) g += small[t * 32 + r] * w_gk_up[r * 512 + h * 128 + d];
            sa[d] = __expf(logsigmoidf(g) * (1.f / 16.f));
            sq[d] = bf2f(proj[t * PJ + PQ + h * 128 + d]) * scale;
            sk[d] = bf2f(proj[t * PJ + PK + h * 128 + d]);
        } else if (tid < 160) {
            sv[tid - 128] = bf2f(proj[t * PJ + PV + h * 256 + es * 32 + (tid - 128)]);
        }
        __syncthreads();
        float part = 0.f; const float v = sv[e];
#pragma unroll
        for (int i = 0; i < 16; ++i) { const int d = dg * 16 + i; st[i] = st[i] * sa[d] + sk[d] * v; part += sq[d] * st[i]; }
        red[dg][e] = part;
        __syncthreads();
        if (tid < 32) { float a = 0.f; for (int i = 0; i < 8; ++i) a += red[i][tid]; o[t * DM + h * 256 + es * 32 + tid] = a; }
        __syncthreads();
    }
}

__global__ void __launch_bounds__(256) n_gla_out(const float* __restrict__ o, const bf16_t* __restrict__ proj, const float* __restrict__ w_gla_norm, bf16_t* __restrict__ mix) {
    __shared__ float red[4];
    const int t = blockIdx.x, tid = threadIdx.x;
    for (int h = 0; h < 4; ++h) {
        const float v = o[(size_t)t * DM + h * 256 + tid];
        float s = v * v;
        for (int of = 32; of > 0; of >>= 1) s += __shfl_xor(s, of);
        __syncthreads();
        if ((tid & 63) == 0) red[tid >> 6] = s;
        __syncthreads();
        s = red[0] + red[1] + red[2] + red[3];
        const float r = rsqrtf(s / 256.f + EPS);
        const float g = bf2f(proj[(size_t)t * PJ + PG + h * 256 + tid]);
        mix[(size_t)t * DM + h * 256 + tid] = f2bf(v * r * w_gla_norm[tid] * siluf(g));
    }
}

__global__ void __launch_bounds__(256) n_ssd_rec(const bf16_t* __restrict__ proj, const float* __restrict__ small, const float* __restrict__ w_conv, const float* __restrict__ b_conv,
                                                 const float* __restrict__ dt_bias, const float* __restrict__ a_log, const float* __restrict__ d_skip, float* __restrict__ y  ) {
    __shared__ float sx[64], sB[128], sC[128];
    const int head = blockIdx.x, b = blockIdx.y, tid = threadIdx.x, g = head >> 2;
    const int p = tid >> 2, ng = tid & 3;
    float st[32];
    for (int i = 0; i < 32; ++i) st[i] = 0.f;
    const float a = -__expf(a_log[head]), dsk = d_skip[head], dtb = dt_bias[head];
    for (int s = 0; s < SEQ; ++s) {
        const size_t t = (size_t)b * SEQ + s;
        for (int c = tid; c < 320; c += 256) {
            const int ch = c < 64 ? head * 64 + c : (c < 192 ? 1024 + g * 128 + (c - 64) : 1536 + g * 128 + (c - 192));
            float acc = b_conv[ch];
            for (int k = 0; k < 4; ++k) { const int ss = s - 3 + k; if (ss >= 0) acc += w_conv[k * 2048 + ch] * bf2f(proj[((size_t)b * SEQ + ss) * PJ + PX + ch]); }
            acc = siluf(acc);
            if (c < 64) sx[c] = acc; else if (c < 192) sB[c - 64] = acc; else sC[c - 192] = acc;
        }
        __syncthreads();
        const float dt = softplusf(small[t * 32 + 16 + head] + dtb);
        const float dA = __expf(dt * a);
        const float xv = sx[p], xdt = xv * dt;
        float part = 0.f;
#pragma unroll
        for (int i = 0; i < 32; ++i) { const int n = ng * 32 + i; st[i] = st[i] * dA + xdt * sB[n]; part += sC[n] * st[i]; }
        part += __shfl_xor(part, 1); part += __shfl_xor(part, 2);
        if (ng == 0) y[t * DM + 1024 + head * 64 + p] = part + dsk * xv;
        __syncthreads();
    }
}

__global__ void __launch_bounds__(256) n_ssd_out(const float* __restrict__ y, const bf16_t* __restrict__ proj, const float* __restrict__ w_ssd_norm, bf16_t* __restrict__ mix) {
    __shared__ float red[4];
    const int t = blockIdx.x, tid = threadIdx.x;
    for (int g = 0; g < 4; ++g) {
        const int c = g * 256 + tid;
        const float v = y[(size_t)t * DM + 1024 + c] * siluf(bf2f(proj[(size_t)t * PJ + PZ + c]));
        float s = v * v;
        for (int of = 32; of > 0; of >>= 1) s += __shfl_xor(s, of);
        __syncthreads();
        if ((tid & 63) == 0) red[tid >> 6] = s;
        __syncthreads();
        s = red[0] + red[1] + red[2] + red[3];
        const float r = rsqrtf(s / 256.f + EPS);
        mix[(size_t)t * DM + 1024 + c] = f2bf(v * r * w_ssd_norm[c]);
    }
}

__global__ void __launch_bounds__(256) n_outproj(const bf16_t* __restrict__ mix, const float* __restrict__ w_out, const float* __restrict__ x, float* __restrict__ x1) {
    auto al = [&](int m, int k) { return bf2f(mix[(size_t)m * DM + k]); };
    auto bl = [&](int k, int n) { return w_out[(size_t)k * DM + n]; };
    auto ep = [&](int m, int n, float v) { x1[(size_t)m * DM + n] = x[(size_t)m * DM + n] + v; };
    ngemm_tile(blockIdx.y * 64, blockIdx.x * 64, DM, al, bl, ep);
}

__global__ void __launch_bounds__(256) n_router(const float* __restrict__ x1, const float* __restrict__ w_norm, const float* __restrict__ w_rg, const float* __restrict__ b_rg,
                                                const float* __restrict__ w_re, const float* __restrict__ b_re, bf16_t* __restrict__ h2, int* __restrict__ tok_e, float* __restrict__ tok_w,
                                                int* __restrict__ cnt, int* __restrict__ list) {
    __shared__ float red[4][36]; __shared__ float sred[4];
    const int t = blockIdx.x, tid = threadIdx.x;
    float v[8]; float s = 0.f;
    for (int i = 0; i < 8; ++i) { v[i] = x1[(size_t)t * DM + tid + i * 256]; s += v[i] * v[i]; }
    for (int o = 32; o > 0; o >>= 1) s += __shfl_xor(s, o);
    if ((tid & 63) == 0) sred[tid >> 6] = s;
    __syncthreads();
    s = sred[0] + sred[1] + sred[2] + sred[3];
    const float r = rsqrtf(s / DM + EPS);
    float lg[36];
    for (int j = 0; j < 36; ++j) lg[j] = 0.f;
    for (int i = 0; i < 8; ++i) {
        const int k = tid + i * 256; const float hv = v[i] * r * w_norm[k];
        h2[(size_t)t * DM + k] = f2bf(hv);
        for (int j = 0; j < 4; ++j) lg[j] += hv * w_rg[k * 4 + j];
        for (int j = 0; j < 32; ++j) lg[4 + j] += hv * w_re[k * 32 + j];
    }
    for (int j = 0; j < 36; ++j) { float a = lg[j]; for (int o = 32; o > 0; o >>= 1) a += __shfl_xor(a, o); if ((tid & 63) == 0) red[tid >> 6][j] = a; }
    __syncthreads();
    if (tid == 0) {
        float gl[4]; int gi = 0; float gm = -1e30f;
        for (int j = 0; j < 4; ++j) { gl[j] = red[0][j] + red[1][j] + red[2][j] + red[3][j] + b_rg[j]; if (gl[j] > gm) { gm = gl[j]; gi = j; } }
        float gs = 0.f; for (int j = 0; j < 4; ++j) gs += __expf(gl[j] - gm);
        const float gw = 1.f / gs;
        float el[8]; int i0 = 0; float m0 = -1e30f;
        for (int j = 0; j < 8; ++j) { const int c = 4 + gi * 8 + j; el[j] = red[0][c] + red[1][c] + red[2][c] + red[3][c] + b_re[gi * 8 + j]; if (el[j] > m0) { m0 = el[j]; i0 = j; } }
        int i1 = -1; float m1 = -1e30f;
        for (int j = 0; j < 8; ++j) if (j != i0 && el[j] > m1) { m1 = el[j]; i1 = j; }
        const float e1 = __expf(m1 - m0);
        const float w0 = gw / (1.f + e1), w1 = gw * e1 / (1.f + e1);
        const int ex0 = gi * 8 + i0, ex1 = gi * 8 + i1;
        tok_e[t * 2] = ex0; tok_e[t * 2 + 1] = ex1; tok_w[t * 2] = w0; tok_w[t * 2 + 1] = w1;
        int p0 = atomicAdd(&cnt[ex0], 1); list[ex0 * T_TOK + p0] = t * 2;
        int p1 = atomicAdd(&cnt[ex1], 1); list[ex1 * T_TOK + p1] = t * 2 + 1;
    }
}

__device__ __forceinline__ int moe_off(const int* cnt, int e) { int o = 0; for (int i = 0; i < e; ++i) o += (cnt[i] + 255) & ~255; return o; }

__global__ void __launch_bounds__(256) n_moe_up(const bf16_t* __restrict__ h2, const float* __restrict__ w_gate, const float* __restrict__ w_up, const int* __restrict__ cnt,
                                                const int* __restrict__ list, bf16_t* __restrict__ hmid, float* __restrict__ tmp  ) {
    const int e = blockIdx.z, m0 = blockIdx.y * 64, n0 = blockIdx.x * 64, ne = cnt[e];
    if (m0 >= ne) return;
    const int off = moe_off(cnt, e);
    const int* le = list + (size_t)e * T_TOK;
    __shared__ float gsave[64][65];
    auto al = [&](int m, int k) { return m < ne ? bf2f(h2[(size_t)(le[m] >> 1) * DM + k]) : 0.f; };
    auto blg = [&](int k, int n) { return w_gate[((size_t)e * DM + k) * DEXP + n]; };
    auto blu = [&](int k, int n) { return w_up[((size_t)e * DM + k) * DEXP + n]; };
    auto epg = [&](int m, int n, float v) { gsave[m - m0][n - n0] = v; };
    ngemm_tile(m0, n0, DM, al, blg, epg);
    auto epu = [&](int m, int n, float v) { if (m < ne) hmid[(size_t)(off + m) * DEXP + n] = f2bf(siluf(gsave[m - m0][n - n0]) * v); };
    ngemm_tile(m0, n0, DM, al, blu, epu);
}

__global__ void __launch_bounds__(256) n_moe_down(const bf16_t* __restrict__ hmid, const float* __restrict__ w_down, const int* __restrict__ cnt, const int* __restrict__ list, bf16_t* __restrict__ y) {
    const int e = blockIdx.z, m0 = blockIdx.y * 64, n0 = blockIdx.x * 64, ne = cnt[e];
    if (m0 >= ne) return;
    const int off = moe_off(cnt, e);
    const int* le = list + (size_t)e * T_TOK;
    auto al = [&](int m, int k) { return m < ne ? bf2f(hmid[(size_t)(off + m) * DEXP + k]) : 0.f; };
    auto bl = [&](int k, int n) { return w_down[((size_t)e * DEXP + k) * DM + n]; };
    auto ep = [&](int m, int n, float v) { if (m < ne) y[(size_t)le[m] * DM + n] = f2bf(v); };
    ngemm_tile(m0, n0, DEXP, al, bl, ep);
}

__global__ void __launch_bounds__(256) n_final(const float* __restrict__ x1, const bf16_t* __restrict__ y, const float* __restrict__ tok_w, const float* __restrict__ w, float* __restrict__ out) {
    __shared__ float red[4];
    const int t = blockIdx.x, tid = threadIdx.x;
    const float w0 = tok_w[t * 2], w1 = tok_w[t * 2 + 1];
    float v[8]; float s = 0.f;
    for (int i = 0; i < 8; ++i) { const int k = tid + i * 256;
        v[i] = x1[(size_t)t * DM + k] + w0 * bf2f(y[((size_t)t * 2) * DM + k]) + w1 * bf2f(y[((size_t)t * 2 + 1) * DM + k]); s += v[i] * v[i]; }
    for (int o = 32; o > 0; o >>= 1) s += __shfl_xor(s, o);
    if ((tid & 63) == 0) red[tid >> 6] = s;
    __syncthreads();
    s = red[0] + red[1] + red[2] + red[3];
    const float r = rsqrtf(s / DM + EPS);
    for (int i = 0; i < 8; ++i) { const int k = tid + i * 256; out[(size_t)t * DM + k] = v[i] * r * w[k]; }
}

#include <hip/hip_cooperative_groups.h>
namespace cg = cooperative_groups;
#define LAS __attribute__((address_space(3)))
#define GAS __attribute__((address_space(1)))
typedef short bf16x8 __attribute__((ext_vector_type(8)));
typedef float f32x4 __attribute__((ext_vector_type(4)));
typedef float f32x2 __attribute__((ext_vector_type(2)));
typedef unsigned u32x4 __attribute__((ext_vector_type(4)));
typedef unsigned u32x2 __attribute__((ext_vector_type(2)));
#define LDS_WAIT() asm volatile("s_waitcnt lgkmcnt(0)" ::: "memory")
#define VM_WAIT() asm volatile("s_waitcnt vmcnt(0)" ::: "memory")
typedef __bf16 bf16x2_t __attribute__((ext_vector_type(2)));
__device__ __forceinline__ unsigned cvt_pk_bf16(float lo, float hi) { f32x2 f = {lo, hi}; bf16x2_t v = __builtin_convertvector(f, bf16x2_t); return __builtin_bit_cast(unsigned, v); }

namespace pg8 {
constexpr int BM = 256, BK = 64, HALF = 128, HTB = HALF * BK * 2, STAGE_BYTES = 8 * HTB, NXCD = 8, WGM = 8;
__host__ __device__ __forceinline__ int lds_byte(int r, int c) { const int st = (r >> 4) * 2 + (c >> 5), rr = r & 15, cc = c & 31, ob = rr * 64 + cc * 2; return st * 1024 + (ob ^ (((ob >> 9) & 1) << 5)); }
__host__ __device__ __forceinline__ void stage_rc(int b, int& R, int& C) { const int st = b / 1024, sb = b % 1024, swz = sb ^ (((sb >> 9) & 1) << 5); R = (st >> 1) * 16 + swz / 64; C = (st & 1) * 32 + (swz % 64) / 2; }
__host__ __device__ __forceinline__ int perm32(int rho) { const int n = rho >> 4, i = rho & 15; return 8 * (i >> 2) + 4 * n + (i & 3); }

struct Unit { int pm, pn, e, row0, ne; };

struct StaticOrder {
    static constexpr bool GATHER = false;
    const char* A; const char* Bt; size_t tstep;
    int nM, nN, nwg, G, c;
    __device__ void init(const bf16_t* A_, const bf16_t* Bt_, int M, int N, int K, int G_, int c_) { A = (const char*)A_; Bt = (const char*)Bt_; tstep = (size_t)BM * K * 2; nM = M / BM; nN = N / BM; nwg = nM * nN; G = G_; c = c_; }
    __device__ bool next(int i, Unit& u) const {
        const long L = (long)i * G + c; if (L >= nwg) return false;
        int wgid = (int)L; { const int q = nwg / NXCD, r = nwg % NXCD, xcd = wgid % NXCD, off = wgid / NXCD; wgid = (xcd < r ? xcd * (q + 1) : r * (q + 1) + (xcd - r) * q) + off; }
        const int nig = WGM * nN, gid = wgid / nig, fm = gid * WGM, gsz = (nM - fm) < WGM ? (nM - fm) : WGM;
        u.pm = fm + ((wgid % nig) % gsz); u.pn = (wgid % nig) / gsz; u.e = 0; u.row0 = 0; u.ne = 0; return true;
    }
    __device__ __forceinline__ const char* a_ptr(const Unit& u) const { return A + (size_t)u.pm * tstep; }
    __device__ __forceinline__ const char* b_ptr(const Unit& u) const { return Bt + (size_t)u.pn * tstep; }
    __device__ __forceinline__ int a_row(const Unit&, int) const { return 0; }
};

template <class Epi, class Sched, bool ALIGN_EPI = true, bool SP2 = true>
__device__ __forceinline__ void gemm_phase(LAS unsigned char* lds, const int K, const Sched& S, const Epi& E) {
    const int tid = threadIdx.x, wid = __builtin_amdgcn_readfirstlane(tid >> 6), lane = tid & 63, wr = wid >> 2, wc = wid & 3, fr = lane & 15, fq = lane >> 4;
    const int nt = K / BK;
    unsigned voffA[2], voffB[2]; int RA[2];
#pragma unroll
    for (int i = 0; i < 2; ++i) { int R, C; stage_rc(tid * 16 + i * 8192, R, C); const int Rb = Epi::PERM ? ((R & ~31) + perm32(R & 31)) : R;
        voffA[i] = Sched::GATHER ? (unsigned)(C * 2) : (unsigned)(R * K + C) * 2u; voffB[i] = (unsigned)(Rb * K + C) * 2u; RA[i] = R; }
    const size_t kstep = (size_t)(BK * 2);
    const size_t hstep = (size_t)HALF * K * 2;
    const size_t hstepA = Sched::GATHER ? 0 : hstep;
    const unsigned ldsw = (unsigned)wid * 1024u;
    const int aoff = lds_byte(wr * 64 + fr, fq * 8), boff = lds_byte(wc * 32 + fr, fq * 8);
#define PG8_SA(b, h) (((b) * 2 + (h)) * HTB)
#define PG8_SB(b, h) ((4 + (b) * 2 + (h)) * HTB)
#define PG8_STAGE(bufoff, gbase, voff) do { _Pragma("unroll") for (int _i = 0; _i < 2; ++_i) \
        __builtin_amdgcn_global_load_lds((const unsigned*)((const char*)(gbase) + (voff)[_i]), (LAS unsigned*)(lds + (bufoff) + ldsw + _i * 8192), 16, 0, 0); } while (0)
#define PG8_LDA(dst, b, h) do { _Pragma("unroll") for (int m = 0; m < 4; ++m) _Pragma("unroll") for (int k = 0; k < 2; ++k) dst[m][k] = *(const LAS bf16x8*)(lds + PG8_SA(b, h) + aoff + m * 2048 + k * 1024); } while (0)
#define PG8_LDB(dst, b, h) do { _Pragma("unroll") for (int n = 0; n < 2; ++n) _Pragma("unroll") for (int k = 0; k < 2; ++k) dst[n][k] = *(const LAS bf16x8*)(lds + PG8_SB(b, h) + boff + n * 2048 + k * 1024); } while (0)
#define PG8_MMA(ai, bj, At, Bt) do { __builtin_amdgcn_s_setprio(1); _Pragma("unroll") for (int m = 0; m < 4; ++m) _Pragma("unroll") for (int n = 0; n < 2; ++n) _Pragma("unroll") for (int k = 0; k < 2; ++k) \
        acc[ai][bj][m][n] = __builtin_amdgcn_mfma_f32_16x16x32_bf16(Bt[n][k], At[m][k], acc[ai][bj][m][n], 0, 0, 0); __builtin_amdgcn_s_setprio(0); } while (0)
#define PG8_WAIT_V(n) asm volatile("s_waitcnt vmcnt(" #n ")" ::: "memory")
#define PG8_WAIT_L(n) asm volatile("s_waitcnt lgkmcnt(" #n ")" ::: "memory")
#define PG8_BAR __builtin_amdgcn_s_barrier()
#define PG8_SCHED __builtin_amdgcn_sched_barrier(0)
    Unit cur, nxt; int ui = 0;
    if (!S.next(0, cur)) return;
    f32x4 acc[2][2][4][2];
#pragma unroll
    for (int a = 0; a < 2; ++a)
#pragma unroll
        for (int b = 0; b < 2; ++b)
#pragma unroll
            for (int m = 0; m < 4; ++m)
#pragma unroll
                for (int n = 0; n < 2; ++n) acc[a][b][m][n] = (f32x4){0.f, 0.f, 0.f, 0.f};
    bf16x8 At[4][2], B0[2][2], B1[2][2];
    const char* cA = S.a_ptr(cur); const char* cB = S.b_ptr(cur);
    unsigned gC0[2], gC1[2], gN0[2], gN1[2];
#pragma unroll
    for (int i = 0; i < 2; ++i) {
        if constexpr (Sched::GATHER) { gC0[i] = voffA[i] + (unsigned)S.a_row(cur, RA[i]) * (unsigned)(K * 2); gC1[i] = voffA[i] + (unsigned)S.a_row(cur, HALF + RA[i]) * (unsigned)(K * 2); }
        else { gC0[i] = voffA[i]; gC1[i] = voffA[i]; }
        gN0[i] = gC0[i]; gN1[i] = gC1[i];
    }
    if constexpr (SP2) {
        PG8_STAGE(PG8_SB(0, 0), cB, voffB); PG8_STAGE(PG8_SB(0, 1), cB + hstep, voffB); PG8_STAGE(PG8_SA(0, 0), cA, gC0); PG8_STAGE(PG8_SA(0, 1), cA + hstepA, gC1);
        if (wr == 1) PG8_BAR;
        PG8_WAIT_V(2); PG8_BAR;
        PG8_STAGE(PG8_SB(1, 0), cB + kstep, voffB); PG8_STAGE(PG8_SA(1, 0), cA + kstep, gC0); PG8_STAGE(PG8_SB(1, 1), cB + hstep + kstep, voffB);
        PG8_WAIT_V(6); PG8_BAR;
    } else {
        PG8_STAGE(PG8_SB(0, 0), cB, voffB); PG8_STAGE(PG8_SA(0, 0), cA, gC0); PG8_STAGE(PG8_SB(0, 1), cB + hstep, voffB); PG8_STAGE(PG8_SA(0, 1), cA + hstepA, gC1);
        if (wr == 1) PG8_BAR;
        PG8_WAIT_V(4); PG8_BAR;
        PG8_STAGE(PG8_SB(1, 0), cB + kstep, voffB); PG8_STAGE(PG8_SA(1, 0), cA + kstep, gC0); PG8_STAGE(PG8_SB(1, 1), cB + hstep + kstep, voffB);
        PG8_WAIT_V(6); PG8_BAR;
    }
    for (;;) {
        const bool has_next = S.next(ui + 1, nxt);
        const char* nA = has_next ? S.a_ptr(nxt) : cA; const char* nB = has_next ? S.b_ptr(nxt) : cB;
        if constexpr (Sched::GATHER) {
#pragma unroll
            for (int i = 0; i < 2; ++i) {
                if (has_next) { gN0[i] = voffA[i] + (unsigned)S.a_row(nxt, RA[i]) * (unsigned)(K * 2); gN1[i] = voffA[i] + (unsigned)S.a_row(nxt, HALF + RA[i]) * (unsigned)(K * 2); }
                else { gN0[i] = gC0[i]; gN1[i] = gC1[i]; }
            }
        }
        for (int t = 0; t < nt; t += 2) {
            const bool last = (t == nt - 2);
            const char* a1 = cA + (size_t)(t + 1) * kstep;
            const char* a2 = last ? nA : cA + (size_t)(t + 2) * kstep; const char* b2 = last ? nB : cB + (size_t)(t + 2) * kstep;
            const char* a3 = a2 + kstep; const char* b3 = b2 + kstep;
            unsigned s0[2], s1[2];
#pragma unroll
            for (int i = 0; i < 2; ++i) { if constexpr (Sched::GATHER) { s0[i] = last ? gN0[i] : gC0[i]; s1[i] = last ? gN1[i] : gC1[i]; } else { s0[i] = gC0[i]; s1[i] = gC1[i]; } }
            if constexpr (SP2) {
            PG8_LDB(B0, 0, 0); PG8_LDB(B1, 0, 1); PG8_SCHED; PG8_LDA(At, 0, 0); PG8_STAGE(PG8_SA(1, 1), a1 + hstepA, gC1);
            PG8_WAIT_V(8); PG8_WAIT_L(0); PG8_BAR; PG8_MMA(0, 0, At, B0); PG8_MMA(0, 1, At, B1); PG8_BAR; PG8_SCHED;
            PG8_LDA(At, 0, 1); PG8_STAGE(PG8_SB(0, 0), b2, voffB); PG8_STAGE(PG8_SB(0, 1), b2 + hstep, voffB); PG8_STAGE(PG8_SA(0, 0), a2, s0);
            PG8_WAIT_V(8); PG8_WAIT_L(0); PG8_BAR; PG8_MMA(1, 0, At, B0); PG8_MMA(1, 1, At, B1); PG8_BAR; PG8_SCHED;
            PG8_LDB(B0, 1, 0); PG8_LDB(B1, 1, 1); PG8_SCHED; PG8_LDA(At, 1, 0); PG8_STAGE(PG8_SA(0, 1), a2 + hstepA, s1);
            PG8_WAIT_V(8); PG8_WAIT_L(0); PG8_BAR; PG8_MMA(0, 0, At, B0); PG8_MMA(0, 1, At, B1); PG8_BAR; PG8_SCHED;
            PG8_LDA(At, 1, 1); PG8_STAGE(PG8_SB(1, 0), b3, voffB); PG8_STAGE(PG8_SB(1, 1), b3 + hstep, voffB); PG8_STAGE(PG8_SA(1, 0), a3, s0);
            PG8_WAIT_V(8); PG8_WAIT_L(0); PG8_BAR; PG8_MMA(1, 0, At, B0); PG8_MMA(1, 1, At, B1); PG8_BAR; PG8_SCHED;
            } else {
            PG8_LDB(B0, 0, 0); PG8_SCHED; PG8_LDA(At, 0, 0); PG8_STAGE(PG8_SA(1, 1), a1 + hstepA, gC1);
            PG8_WAIT_L(8); PG8_BAR; PG8_WAIT_L(0); PG8_MMA(0, 0, At, B0); PG8_BAR; PG8_SCHED;
            PG8_LDB(B1, 0, 1); PG8_STAGE(PG8_SB(0, 0), b2, voffB);
            PG8_BAR; PG8_WAIT_L(0); PG8_MMA(0, 1, At, B1); PG8_BAR;
            PG8_LDA(At, 0, 1); PG8_STAGE(PG8_SA(0, 0), a2, s0);
            PG8_BAR; PG8_WAIT_L(0); PG8_MMA(1, 0, At, B0); PG8_BAR; PG8_SCHED;
            PG8_STAGE(PG8_SB(0, 1), b2 + hstep, voffB);
            PG8_WAIT_V(6); PG8_BAR; PG8_MMA(1, 1, At, B1); PG8_BAR;
            PG8_LDB(B0, 1, 0); PG8_SCHED; PG8_LDA(At, 1, 0); PG8_STAGE(PG8_SA(0, 1), a2 + hstepA, s1);
            PG8_WAIT_L(8); PG8_BAR; PG8_WAIT_L(0); PG8_MMA(0, 0, At, B0); PG8_BAR; PG8_SCHED;
            PG8_LDB(B1, 1, 1); PG8_STAGE(PG8_SB(1, 0), b3, voffB);
            PG8_BAR; PG8_WAIT_L(0); PG8_MMA(0, 1, At, B1); PG8_BAR;
            PG8_LDA(At, 1, 1); PG8_STAGE(PG8_SA(1, 0), a3, s0);
            PG8_BAR; PG8_WAIT_L(0); PG8_MMA(1, 0, At, B0); PG8_BAR; PG8_SCHED;
            PG8_STAGE(PG8_SB(1, 1), b3 + hstep, voffB);
            PG8_WAIT_V(6); PG8_BAR; PG8_MMA(1, 1, At, B1); PG8_BAR;
            }
        }
        if constexpr (ALIGN_EPI) { if (wr == 0) PG8_BAR; }
        E(acc, cur, wr, wc, fr, fq);
        if (!has_next) break;
#pragma unroll
        for (int a = 0; a < 2; ++a)
#pragma unroll
            for (int b = 0; b < 2; ++b)
#pragma unroll
                for (int m = 0; m < 4; ++m)
#pragma unroll
                    for (int n = 0; n < 2; ++n) acc[a][b][m][n] = (f32x4){0.f, 0.f, 0.f, 0.f};
        cur = nxt; cA = nA; cB = nB; ++ui;
#pragma unroll
        for (int i = 0; i < 2; ++i) { gC0[i] = gN0[i]; gC1[i] = gN1[i]; }
        if constexpr (ALIGN_EPI) { if (wr == 1) PG8_BAR; }
    }
    PG8_WAIT_V(0);
    if constexpr (!ALIGN_EPI) { if (wr == 0) PG8_BAR; }
    PG8_BAR;
#undef PG8_SA
#undef PG8_SB
#undef PG8_STAGE
#undef PG8_LDA
#undef PG8_LDB
#undef PG8_MMA
#undef PG8_WAIT_V
#undef PG8_WAIT_L
#undef PG8_BAR
#undef PG8_SCHED
}

struct EpiBf16 {
    static constexpr bool PERM = true;
    bf16_t* O; int ldc;
    __device__ __forceinline__ void operator()(const f32x4 (&acc)[2][2][4][2], const Unit& u, int wr, int wc, int fr, int fq) const {
        const int row0 = u.pm * BM + wr * 64 + fr, col0 = u.pn * BM + wc * 32 + 8 * fq;
#pragma unroll
        for (int ai = 0; ai < 2; ++ai)
#pragma unroll
            for (int m = 0; m < 4; ++m) { bf16_t* rowp = O + (size_t)(row0 + ai * HALF + m * 16) * ldc + col0;
#pragma unroll
                for (int bj = 0; bj < 2; ++bj) { const f32x4 v0 = acc[ai][bj][m][0], v1 = acc[ai][bj][m][1];
                    u32x4 w; w.x = cvt_pk_bf16(v0[0], v0[1]); w.y = cvt_pk_bf16(v0[2], v0[3]); w.z = cvt_pk_bf16(v1[0], v1[1]); w.w = cvt_pk_bf16(v1[2], v1[3]);
                    *(u32x4*)(rowp + bj * HALF) = w; } }
    }
};
struct EpiResF32 {
    static constexpr bool PERM = false;
    const float* base; float* C; int ldc;
    __device__ __forceinline__ void operator()(const f32x4 (&acc)[2][2][4][2], const Unit& u, int wr, int wc, int fr, int fq) const {
        const int row0 = u.pm * BM + wr * 64 + fr, col0 = u.pn * BM + wc * 32 + 4 * fq;
#pragma unroll
        for (int ai = 0; ai < 2; ++ai)
#pragma unroll
            for (int m = 0; m < 4; ++m) { const size_t off = (size_t)(row0 + ai * HALF + m * 16) * ldc + col0;
#pragma unroll
                for (int bj = 0; bj < 2; ++bj)
#pragma unroll
                    for (int n = 0; n < 2; ++n) *(f32x4*)(C + off + bj * HALF + n * 16) = *(const f32x4*)(base + off + bj * HALF + n * 16) + acc[ai][bj][m][n]; }
    }
};
}
#define RLX_AGENT __ATOMIC_RELAXED, __HIP_MEMORY_SCOPE_AGENT
#define XB_TMO      128
#define XB_XCNT(j)  (256  + 64 * (j))
#define XB_XSUB(j)  (1280 + 64 * (j))
#define XB_XGEN(j)  (2304 + 64 * (j))
#define XB_TOP      3328
#define XB_TOPGEN   3392
#define XCD_BAR_WORDS 3456
#define XB_SPIN_CAP (1u << 18)

__device__ __forceinline__ unsigned xb_ld(unsigned* p)              { return __hip_atomic_load(p, __ATOMIC_RELAXED, __HIP_MEMORY_SCOPE_AGENT); }
__device__ __forceinline__ unsigned xb_add(unsigned* p, unsigned v) { return __hip_atomic_fetch_add(p, v, __ATOMIC_RELAXED, __HIP_MEMORY_SCOPE_AGENT); }
__device__ __forceinline__ unsigned xb_xcc_id() { return (unsigned)__builtin_amdgcn_s_getreg((3 << 11) | 20) & 0xFu; }
#define XB_SPIN(cond, bar) do { unsigned _sp = 0; while (cond) { __builtin_amdgcn_s_sleep(1); \
    if ((++_sp & 255u) == 0u) { if (xb_ld(&(bar)[XB_TMO])) break; if (_sp > XB_SPIN_CAP) { atomicAdd(&(bar)[XB_TMO], 1u); break; } } } } while (0)

struct XcdBarrier {
    unsigned* bar; unsigned x;
    volatile LAS unsigned* st;
};

__device__ __forceinline__ XcdBarrier xcd_barrier_post(unsigned* bar, volatile LAS unsigned* st) {
    XcdBarrier b; b.bar = bar; b.x = xb_xcc_id(); b.st = st;
    if (threadIdx.x == 0) (void)xb_add(&bar[XB_XCNT(b.x)], 1u);
    return b;
}
__device__ __forceinline__ void xcd_barrier_complete(unsigned* bar, unsigned x, unsigned& nloc, unsigned& nx) {
    const unsigned G = gridDim.x * gridDim.y * gridDim.z;
    unsigned sum, cnt, mine, sp = 0u;
    for (;;) {
        sum = 0u; cnt = 0u; mine = 0u;
#pragma unroll
        for (unsigned j = 0; j < 16; ++j) { const unsigned c = xb_ld(&bar[XB_XCNT(j)]); sum += c; cnt += (c > 0u) ? 1u : 0u; mine = (j == x) ? c : mine; }
        if (sum == G) break;
        __builtin_amdgcn_s_sleep(1);
        if ((++sp & 255u) == 0u) { if (xb_ld(&bar[XB_TMO])) break; if (sp > XB_SPIN_CAP) { atomicAdd(&bar[XB_TMO], 1u); break; } }
    }
    nloc = mine > 0u ? mine : 1u; nx = cnt > 0u ? cnt : 1u;
}

__device__ __forceinline__ void xcd_barrier(const XcdBarrier& b) {
    asm volatile("s_waitcnt vmcnt(0)" ::: "memory");
    __syncthreads();
    if (threadIdx.x == 0) {
        unsigned* bar = b.bar;
        __builtin_amdgcn_s_waitcnt(0);
        unsigned nloc = b.st[0], nx = b.st[1];
        if (nloc == 0u) { xcd_barrier_complete(bar, b.x, nloc, nx); b.st[0] = nloc; b.st[1] = nx; }
        const unsigned old = xb_add(&bar[XB_XSUB(b.x)], 1u);
        const unsigned gen = old / nloc;
        if (old + 1u == (gen + 1u) * nloc) {
            __builtin_amdgcn_fence(__ATOMIC_RELEASE, "agent");
            asm volatile("s_waitcnt vmcnt(0)" ::: "memory");
            const unsigned og = xb_add(&bar[XB_TOP], 1u);
            const unsigned tg = og / nx;
            if (og + 1u == (tg + 1u) * nx) xb_add(&bar[XB_TOPGEN], 1u);
            else XB_SPIN(xb_ld(&bar[XB_TOPGEN]) == tg, bar);
            __builtin_amdgcn_fence(__ATOMIC_ACQUIRE, "agent");
            xb_add(&bar[XB_XGEN(b.x)], 1u);
            asm volatile("s_waitcnt vmcnt(0)" ::: "memory");
        } else {
            XB_SPIN(xb_ld(&bar[XB_XGEN(b.x)]) == gen, bar);
            __builtin_amdgcn_fence(__ATOMIC_ACQUIRE, "agent");
            asm volatile("s_waitcnt vmcnt(0)" ::: "memory");
        }
    }
    __syncthreads();
}

constexpr int NWAVES = 8, NTHREADS = 512;
constexpr int LDS_BYTES = 147456;
constexpr int NPHASES = 10;

constexpr int LDS_TAB = 131072;

struct MkArgs {
    const float* in[22]; float* out; unsigned char* ws; int ph_lo, ph_hi, flags, li;
};

__device__ __forceinline__ float wave_sum(float v) {
#pragma unroll
    for (int o = 1; o < 64; o <<= 1) v += __shfl_xor(v, o);
    return v;
}

__device__ __forceinline__ void transpose_item(const float* __restrict__ W, int ldw, int k0, int colA, int colB, bf16_t* __restrict__ WT, int Kdst, int drow0, LAS float* scr, int lane) {
    const int j = lane & 31; const int sc = j < 16 ? colA + j : colB + j - 16;
#pragma unroll 8
    for (int i = 0; i < 32; ++i) { const int kk = 2 * i + (lane >> 5); scr[kk * 33 + j] = W[(size_t)(k0 + kk) * ldw + sc]; }
    LDS_WAIT();
    const int c = lane & 7;
#pragma unroll
    for (int jj = 0; jj < 4; ++jj) { const int n = (lane >> 3) + 8 * jj; const LAS float* s = scr + (8 * c) * 33 + n;
        u32x4 o; o.x = cvt_pk_bf16(s[0 * 33], s[1 * 33]); o.y = cvt_pk_bf16(s[2 * 33], s[3 * 33]); o.z = cvt_pk_bf16(s[4 * 33], s[5 * 33]); o.w = cvt_pk_bf16(s[6 * 33], s[7 * 33]);
        *(u32x4*)(WT + (size_t)(drow0 + n) * Kdst + k0 + 8 * c) = o; }
    LDS_WAIT();
}

__device__ __forceinline__ void rms_row_to_bf16(const float* __restrict__ xrow, const float* __restrict__ w, bf16_t* __restrict__ orow, int lane) {
    const f32x4* xr = (const f32x4*)xrow + lane; const f32x4* wr = (const f32x4*)w + lane;
    f32x4 v[8]; float s = 0.f;
#pragma unroll
    for (int j = 0; j < 8; ++j) { v[j] = xr[64 * j]; s += (v[j].x * v[j].x + v[j].y * v[j].y) + (v[j].z * v[j].z + v[j].w * v[j].w); }
    const float r = rsqrtf(wave_sum(s) * (1.f / DM) + EPS);
    u32x2* o8 = (u32x2*)orow + lane;
#pragma unroll
    for (int j = 0; j < 8; ++j) { const f32x4 ww = wr[64 * j]; u32x2 o; o.x = cvt_pk_bf16(v[j].x * r * ww.x, v[j].y * r * ww.y); o.y = cvt_pk_bf16(v[j].z * r * ww.z, v[j].w * r * ww.w); o8[64 * j] = o; }
}

__device__ __forceinline__ void phase0(const MkArgs& a, LAS unsigned char* lds, int wave, int lane) {
    unsigned char* ws = a.ws;
    LAS float* scr = (LAS float*)(lds + wave * 16384);
    const int gw = blockIdx.x * NWAVES + wave, NGW = gridDim.x * NWAVES;
    bf16_t* WinT = (bf16_t*)(ws + WS_WINT); bf16_t* WsT = (bf16_t*)(ws + WS_WST); bf16_t* WoutT = (bf16_t*)(ws + WS_WOUTT);
    constexpr int I_IN = 32 * 192, I_S = 32, I_OUT = 32 * 64, NITEMS = I_IN + I_S + I_OUT;
    for (int it = gw; it < NITEMS; it += NGW) {
        int r = it;
        if (r < I_IN) { const int kb = r / 192, nb = r % 192, n0 = nb * 32; const int sc = win_col(n0); transpose_item(a.in[2], IN_DIM, kb * 64, sc, sc + 16, WinT, DM, n0, scr, lane); continue; } r -= I_IN;
        if (r < I_S) { transpose_item(a.in[2], IN_DIM, r * 64, WI_GK, WI_DT, WsT, DM, 0, scr, lane); continue; } r -= I_S;
        { const int kb = r / 64, nb = r % 64; transpose_item(a.in[12], DM, kb * 64, nb * 32, nb * 32 + 16, WoutT, DM, nb * 32, scr, lane); }
    }
    {
        bf16_t* WrT = (bf16_t*)(ws + WS_WRT);
        for (int idx = gw * 64 + lane; idx < 48 * DM; idx += NGW * 64) { const int n = idx / DM, k = idx % DM;
            const float v = a.in[13][k] * (n < 4 ? a.in[14][k * 4 + n] : (n < 36 ? a.in[16][k * 32 + n - 4] : 0.f));
            const bf16_t hi = f2bf(v); WrT[idx] = hi; WrT[48 * DM + idx] = f2bf(v - bf2f(hi)); }
    }
    bf16_t* hA = (bf16_t*)(ws + WS_HA);
    for (int m = gw; m < T_TOK; m += NGW) rms_row_to_bf16(a.in[0] + (size_t)m * DM, a.in[1], hA + (size_t)m * DM, lane);
}

__device__ __forceinline__ void skinny32_phase(const bf16_t* __restrict__ A, const bf16_t* __restrict__ BsT, float* __restrict__ out, LAS unsigned char* lds, int wave, int lane) {
    const int fr = lane & 15, fq = lane >> 4, mi = wave & 3, kh = wave >> 2;
    LAS f32x4* red = (LAS f32x4*)lds;
    for (int mt = blockIdx.x; mt < T_TOK / 64; mt += gridDim.x) {
        const bf16_t* ap = A + (size_t)(mt * 64 + mi * 16 + fr) * DM + kh * 1024 + fq * 8;
        const bf16_t* bp0 = BsT + (size_t)fr * DM + kh * 1024 + fq * 8;
        const bf16_t* bp1 = bp0 + (size_t)16 * DM;
        f32x4 acc0 = {0.f, 0.f, 0.f, 0.f}, acc1 = {0.f, 0.f, 0.f, 0.f};
#pragma unroll 8
        for (int ks = 0; ks < 32; ++ks) {
            const bf16x8 av = *(const bf16x8*)(ap + ks * 32), b0 = *(const bf16x8*)(bp0 + ks * 32), b1 = *(const bf16x8*)(bp1 + ks * 32);
            acc0 = __builtin_amdgcn_mfma_f32_16x16x32_bf16(av, b0, acc0, 0, 0, 0);
            acc1 = __builtin_amdgcn_mfma_f32_16x16x32_bf16(av, b1, acc1, 0, 0, 0);
        }
        if (kh == 1) { red[(mi * 2 + 0) * 64 + lane] = acc0; red[(mi * 2 + 1) * 64 + lane] = acc1; }
        __syncthreads();
        if (kh == 0) {
            acc0 += red[(mi * 2 + 0) * 64 + lane]; acc1 += red[(mi * 2 + 1) * 64 + lane];
#pragma unroll
            for (int j = 0; j < 4; ++j) { float* o = out + (size_t)(mt * 64 + mi * 16 + 4 * fq + j) * 32; o[fr] = acc0[j]; o[16 + fr] = acc1[j]; }
        }
        __syncthreads();
    }
}

__device__ __forceinline__ void phase1(const MkArgs& a, LAS unsigned char* lds, int wave, int lane) {
    unsigned char* ws = a.ws;
    const bf16_t* hA = (const bf16_t*)(ws + WS_HA);
    skinny32_phase(hA, (const bf16_t*)(ws + WS_WST), (float*)(ws + WS_SMALL), lds, wave, lane);
    pg8::StaticOrder S; S.init(hA, (const bf16_t*)(ws + WS_WINT), T_TOK, PJ, DM, gridDim.x, blockIdx.x);
    pg8::EpiBf16 E{(bf16_t*)(ws + WS_PROJ), PJ};
    pg8::gemm_phase<pg8::EpiBf16, pg8::StaticOrder>(lds, DM, S, E);
}

__device__ __forceinline__ void phase5(const MkArgs& a, LAS unsigned char* lds, float* x1) {
    unsigned char* ws = a.ws;
    pg8::StaticOrder S; S.init((const bf16_t*)(ws + WS_HA), (const bf16_t*)(ws + WS_WOUTT), T_TOK, DM, DM, gridDim.x, blockIdx.x);
    pg8::EpiResF32 E{a.in[0], x1, DM};
    pg8::gemm_phase<pg8::EpiResF32, pg8::StaticOrder>(lds, DM, S, E);
}


__device__ __forceinline__ void phase6(const MkArgs& a, LAS unsigned char* lds, const float* x1, int wave, int lane) {
    unsigned char* ws = a.ws;
    const int fr = lane & 15, fq = lane >> 4, mi = wave & 3, kh = wave >> 2;
    bf16_t* h2 = (bf16_t*)(ws + WS_HA);
    const bf16_t* WrT = (const bf16_t*)(ws + WS_WRT);
    float* rstd2 = (float*)(ws + WS_RSTD);
    int* cnt = (int*)(ws + WS_CTL); int* list = (int*)(ws + WS_LIST);
    int* tok_e = (int*)(ws + WS_TOKE); float* tok_w = (float*)(ws + WS_TOKW);
    LAS f32x4* red = (LAS f32x4*)lds;
    LAS float* redss = (LAS float*)(lds + 12288);
    LAS float* lg = (LAS float*)(lds + 12288 + 256);
    LAS float* ssum = (LAS float*)(lds + 12288 + 256 + 64 * 49 * 4);
    for (int mt = blockIdx.x; mt < T_TOK / 64; mt += gridDim.x) {
        const int row = mt * 64 + mi * 16 + fr;
        const float* xp = x1 + (size_t)row * DM + kh * 1024 + fq * 8;
        const float* wn = a.in[13] + kh * 1024 + fq * 8;
        bf16_t* hp = h2 + (size_t)row * DM + kh * 1024 + fq * 8;
        const bf16_t* bp = WrT + (size_t)fr * DM + kh * 1024 + fq * 8;
        f32x4 acc[3]; for (int n = 0; n < 3; ++n) acc[n] = (f32x4){0.f, 0.f, 0.f, 0.f};
        float ss = 0.f;
#pragma unroll 4
        for (int ks = 0; ks < 32; ++ks) {
            const f32x4 xa = *(const f32x4*)(xp + ks * 32), xb = *(const f32x4*)(xp + ks * 32 + 4);
            const f32x4 wa = *(const f32x4*)(wn + ks * 32), wb = *(const f32x4*)(wn + ks * 32 + 4);
            ss += (xa.x * xa.x + xa.y * xa.y) + (xa.z * xa.z + xa.w * xa.w) + (xb.x * xb.x + xb.y * xb.y) + (xb.z * xb.z + xb.w * xb.w);
            u32x4 hu; hu.x = cvt_pk_bf16(xa.x * wa.x, xa.y * wa.y); hu.y = cvt_pk_bf16(xa.z * wa.z, xa.w * wa.w); hu.z = cvt_pk_bf16(xb.x * wb.x, xb.y * wb.y); hu.w = cvt_pk_bf16(xb.z * wb.z, xb.w * wb.w);
            *(u32x4*)(hp + ks * 32) = hu;
            u32x4 hi; hi.x = cvt_pk_bf16(xa.x, xa.y); hi.y = cvt_pk_bf16(xa.z, xa.w); hi.z = cvt_pk_bf16(xb.x, xb.y); hi.w = cvt_pk_bf16(xb.z, xb.w);
            u32x4 lo;
            lo.x = cvt_pk_bf16(xa.x - __uint_as_float(hi.x << 16), xa.y - __uint_as_float(hi.x & 0xffff0000u));
            lo.y = cvt_pk_bf16(xa.z - __uint_as_float(hi.y << 16), xa.w - __uint_as_float(hi.y & 0xffff0000u));
            lo.z = cvt_pk_bf16(xb.x - __uint_as_float(hi.z << 16), xb.y - __uint_as_float(hi.z & 0xffff0000u));
            lo.w = cvt_pk_bf16(xb.z - __uint_as_float(hi.w << 16), xb.w - __uint_as_float(hi.w & 0xffff0000u));
            const bf16x8 ah = __builtin_bit_cast(bf16x8, hi), al = __builtin_bit_cast(bf16x8, lo);
#pragma unroll
            for (int n = 0; n < 3; ++n) {
                const bf16x8 bh = *(const bf16x8*)(bp + (size_t)n * 16 * DM + ks * 32), bl = *(const bf16x8*)(bp + (size_t)(48 + n * 16) * DM + ks * 32);
                acc[n] = __builtin_amdgcn_mfma_f32_16x16x32_bf16(ah, bh, acc[n], 0, 0, 0);
                acc[n] = __builtin_amdgcn_mfma_f32_16x16x32_bf16(al, bh, acc[n], 0, 0, 0);
                acc[n] = __builtin_amdgcn_mfma_f32_16x16x32_bf16(ah, bl, acc[n], 0, 0, 0);
            }
        }
        ss += __shfl_xor(ss, 16); ss += __shfl_xor(ss, 32);
        if (kh == 1) { for (int n = 0; n < 3; ++n) red[(mi * 3 + n) * 64 + lane] = acc[n]; if (fq == 0) redss[mi * 16 + fr] = ss; }
        __syncthreads();
        if (kh == 0) {
            for (int n = 0; n < 3; ++n) { acc[n] += red[(mi * 3 + n) * 64 + lane];
#pragma unroll
                for (int j = 0; j < 4; ++j) lg[(mi * 16 + 4 * fq + j) * 49 + n * 16 + fr] = acc[n][j]; }
            if (fq == 0) ssum[mi * 16 + fr] = ss + redss[mi * 16 + fr];
        }
        __syncthreads();
        if (wave == 0) {
            const int t = mt * 64 + lane;
            const float r = rsqrtf(ssum[lane] * (1.f / DM) + EPS);
            rstd2[t] = r;
            const LAS float* l = lg + lane * 49;
            float gm = -1e30f; int gi = 0; float gl[4];
#pragma unroll
            for (int j = 0; j < 4; ++j) { gl[j] = l[j] * r + a.in[15][j]; if (gl[j] > gm) { gm = gl[j]; gi = j; } }
            float gs = 0.f;
#pragma unroll
            for (int j = 0; j < 4; ++j) gs += __expf(gl[j] - gm);
            const float gw_ = 1.f / gs;
            float m0 = -1e30f, m1 = -1e30f; int i0 = 0, i1 = 0;
            for (int j = 0; j < 8; ++j) { const float v = l[4 + gi * 8 + j] * r + a.in[17][gi * 8 + j];
                if (v > m0) { m1 = m0; i1 = i0; m0 = v; i0 = j; } else if (v > m1) { m1 = v; i1 = j; } }
            const float e1 = __expf(m1 - m0);
            const float w0 = gw_ / (1.f + e1), w1 = gw_ * e1 / (1.f + e1);
            const int ex0 = gi * 8 + i0, ex1 = gi * 8 + i1;
            tok_e[t * 2] = ex0; tok_e[t * 2 + 1] = ex1; tok_w[t * 2] = w0; tok_w[t * 2 + 1] = w1;
            const int p0 = atomicAdd(&cnt[ex0], 1); list[ex0 * T_TOK + p0] = t * 2;
            const int p1 = atomicAdd(&cnt[ex1], 1); list[ex1 * T_TOK + p1] = t * 2 + 1;
        }
        __syncthreads();
    }
    LAS float* scr = (LAS float*)(lds + 32768 + wave * 8704);
    const int gw = blockIdx.x * NWAVES + wave, NGW = gridDim.x * NWAVES;
    bf16_t* WguT = (bf16_t*)(ws + WS_WGUT); bf16_t* WdT = (bf16_t*)(ws + WS_WDT);
    constexpr int I_G = 32 * 32 * 16, I_D = 32 * 8 * 64;
    for (int it = gw; it < 2 * I_G + I_D; it += NGW) {
        int r = it;
        if (r < 2 * I_G) { const int up = r >= I_G; if (up) r -= I_G; const int e = r / 512, q = r % 512, kb = q / 16, nb = q % 16, n0 = nb * 32;
            const float* W = (up ? a.in[19] : a.in[18]) + (size_t)e * DM * DEXP;
            transpose_item(W, DEXP, kb * 64, n0, n0 + 16, WguT, DM, e * 1024 + (n0 >> 7) * 256 + up * 128 + (n0 & 127), scr, lane); continue; }
        r -= 2 * I_G;
        { const int e = r / 512, q = r % 512, kb = q / 64, nb = q % 64, n0 = nb * 32;
          transpose_item(a.in[20] + (size_t)e * DEXP * DM, DM, kb * 64, n0, n0 + 16, WdT, DEXP, e * DM + n0, scr, lane); }
    }
}

template <bool GATHER_T>
struct MoeOrderT {
    static constexpr bool GATHER = GATHER_T;
    const char* A; const char* Bt; const int* list; const LAS int* tab; int NT, K, G, c, nwg; size_t bstride;
    __device__ bool next(int i, pg8::Unit& u) const {
        const long L = (long)i * G + c; if (L >= nwg) return false;
        int wgid = (int)L; { const int q = nwg / 8, r = nwg % 8, xcd = wgid % 8, off = wgid / 8; wgid = (xcd < r ? xcd * (q + 1) : r * (q + 1) + (xcd - r) * q) + off; }
        int e = 0;
        for (; e < 31; ++e) { const int te = __builtin_amdgcn_readfirstlane(tab[33 + e] - tab[32 + e]); if (wgid < te * NT) break; wgid -= te * NT; }
        const int te = __builtin_amdgcn_readfirstlane(tab[33 + e] - tab[32 + e]), tp = __builtin_amdgcn_readfirstlane(tab[32 + e]);
        const int pn = wgid / te, mt = wgid % te;
        u.pm = tp + mt; u.pn = pn; u.e = e; u.row0 = mt * 256; u.ne = __builtin_amdgcn_readfirstlane(tab[e]); return true;
    }
    __device__ __forceinline__ const char* a_ptr(const pg8::Unit& u) const { return GATHER ? A : A + (size_t)u.pm * 256 * K * 2; }
    __device__ __forceinline__ const char* b_ptr(const pg8::Unit& u) const { return Bt + (size_t)u.e * bstride + (size_t)u.pn * 256 * K * 2; }
    __device__ __forceinline__ int a_row(const pg8::Unit& u, int r) const { const int rr = u.row0 + r; return rr < u.ne ? (list[(size_t)u.e * T_TOK + rr] >> 1) : 0; }
};
__device__ __forceinline__ int moe_tables(const int* cnt, LAS int* tab) {
    if (threadIdx.x < 32) tab[threadIdx.x] = __hip_atomic_load(cnt + threadIdx.x, __ATOMIC_RELAXED, __HIP_MEMORY_SCOPE_AGENT);
    __syncthreads();
    if (threadIdx.x == 0) { int p = 0; for (int e = 0; e < 32; ++e) { tab[32 + e] = p; p += (tab[e] + 255) >> 8; } tab[64] = p; }
    __syncthreads();
    return __builtin_amdgcn_readfirstlane(tab[64]);
}
struct EpiSwiGLU {
    static constexpr bool PERM = true;
    bf16_t* H; const int* list; const float* rstd;
    __device__ __forceinline__ void operator()(const f32x4 (&acc)[2][2][4][2], const pg8::Unit& u, int wr, int wc, int fr, int fq) const {
#pragma unroll
        for (int ai = 0; ai < 2; ++ai)
#pragma unroll
            for (int m = 0; m < 4; ++m) { const int rt = ai * 128 + wr * 64 + m * 16 + fr; const int rr = u.row0 + rt;
                const float rs = rr < u.ne ? rstd[list[(size_t)u.e * T_TOK + rr] >> 1] : 0.f;
                const f32x4 g0 = acc[ai][0][m][0] * rs, g1 = acc[ai][0][m][1] * rs, u0 = acc[ai][1][m][0] * rs, u1 = acc[ai][1][m][1] * rs;
                float h[8];
#pragma unroll
                for (int j = 0; j < 4; ++j) { h[j] = g0[j] / (1.f + __expf(-g0[j])) * u0[j]; h[4 + j] = g1[j] / (1.f + __expf(-g1[j])) * u1[j]; }
                u32x4 w; w.x = cvt_pk_bf16(h[0], h[1]); w.y = cvt_pk_bf16(h[2], h[3]); w.z = cvt_pk_bf16(h[4], h[5]); w.w = cvt_pk_bf16(h[6], h[7]);
                *(u32x4*)(H + (size_t)(u.pm * 256 + rt) * DEXP + u.pn * 128 + wc * 32 + 8 * fq) = w; }
    }
};
struct EpiDown {
    static constexpr bool PERM = true;
    bf16_t* Y; const int* list;
    __device__ __forceinline__ void operator()(const f32x4 (&acc)[2][2][4][2], const pg8::Unit& u, int wr, int wc, int fr, int fq) const {
#pragma unroll
        for (int ai = 0; ai < 2; ++ai)
#pragma unroll
            for (int m = 0; m < 4; ++m) { const int rr = u.row0 + ai * 128 + wr * 64 + m * 16 + fr;
                if (rr < u.ne) { const int slot = list[(size_t)u.e * T_TOK + rr]; bf16_t* rowp = Y + (size_t)slot * DM + u.pn * 256 + wc * 32 + 8 * fq;
#pragma unroll
                    for (int bj = 0; bj < 2; ++bj) { const f32x4 v0 = acc[ai][bj][m][0], v1 = acc[ai][bj][m][1];
                        u32x4 w; w.x = cvt_pk_bf16(v0[0], v0[1]); w.y = cvt_pk_bf16(v0[2], v0[3]); w.z = cvt_pk_bf16(v1[0], v1[1]); w.w = cvt_pk_bf16(v1[2], v1[3]);
                        *(u32x4*)(rowp + bj * 128) = w; } } }
    }
};
__device__ __forceinline__ void phase7(const MkArgs& a, LAS unsigned char* lds) {
    unsigned char* ws = a.ws;
    LAS int* tab = (LAS int*)(lds + LDS_TAB);
    const int tiles = moe_tables((const int*)(ws + WS_CTL), tab);
    MoeOrderT<true> S; S.A = (const char*)(ws + WS_HA); S.Bt = (const char*)(ws + WS_WGUT); S.list = (const int*)(ws + WS_LIST); S.tab = tab; S.NT = 4; S.K = DM; S.G = gridDim.x; S.c = blockIdx.x; S.nwg = tiles * 4; S.bstride = (size_t)1024 * DM * 2;
    EpiSwiGLU E{(bf16_t*)(ws + WS_HMID), (const int*)(ws + WS_LIST), (const float*)(ws + WS_RSTD)};
    pg8::gemm_phase<EpiSwiGLU, MoeOrderT<true>>(lds, DM, S, E);
}
__device__ __forceinline__ void phase8(const MkArgs& a, LAS unsigned char* lds) {
    unsigned char* ws = a.ws;
    LAS int* tab = (LAS int*)(lds + LDS_TAB);
    const int tiles = moe_tables((const int*)(ws + WS_CTL), tab);
    MoeOrderT<false> S; S.A = (const char*)(ws + WS_HMID); S.Bt = (const char*)(ws + WS_WDT); S.list = (const int*)(ws + WS_LIST); S.tab = tab; S.NT = 8; S.K = DEXP; S.G = gridDim.x; S.c = blockIdx.x; S.nwg = tiles * 8; S.bstride = (size_t)DM * DEXP * 2;
    EpiDown E{(bf16_t*)(ws + WS_Y), (const int*)(ws + WS_LIST)};
    pg8::gemm_phase<EpiDown, MoeOrderT<false>>(lds, DEXP, S, E);
}
__device__ __forceinline__ void phase9(const MkArgs& a, int wave, int lane) {
    unsigned char* ws = a.ws;
    const bf16_t* Y = (const bf16_t*)(ws + WS_Y); const float* tok_w = (const float*)(ws + WS_TOKW);
    const int gw = blockIdx.x * NWAVES + wave, NGW = gridDim.x * NWAVES;
    for (int t = gw; t < T_TOK; t += NGW) {
        const float w0 = tok_w[t * 2], w1 = tok_w[t * 2 + 1];
        f32x4* xr = (f32x4*)(a.out + (size_t)t * DM) + lane;
        const u32x2* y0 = (const u32x2*)(Y + (size_t)(t * 2) * DM) + lane; const u32x2* y1 = (const u32x2*)(Y + (size_t)(t * 2 + 1) * DM) + lane;
        const f32x4* wf = (const f32x4*)a.in[21] + lane;
        f32x4 v[8]; float s = 0.f;
#pragma unroll
        for (int j = 0; j < 8; ++j) { v[j] = xr[64 * j]; const u32x2 p = y0[64 * j], q = y1[64 * j];
            v[j].x += w0 * __uint_as_float(p.x << 16) + w1 * __uint_as_float(q.x << 16);
            v[j].y += w0 * __uint_as_float(p.x & 0xffff0000u) + w1 * __uint_as_float(q.x & 0xffff0000u);
            v[j].z += w0 * __uint_as_float(p.y << 16) + w1 * __uint_as_float(q.y << 16);
            v[j].w += w0 * __uint_as_float(p.y & 0xffff0000u) + w1 * __uint_as_float(q.y & 0xffff0000u);
            s += (v[j].x * v[j].x + v[j].y * v[j].y) + (v[j].z * v[j].z + v[j].w * v[j].w); }
        const float r = rsqrtf(wave_sum(s) * (1.f / DM) + EPS);
#pragma unroll
        for (int j = 0; j < 8; ++j) { const f32x4 ww = wf[64 * j]; xr[64 * j] = (f32x4){v[j].x * r * ww.x, v[j].y * r * ww.y, v[j].z * r * ww.z, v[j].w * r * ww.w}; }
    }
}

__device__ __forceinline__ bf16x8 ldfrag(const LAS bf16_t* base, int stride, int r0, int k0, int fr, int fq) {
    return *(const LAS bf16x8*)(base + (r0 + fr) * stride + k0 + fq * 8);
}
#define MFMA16(X, Y, C) __builtin_amdgcn_mfma_f32_16x16x32_bf16((X), (Y), (C), 0, 0, 0)
__device__ __forceinline__ u32x2 pack4(f32x4 v) { u32x2 o; o.x = cvt_pk_bf16(v[0], v[1]); o.y = cvt_pk_bf16(v[2], v[3]); return o; }
__device__ __forceinline__ float bflo(unsigned u) { return __uint_as_float(u << 16); }
__device__ __forceinline__ float bfhi(unsigned u) { return __uint_as_float(u & 0xffff0000u); }

template <class SC>
__device__ __forceinline__ void load_transposed(const bf16_t* __restrict__ src, size_t ld, int ntp, int ncol8, LAS unsigned* dst32, int dstride32, int tid, SC scale) {
    for (int u = tid; u < ntp * ncol8; u += NTHREADS) {
        const int tp = u % ntp, cg = u / ntp;
        const bf16_t* p = src + (size_t)(2 * tp) * ld + cg * 8;
        const u32x4 r0 = *(const u32x4*)p, r1 = *(const u32x4*)(p + ld);
        const float s0 = scale(2 * tp, cg), s1 = scale(2 * tp + 1, cg);
#pragma unroll
        for (int i = 0; i < 4; ++i) {
            dst32[(cg * 8 + 2 * i) * dstride32 + tp] = cvt_pk_bf16(bflo(r0[i]) * s0, bflo(r1[i]) * s1);
            dst32[(cg * 8 + 2 * i + 1) * dstride32 + tp] = cvt_pk_bf16(bfhi(r0[i]) * s0, bfhi(r1[i]) * s1);
        }
    }
}
struct NoScale { __device__ __forceinline__ float operator()(int, int) const { return 1.f; } };

__device__ __forceinline__ void gla_p2_item(const MkArgs& a, LAS unsigned char* lds, int item, int tid, int wave, int lane) {
    unsigned char* ws = a.ws;
    const int c = item & 63, bh = item >> 6, h = bh & 3, b = bh >> 2;
    const size_t t0 = (size_t)b * SEQ + c * 64;
    const bf16_t* proj = (const bf16_t*)(ws + WS_PROJ); const float* small = (const float*)(ws + WS_SMALL);
    bf16_t* QT = (bf16_t*)(ws + WS_QT); bf16_t* KT = (bf16_t*)(ws + WS_KT); bf16_t* GS = (bf16_t*)(ws + WS_GS); float* GDEC = (float*)(ws + WS_GDEC);
    LAS bf16_t* kdT = (LAS bf16_t*)(lds);
    LAS bf16_t* vT = (LAS bf16_t*)(lds + 18432);
    LAS float* gk = (LAS float*)(lds + 18432 + 36864);
    LAS float* part = (LAS float*)(lds + 18432 + 36864 + 4096);
    for (int i = tid; i < 64 * 16; i += NTHREADS) gk[i] = small[(t0 + (i >> 4)) * 32 + (i & 15)];
    load_transposed(proj + t0 * PJ + PV + h * 256, PJ, 32, 32, (LAS unsigned*)vT, 36, tid, NoScale());
    __syncthreads();
    const int d = tid & 127, tq = tid >> 7;
    float wg[16];
#pragma unroll
    for (int r = 0; r < 16; ++r) wg[r] = a.in[3][r * 512 + h * 128 + d];
    const float bias = a.in[4][h * 128 + d];
    float G[16]; float run = 0.f;
#pragma unroll
    for (int i = 0; i < 16; ++i) { const int t = tq * 16 + i; float g = bias;
#pragma unroll
        for (int r = 0; r < 16; ++r) g += gk[t * 16 + r] * wg[r];
        run += logsigmoidf(g) * (1.f / 16.f); G[i] = run; }
    part[tq * 128 + d] = run;
    __syncthreads();
    float off = 0.f, total = 0.f;
#pragma unroll
    for (int q = 0; q < 4; ++q) { const float pv = part[q * 128 + d]; total += pv; if (q < tq) off += pv; }
    const float scale = 0.08838834764831845f;
#pragma unroll
    for (int i = 0; i < 16; ++i) { const int t = tq * 16 + i; const float Gi = G[i] + off;
        const float q = bf2f(proj[(t0 + t) * PJ + PQ + h * 128 + d]), k = bf2f(proj[(t0 + t) * PJ + PK + h * 128 + d]);
        QT[(t0 + t) * 512 + h * 128 + d] = f2bf(q * scale * __expf(Gi));
        KT[(t0 + t) * 512 + h * 128 + d] = f2bf(k * __expf(-Gi));
        kdT[d * 72 + t] = f2bf(k * __expf(total - Gi)); }
    if (tq == 0) GDEC[item * 128 + d] = __expf(total);
    __syncthreads();
    const int fr = lane & 15, fq = lane >> 4;
    bf16_t* gs = GS + (size_t)item * 32768;
#pragma unroll
    for (int et = 0; et < 2; ++et) {
        const int e0 = wave * 32 + et * 16;
        const bf16x8 y0 = ldfrag(vT, 72, e0, 0, fr, fq), y1 = ldfrag(vT, 72, e0, 32, fr, fq);
#pragma unroll
        for (int dt_ = 0; dt_ < 8; ++dt_) {
            f32x4 acc = {0.f, 0.f, 0.f, 0.f};
            acc = MFMA16(ldfrag(kdT, 72, dt_ * 16, 0, fr, fq), y0, acc);
            acc = MFMA16(ldfrag(kdT, 72, dt_ * 16, 32, fr, fq), y1, acc);
            *(u32x2*)(gs + (e0 + fr) * 128 + dt_ * 16 + 4 * fq) = pack4(acc);
        }
    }
    __syncthreads();
}

__device__ __forceinline__ void scan_phase(const MkArgs& a, int flags) {
    unsigned char* ws = a.ws;
    const int u = blockIdx.x * NTHREADS + threadIdx.x, NU = gridDim.x * NTHREADS;
    if (flags & 1) {
        bf16_t* GS = (bf16_t*)(ws + WS_GS); const float* GDEC = (const float*)(ws + WS_GDEC);
        for (int v = u; v < 16 * 8192; v += NU) {
            const int bh = v >> 13, rem = v & 8191, e = rem >> 5, d0 = (rem & 31) * 4;
            f32x4 S = {0.f, 0.f, 0.f, 0.f};
            for (int c0 = 0; c0 < 64; c0 += 8) {
                u32x2 loc[8]; f32x4 dec[8];
#pragma unroll
                for (int i = 0; i < 8; ++i) { const int item = bh * 64 + c0 + i; loc[i] = *(const u32x2*)(GS + (size_t)item * 32768 + e * 128 + d0); dec[i] = *(const f32x4*)(GDEC + item * 128 + d0); }
#pragma unroll
                for (int i = 0; i < 8; ++i) { const int item = bh * 64 + c0 + i; *(u32x2*)(GS + (size_t)item * 32768 + e * 128 + d0) = pack4(S);
                    S = S * dec[i] + (f32x4){bflo(loc[i].x), bfhi(loc[i].x), bflo(loc[i].y), bfhi(loc[i].y)}; }
            }
        }
    }
    if (flags & 2) {
        bf16_t* SS = (bf16_t*)(ws + WS_SS); const float* ACS = (const float*)(ws + WS_ACS);
        for (int v = u; v < 64 * 2048; v += NU) {
            const int bhd = v >> 11, rem = v & 2047, b = bhd >> 4, head = bhd & 15;
            f32x4 S = {0.f, 0.f, 0.f, 0.f};
            for (int c0 = 0; c0 < 32; c0 += 8) {
                u32x2 loc[8]; float dec[8];
#pragma unroll
                for (int i = 0; i < 8; ++i) { const int c = c0 + i; const size_t item = ((size_t)b * 32 + c) * 16 + head; loc[i] = *(const u32x2*)(SS + item * 8192 + rem * 4);
                    dec[i] = __expf(ACS[((size_t)b * SEQ + c * 128 + 127) * 16 + head]); }
#pragma unroll
                for (int i = 0; i < 8; ++i) { const int c = c0 + i; const size_t item = ((size_t)b * 32 + c) * 16 + head; *(u32x2*)(SS + item * 8192 + rem * 4) = pack4(S);
                    S = S * dec[i] + (f32x4){bflo(loc[i].x), bfhi(loc[i].x), bflo(loc[i].y), bfhi(loc[i].y)}; }
            }
        }
    }
}

__device__ __forceinline__ void gla_p4_item(const MkArgs& a, LAS unsigned char* lds, int item, int tid, int wave, int lane) {
    unsigned char* ws = a.ws;
    const int c = item & 63, bh = item >> 6, h = bh & 3, b = bh >> 2;
    const size_t t0 = (size_t)b * SEQ + c * 64;
    const bf16_t* proj = (const bf16_t*)(ws + WS_PROJ);
    const bf16_t* QT = (const bf16_t*)(ws + WS_QT); const bf16_t* KT = (const bf16_t*)(ws + WS_KT); const bf16_t* gs = (const bf16_t*)(ws + WS_GS) + (size_t)item * 32768;
    bf16_t* mix = (bf16_t*)(ws + WS_HA);
    LAS bf16_t* qs = (LAS bf16_t*)(lds);
    LAS bf16_t* ks = (LAS bf16_t*)(lds + 17408);
    LAS bf16_t* vT = (LAS bf16_t*)(lds + 34816);
    LAS bf16_t* P = (LAS bf16_t*)(lds + 71680);
    LAS float* red = (LAS float*)(lds + 80896);
    for (int u = tid; u < 1024; u += NTHREADS) { const int r = u >> 4, cq = u & 15;
        *(LAS u32x4*)(qs + r * 136 + cq * 8) = *(const u32x4*)(QT + (t0 + r) * 512 + h * 128 + cq * 8);
        *(LAS u32x4*)(ks + r * 136 + cq * 8) = *(const u32x4*)(KT + (t0 + r) * 512 + h * 128 + cq * 8); }
    load_transposed(proj + t0 * PJ + PV + h * 256, PJ, 32, 32, (LAS unsigned*)vT, 36, tid, NoScale());
    __syncthreads();
    const int fr = lane & 15, fq = lane >> 4;
    {
        const int it = wave >> 1;
#pragma unroll
        for (int jj_ = 0; jj_ < 2; ++jj_) { const int jt = (wave & 1) * 2 + jj_;
            f32x4 acc = {0.f, 0.f, 0.f, 0.f};
            if (jt <= it) {
#pragma unroll
                for (int kk = 0; kk < 4; ++kk) acc = MFMA16(ldfrag(ks, 136, jt * 16, kk * 32, fr, fq), ldfrag(qs, 136, it * 16, kk * 32, fr, fq), acc);
                if (jt == it) {
#pragma unroll
                    for (int j = 0; j < 4; ++j) if (4 * fq + j > fr) acc[j] = 0.f;
                }
            }
            *(LAS u32x2*)(P + (it * 16 + fr) * 72 + jt * 16 + 4 * fq) = pack4(acc); }
    }
    __syncthreads();
    f32x4 o[4][2];
#pragma unroll
    for (int mt = 0; mt < 4; ++mt)
#pragma unroll
        for (int et = 0; et < 2; ++et) o[mt][et] = (f32x4){0.f, 0.f, 0.f, 0.f};
#pragma unroll
    for (int et = 0; et < 2; ++et) { const int e0 = wave * 32 + et * 16;
#pragma unroll
        for (int kk = 0; kk < 2; ++kk) { const bf16x8 x = ldfrag(vT, 72, e0, kk * 32, fr, fq);
#pragma unroll
            for (int mt = 0; mt < 4; ++mt) if (mt * 16 + 15 >= kk * 32) o[mt][et] = MFMA16(x, ldfrag(P, 72, mt * 16, kk * 32, fr, fq), o[mt][et]); }
#pragma unroll
        for (int kk = 0; kk < 4; ++kk) { const bf16x8 x = *(const bf16x8*)(gs + (e0 + fr) * 128 + kk * 32 + fq * 8);
#pragma unroll
            for (int mt = 0; mt < 4; ++mt) o[mt][et] = MFMA16(x, ldfrag(qs, 136, mt * 16, kk * 32, fr, fq), o[mt][et]); }
    }
#pragma unroll
    for (int mt = 0; mt < 4; ++mt) { float s = 0.f;
#pragma unroll
        for (int et = 0; et < 2; ++et)
#pragma unroll
            for (int j = 0; j < 4; ++j) s += o[mt][et][j] * o[mt][et][j];
        s += __shfl_xor(s, 16); s += __shfl_xor(s, 32);
        if (fq == 0) red[wave * 64 + mt * 16 + fr] = s; }
    __syncthreads();
#pragma unroll
    for (int mt = 0; mt < 4; ++mt) { const int i = mt * 16 + fr; float s = 0.f;
#pragma unroll
        for (int w = 0; w < 8; ++w) s += red[w * 64 + i];
        const float r = rsqrtf(s * (1.f / 256.f) + EPS);
#pragma unroll
        for (int et = 0; et < 2; ++et) { const int e = wave * 32 + et * 16 + 4 * fq;
            const u32x2 g = *(const u32x2*)(proj + (t0 + i) * PJ + PG + h * 256 + e); const f32x4 wn = *(const f32x4*)(a.in[5] + e);
            f32x4 v = o[mt][et] * r * wn; v[0] *= siluf(bflo(g.x)); v[1] *= siluf(bfhi(g.x)); v[2] *= siluf(bflo(g.y)); v[3] *= siluf(bfhi(g.y));
            *(u32x2*)(mix + (t0 + i) * DM + h * 256 + e) = pack4(v); } }
    __syncthreads();
}


__device__ __forceinline__ void ssd_p2_item(const MkArgs& a, LAS unsigned char* lds, int item, int tid, int wave, int lane) {
    unsigned char* ws = a.ws;
    const int g = item & 3, c = (item >> 2) & 31, b = item >> 7;
    const size_t t0 = (size_t)b * SEQ + c * 128;
    const bf16_t* proj = (const bf16_t*)(ws + WS_PROJ); const float* small = (const float*)(ws + WS_SMALL);
    bf16_t* XC = (bf16_t*)(ws + WS_XC); bf16_t* BC = (bf16_t*)(ws + WS_BC); bf16_t* CC = (bf16_t*)(ws + WS_CC); bf16_t* SS = (bf16_t*)(ws + WS_SS);
    float* DT = (float*)(ws + WS_DT); float* ACS = (float*)(ws + WS_ACS);
    LAS bf16_t* xsdT = (LAS bf16_t*)(lds);
    LAS bf16_t* BT = (LAS bf16_t*)(lds + 69632);
    LAS float* dts = (LAS float*)(lds + 104448);
    LAS float* acs = (LAS float*)(lds + 106496);
    if (wave < 4) {
        const int head = g * 4 + wave; const float av = -__expf(a.in[9][head]), dtb = a.in[8][head];
        const float d0 = softplusf(small[(t0 + 2 * lane) * 32 + 16 + head] + dtb), d1 = softplusf(small[(t0 + 2 * lane + 1) * 32 + 16 + head] + dtb);
        const float a0 = d0 * av, a1 = d1 * av;
        float v = a0 + a1;
#pragma unroll
        for (int o = 1; o < 64; o <<= 1) { const float u = __shfl_up(v, o); if (lane >= o) v += u; }
        const float ex = v - (a0 + a1);
        dts[wave * 128 + 2 * lane] = d0; dts[wave * 128 + 2 * lane + 1] = d1;
        acs[wave * 128 + 2 * lane] = ex + a0; acs[wave * 128 + 2 * lane + 1] = ex + a0 + a1;
        DT[(t0 + 2 * lane) * 16 + head] = d0; DT[(t0 + 2 * lane + 1) * 16 + head] = d1;
        ACS[(t0 + 2 * lane) * 16 + head] = ex + a0; ACS[(t0 + 2 * lane + 1) * 16 + head] = ex + a0 + a1;
    }
    __syncthreads();
    {
        const int ch = tid; const int kind = ch < 256 ? 0 : (ch < 384 ? 1 : 2);
        const int xch = kind == 0 ? g * 256 + ch : (kind == 1 ? 1024 + g * 128 + (ch - 256) : 1536 + g * 128 + (ch - 384));
        const float w0 = a.in[6][xch], w1 = a.in[6][2048 + xch], w2 = a.in[6][4096 + xch], w3 = a.in[6][6144 + xch], bias = a.in[7][xch];
        const bf16_t* src = proj + t0 * PJ + PX + xch;
        float u3 = 0.f, u2 = 0.f, u1 = 0.f;
        if (c > 0) { u3 = bf2f(*(src - 3 * (size_t)PJ)); u2 = bf2f(*(src - 2 * (size_t)PJ)); u1 = bf2f(*(src - (size_t)PJ)); }
        const int r = ch >> 6;
        const float alast = kind == 0 ? acs[r * 128 + 127] : 0.f;
        bf16_t* gdst = kind == 0 ? XC + t0 * 1024 + g * 256 + ch : (kind == 1 ? BC + t0 * 512 + g * 128 + (ch - 256) : CC + t0 * 512 + g * 128 + (ch - 384));
        const size_t gld = kind == 0 ? 1024 : 512;
        LAS bf16_t* ldst = kind == 0 ? xsdT + ch * 136 : BT + (ch - 256) * 136;
        for (int t8 = 0; t8 < 16; ++t8) {
            float o[8];
#pragma unroll
            for (int i = 0; i < 8; ++i) { const int t = t8 * 8 + i; const float u = bf2f(src[(size_t)t * PJ]);
                const float v = siluf(bias + w0 * u3 + w1 * u2 + w2 * u1 + w3 * u); u3 = u2; u2 = u1; u1 = u;
                gdst[(size_t)t * gld] = f2bf(v);
                o[i] = kind == 0 ? v * dts[r * 128 + t] * __expf(alast - acs[r * 128 + t]) : v; }
            if (kind < 2) { u32x4 w; w.x = cvt_pk_bf16(o[0], o[1]); w.y = cvt_pk_bf16(o[2], o[3]); w.z = cvt_pk_bf16(o[4], o[5]); w.w = cvt_pk_bf16(o[6], o[7]);
                *(LAS u32x4*)(ldst + t8 * 8) = w; }
        }
    }
    __syncthreads();
    {
        const int fr = lane & 15, fq = lane >> 4, r = wave >> 1;
        bf16_t* ss = SS + (((size_t)b * 32 + c) * 16 + g * 4 + r) * 8192;
#pragma unroll
        for (int pi = 0; pi < 2; ++pi) { const int pt = (wave & 1) * 2 + pi;
            bf16x8 y[4];
#pragma unroll
            for (int kk = 0; kk < 4; ++kk) y[kk] = ldfrag(xsdT, 136, r * 64 + pt * 16, kk * 32, fr, fq);
#pragma unroll
            for (int nt = 0; nt < 8; ++nt) { f32x4 acc = {0.f, 0.f, 0.f, 0.f};
#pragma unroll
                for (int kk = 0; kk < 4; ++kk) acc = MFMA16(ldfrag(BT, 136, nt * 16, kk * 32, fr, fq), y[kk], acc);
                *(u32x2*)(ss + (pt * 16 + fr) * 128 + nt * 16 + 4 * fq) = pack4(acc); } }
    }
    __syncthreads();
}

__device__ __forceinline__ void ssd_p4_item(const MkArgs& a, LAS unsigned char* lds, int item, int tid, int wave, int lane) {
    unsigned char* ws = a.ws;
    const int g = item & 3, c = (item >> 2) & 31, b = item >> 7;
    const size_t t0 = (size_t)b * SEQ + c * 128;
    const bf16_t* proj = (const bf16_t*)(ws + WS_PROJ);
    const bf16_t* XC = (const bf16_t*)(ws + WS_XC); const bf16_t* BC = (const bf16_t*)(ws + WS_BC); const bf16_t* CC = (const bf16_t*)(ws + WS_CC); const bf16_t* SS = (const bf16_t*)(ws + WS_SS);
    const float* DT = (const float*)(ws + WS_DT); const float* ACS = (const float*)(ws + WS_ACS);
    bf16_t* mix = (bf16_t*)(ws + WS_HA);
    LAS bf16_t* Cs = (LAS bf16_t*)(lds);
    LAS bf16_t* Bs = (LAS bf16_t*)(lds + 34816);
    LAS bf16_t* xsT = (LAS bf16_t*)(lds + 69632);
    LAS float* dts = (LAS float*)(lds + 139264);
    LAS float* acs = (LAS float*)(lds + 141312);
    { const int r = tid >> 7, t = tid & 127; dts[tid] = DT[(t0 + t) * 16 + g * 4 + r]; acs[tid] = ACS[(t0 + t) * 16 + g * 4 + r]; }
    for (int u = tid; u < 2048; u += NTHREADS) { const int r = u >> 4, cq = u & 15;
        *(LAS u32x4*)(Cs + r * 136 + cq * 8) = *(const u32x4*)(CC + (t0 + r) * 512 + g * 128 + cq * 8);
        *(LAS u32x4*)(Bs + r * 136 + cq * 8) = *(const u32x4*)(BC + (t0 + r) * 512 + g * 128 + cq * 8); }
    __syncthreads();
    load_transposed(XC + t0 * 1024 + g * 256, 1024, 64, 32, (LAS unsigned*)xsT, 68, tid, [&](int tok, int cg) { return dts[(cg >> 3) * 128 + tok]; });
    const int fr = lane & 15, fq = lane >> 4, w = wave;
    bf16x8 cf[4];
#pragma unroll
    for (int kk = 0; kk < 4; ++kk) cf[kk] = ldfrag(Cs, 136, w * 16, kk * 32, fr, fq);
    f32x4 cb[8];
#pragma unroll
    for (int st = 0; st < 8; ++st) { cb[st] = (f32x4){0.f, 0.f, 0.f, 0.f};
        if (st <= w) {
#pragma unroll
            for (int kk = 0; kk < 4; ++kk) cb[st] = MFMA16(ldfrag(Bs, 136, st * 16, kk * 32, fr, fq), cf[kk], cb[st]); } }
    __syncthreads();
    const int l = w * 16 + fr;
    float ssq = 0.f;
    bf16_t* mrow = mix + (t0 + l) * DM + 1024 + g * 256 + 4 * fq;
#pragma unroll 1
    for (int r = 0; r < 4; ++r) {
        const float al = acs[r * 128 + l];
#pragma unroll
        for (int st = 0; st < 8; ++st) if (st <= (w | 1)) { f32x4 mv;
#pragma unroll
            for (int j = 0; j < 4; ++j) { const int s = st * 16 + 4 * fq + j; mv[j] = (s <= l) ? cb[st][j] * __expf(al - acs[r * 128 + s]) : 0.f; }
            *(LAS u32x2*)(Bs + l * 136 + st * 16 + 4 * fq) = pack4(mv); }
        LDS_WAIT();
        const float eal = __expf(al), dsk = a.in[10][g * 4 + r];
        const bf16_t* ss = SS + (((size_t)b * 32 + c) * 16 + g * 4 + r) * 8192 + fr * 128 + fq * 8;
        const bf16_t* xcp = XC + (t0 + l) * 1024 + g * 256 + r * 64 + 4 * fq; const bf16_t* zp = proj + (t0 + l) * PJ + PZ + g * 256 + r * 64 + 4 * fq;
#pragma unroll
        for (int pt = 0; pt < 4; ++pt) {
            f32x4 ad = {0.f, 0.f, 0.f, 0.f}, ao = {0.f, 0.f, 0.f, 0.f};
#pragma unroll
            for (int kk = 0; kk < 4; ++kk) if (kk <= (w >> 1)) ad = MFMA16(ldfrag(xsT, 136, r * 64 + pt * 16, kk * 32, fr, fq), ldfrag(Bs, 136, w * 16, kk * 32, fr, fq), ad);
#pragma unroll
            for (int kk = 0; kk < 4; ++kk) ao = MFMA16(*(const bf16x8*)(ss + pt * 2048 + kk * 32), cf[kk], ao);
            const u32x2 xv = *(const u32x2*)(xcp + pt * 16), zv = *(const u32x2*)(zp + pt * 16);
            f32x4 y = ad + ao * eal;
            y[0] = (y[0] + dsk * bflo(xv.x)) * siluf(bflo(zv.x)); y[1] = (y[1] + dsk * bfhi(xv.x)) * siluf(bfhi(zv.x));
            y[2] = (y[2] + dsk * bflo(xv.y)) * siluf(bflo(zv.y)); y[3] = (y[3] + dsk * bfhi(xv.y)) * siluf(bfhi(zv.y));
            ssq += (y[0] * y[0] + y[1] * y[1]) + (y[2] * y[2] + y[3] * y[3]);
            *(u32x2*)(mrow + r * 64 + pt * 16) = pack4(y);
        }
        LDS_WAIT();
    }
    ssq += __shfl_xor(ssq, 16); ssq += __shfl_xor(ssq, 32);
    const float rs = rsqrtf(ssq * (1.f / 256.f) + EPS);
    VM_WAIT();
#pragma unroll 4
    for (int q = 0; q < 16; ++q) { const f32x4 wn = *(const f32x4*)(a.in[11] + g * 256 + q * 16 + 4 * fq); const u32x2 v = *(const u32x2*)(mrow + q * 16);
        *(u32x2*)(mrow + q * 16) = pack4((f32x4){bflo(v.x), bfhi(v.x), bflo(v.y), bfhi(v.y)} * rs * wn); }
    __syncthreads();
}

__device__ __forceinline__ void phase2(const MkArgs& a, LAS unsigned char* lds, int tid, int wave, int lane) {
    if (a.flags & 2) for (int it = blockIdx.x; it < 512; it += gridDim.x) ssd_p2_item(a, lds, it, tid, wave, lane);
    if (a.flags & 1) for (int it = blockIdx.x; it < 1024; it += gridDim.x) gla_p2_item(a, lds, it, tid, wave, lane);
}
__device__ __forceinline__ void phase4(const MkArgs& a, LAS unsigned char* lds, int tid, int wave, int lane) {
#ifndef NO_SSD4
    if (a.flags & 2) for (int it = blockIdx.x; it < 512; it += gridDim.x) ssd_p4_item(a, lds, it, tid, wave, lane);
#endif
#ifndef NO_GLA4
    if (a.flags & 1) for (int it = blockIdx.x; it < 1024; it += gridDim.x) gla_p4_item(a, lds, it, tid, wave, lane);
#endif
}
__global__ void __launch_bounds__(NTHREADS, 2) mk_fwd(MkArgs a) {
    extern __shared__ __attribute__((aligned(16))) unsigned char lds_raw[];
    LAS unsigned char* lds = (LAS unsigned char*)lds_raw;
    const int tid = threadIdx.x, lane = tid & 63, wave = __builtin_amdgcn_readfirstlane(tid >> 6);
    const int lo = a.ph_lo, hi = a.ph_hi;
    volatile LAS unsigned* bst = (volatile LAS unsigned*)(lds + LDS_BYTES - 64);
    if (tid < 16) bst[tid] = 0u;
    __syncthreads();
    XcdBarrier bar = xcd_barrier_post((unsigned*)(a.ws + WS_BAR) + a.li * XCD_BAR_WORDS, bst);
#ifndef ONLY_PHASE
#define ONLY_PHASE -1
#endif
#define IN(k) ((ONLY_PHASE < 0 || ONLY_PHASE == (k)) && lo <= (k) && (k) < hi)
#define SEAM(k) do { if (IN(k) && IN((k) + 1)) { xcd_barrier(bar); } } while (0)
    if (IN(0)) { phase0(a, lds, wave, lane); }
    SEAM(0);
    if (IN(1)) { phase1(a, lds, wave, lane); }
    SEAM(1);
    if (IN(2)) { phase2(a, lds, tid, wave, lane); }
    SEAM(2);
    if (IN(3)) { scan_phase(a, a.flags); }
    SEAM(3);
    if (IN(4)) { phase4(a, lds, tid, wave, lane); }
    SEAM(4);
    if (IN(5)) { phase5(a, lds, a.out); }
    SEAM(5);
    if (IN(6)) { phase6(a, lds, a.out, wave, lane); }
    SEAM(6);
    if (IN(7)) { phase7(a, lds); }
    SEAM(7);
    if (IN(8)) { phase8(a, lds); }
    SEAM(8);
    if (IN(9)) { phase9(a, wave, lane); }
#undef IN
#undef SEAM
}

__global__ void n_copy_cols(const bf16_t* __restrict__ src, bf16_t* __restrict__ dst) {
    const size_t i = (size_t)blockIdx.x * 256 + threadIdx.x; const size_t t = i >> 10, c = i & 1023; dst[i] = src[t * DM + c];
}
__global__ void n_cmp_cols(const bf16_t* __restrict__ ref, const bf16_t* __restrict__ tst, unsigned* flag) {
    const size_t i = (size_t)blockIdx.x * 256 + threadIdx.x; const size_t t = i >> 10, c = i & 1023;
    const float d = fabsf(bf2f(ref[t * DM + c]) - bf2f(tst[i]));
    if (d > 0.02f) atomicMax(flag, __float_as_uint(d));
}
__global__ void n_poison(float* out, const unsigned* flag) { if (threadIdx.x == 0 && flag[0] != 0u) out[0] += 1000.f * __uint_as_float(flag[0]); }
static int g_grid = 0;
static void launch_mk(MkArgs a, int lo, int hi, int li, hipStream_t stream) {
    if (g_grid == 0) {
        int dev = 0, cus = 0, per_cu = 0;
        hipGetDevice(&dev);
        hipDeviceGetAttribute(&cus, hipDeviceAttributeMultiprocessorCount, dev);
        hipFuncSetAttribute((const void*)mk_fwd, hipFuncAttributeMaxDynamicSharedMemorySize, LDS_BYTES);
        hipOccupancyMaxActiveBlocksPerMultiprocessor(&per_cu, (const void*)mk_fwd, NTHREADS, LDS_BYTES);
        if (per_cu < 1) { fprintf(stderr, "kernel_launch: occupancy query says %d blocks/CU\n", per_cu); per_cu = 1; }
        g_grid = cus * per_cu;
        fprintf(stderr, "kernel_launch: grid %d (%d CUs x %d)\n", g_grid, cus, per_cu);
    }
    a.ph_lo = lo; a.ph_hi = hi; a.li = li;
    void* args[] = {&a};
    hipError_t e = hipLaunchCooperativeKernel((const void*)mk_fwd, dim3(g_grid), dim3(NTHREADS), args, LDS_BYTES, stream);
    if (e != hipSuccess) fprintf(stderr, "cooperative launch failed: %s (grid %d)\n", hipGetErrorString(e), g_grid);
}

extern "C" void kernel_launch(void* const* d_in, const int* in_sizes, int n_in, void* d_out, int out_size, void* d_ws, size_t ws_size, hipStream_t stream) {
    if (ws_size < WS_END) { fprintf(stderr, "kernel_launch: workspace too small: %zu < %zu\n", ws_size, (size_t)WS_END); return; }
    const float* x = (const float*)d_in[0];
    const float* w_gk_up = (const float*)d_in[3];
    const float* b_gk = (const float*)d_in[4];
    const float* w_gla_norm = (const float*)d_in[5];
    const float* w_conv = (const float*)d_in[6];
    const float* b_conv = (const float*)d_in[7];
    const float* dt_bias = (const float*)d_in[8];
    const float* a_log = (const float*)d_in[9];
    const float* d_skip = (const float*)d_in[10];
    const float* w_ssd_norm = (const float*)d_in[11];
    const float* w_norm_ffn = (const float*)d_in[13];
    const float* w_rg = (const float*)d_in[14];
    const float* b_rg = (const float*)d_in[15];
    const float* w_re = (const float*)d_in[16];
    const float* b_re = (const float*)d_in[17];
    const float* w_gate = (const float*)d_in[18];
    const float* w_up = (const float*)d_in[19];
    const float* w_down = (const float*)d_in[20];
    const float* w_final = (const float*)d_in[21];
    char* ws = (char*)d_ws;
    float* out = (float*)d_out;
    int* cnt = (int*)(ws + WS_CTL);
    float* small = (float*)(ws + WS_SMALL);
    int* tok_e = (int*)(ws + WS_TOKE);
    float* tok_w = (float*)(ws + WS_TOKW);
    int* list = (int*)(ws + WS_LIST);
    bf16_t* hA = (bf16_t*)(ws + WS_HA);
    bf16_t* proj = (bf16_t*)(ws + WS_PROJ);
    bf16_t* ybuf = (bf16_t*)(ws + WS_Y);
    bf16_t* hmid = (bf16_t*)(ws + WS_HMID);
    bf16_t* mix = hA;
    bf16_t* h2 = hA;
    float* x1 = (float*)(ws + WS_PROJ);
    float* oy = out; (void)x1; (void)h2; (void)hmid; (void)ybuf; (void)list; (void)tok_w; (void)tok_e; (void)cnt; (void)x;
    (void)w_norm_ffn; (void)w_rg; (void)b_rg; (void)w_re; (void)b_re; (void)w_gate; (void)w_up; (void)w_down; (void)w_final;
    MkArgs a{};
    for (int i = 0; i < 22; ++i) a.in[i] = (const float*)d_in[i];
    a.out = out; a.ws = (unsigned char*)d_ws;

    (void)hipMemsetAsync(ws + WS_CTL, 0, 262144, stream);
    a.flags = 3;
    launch_mk(a, 0, 10, 0, stream);
    (void)w_conv; (void)b_conv; (void)dt_bias; (void)a_log; (void)d_skip; (void)w_ssd_norm; (void)oy; (void)small; (void)proj; (void)mix;
    (void)w_gk_up; (void)b_gk; (void)w_gla_norm;
}
```

```cpp
#include <hip/hip_runtime.h>
#include <cstdio>
#include <cstdint>

typedef unsigned short bf16_t;

constexpr int T_TOK = 16384, SEQ = 4096, NB = 4, DM = 2048;
constexpr int IN_DIM = 6176;
constexpr int PJ = 6144;
constexpr int PQ = 0, PK = 512, PV = 1024, PG = 2048, PZ = 3072, PX = 4096, PB = 5120, PC = 5632;
constexpr int WI_GK = 3072, WI_Z = 3088, WI_XBC = 4112, WI_DT = 6160;
constexpr int NEXP = 32, DEXP = 512;
constexpr float EPS = 1e-6f;

__device__ __forceinline__ float bf2f(bf16_t b) { return __uint_as_float(((unsigned)b) << 16); }
__device__ __forceinline__ bf16_t f2bf(float f) { unsigned u = __float_as_uint(f); u += 0x7FFFu + ((u >> 16) & 1u); return (bf16_t)(u >> 16); }
__device__ __forceinline__ float siluf(float v) { return v / (1.f + __expf(-v)); }
__device__ __forceinline__ float softplusf(float v) { return v > 20.f ? v : log1pf(__expf(v)); }
__device__ __forceinline__ float logsigmoidf(float v) { return fminf(v, 0.f) - log1pf(__expf(-fabsf(v))); }
__device__ __forceinline__ int win_col(int j) { return j < 3072 ? j : (j < 4096 ? j - 3072 + WI_Z : j - 4096 + WI_XBC); }
__device__ __forceinline__ int win_col_small(int j) { return j < 16 ? WI_GK + j : WI_DT + (j - 16); }

constexpr size_t MiB = 1024 * 1024;
constexpr size_t WS_CTL = 0;
constexpr size_t WS_BAR = 65536;
constexpr size_t WS_SMALL = 1 * MiB;
constexpr size_t WS_TOKE = WS_SMALL + 2 * MiB;
constexpr size_t WS_TOKW = WS_TOKE + MiB / 8;
constexpr size_t WS_LIST = WS_TOKW + MiB / 8;
constexpr size_t WS_RSTD = 6 * MiB;
constexpr size_t WS_WRT = 7 * MiB;
constexpr size_t WS_HA = 8 * MiB;
constexpr size_t WS_PROJ = WS_HA + 64 * MiB;
constexpr size_t WS_SCR = WS_PROJ + 192 * MiB;
constexpr size_t WS_Y = WS_SCR;
constexpr size_t WS_HMID = WS_SCR + 128 * MiB;
constexpr size_t WS_QT = WS_SCR;
constexpr size_t WS_KT = WS_QT + 16 * MiB;
constexpr size_t WS_GS = WS_KT + 16 * MiB;
constexpr size_t WS_GDEC = WS_GS + 64 * MiB;
constexpr size_t WS_XC = WS_GDEC + 1 * MiB;
constexpr size_t WS_BC = WS_XC + 32 * MiB;
constexpr size_t WS_CC = WS_BC + 16 * MiB;
constexpr size_t WS_SS = WS_CC + 16 * MiB;
constexpr size_t WS_DT = WS_SS + 32 * MiB;
constexpr size_t WS_ACS = WS_DT + 1 * MiB;
static_assert(WS_ACS + 1 * MiB <= WS_SCR + 200 * MiB, "mixer scratch");
constexpr size_t WS_WINT = WS_SCR + 200 * MiB;
constexpr size_t WS_WST = WS_WINT + 24 * MiB;
constexpr size_t WS_WOUTT = WS_WST + 1 * MiB;
constexpr size_t WS_END = WS_WOUTT + 8 * MiB;
constexpr size_t WS_WGUT = WS_PROJ;
constexpr size_t WS_WDT = WS_PROJ + 128 * MiB;

__global__ void __launch_bounds__(256) n_rmsnorm_bf16(const float* __restrict__ x, const float* __restrict__ w, bf16_t* __restrict__ out) {
    __shared__ float red[4];
    const int t = blockIdx.x, tid = threadIdx.x;
    const float* xr = x + (size_t)t * DM;
    float v[8]; float s = 0.f;
    for (int i = 0; i < 8; ++i) { v[i] = xr[tid + i * 256]; s += v[i] * v[i]; }
    for (int o = 32; o > 0; o >>= 1) s += __shfl_xor(s, o);
    if ((tid & 63) == 0) red[tid >> 6] = s;
    __syncthreads();
    s = red[0] + red[1] + red[2] + red[3];
    const float r = rsqrtf(s / DM + EPS);
    for (int i = 0; i < 8; ++i) out[(size_t)t * DM + tid + i * 256] = f2bf(v[i] * r * w[tid + i * 256]);
}

template <class AL, class BL, class EP>
__device__ __forceinline__ void ngemm_tile(int m0, int n0, int K, AL aload, BL bload, EP epi) {
    __shared__ float As[16][65], Bs[16][65];
    const int tid = threadIdx.x, tx = tid & 15, ty = tid >> 4;
    float acc[4][4];
    for (int i = 0; i < 4; ++i) for (int j = 0; j < 4; ++j) acc[i][j] = 0.f;
    for (int k0 = 0; k0 < K; k0 += 16) {
        for (int i = 0; i < 4; ++i) { const int idx = tid + i * 256; const int r = idx >> 4, kk = idx & 15; As[kk][r] = aload(m0 + r, k0 + kk); }
        for (int i = 0; i < 4; ++i) { const int idx = tid + i * 256; const int kk = idx >> 6, c = idx & 63; Bs[kk][c] = bload(k0 + kk, n0 + c); }
        __syncthreads();
#pragma unroll
        for (int kk = 0; kk < 16; ++kk) {
            float a[4], b[4];
            for (int i = 0; i < 4; ++i) a[i] = As[kk][ty * 4 + i];
            for (int j = 0; j < 4; ++j) b[j] = Bs[kk][tx * 4 + j];
            for (int i = 0; i < 4; ++i) for (int j = 0; j < 4; ++j) acc[i][j] += a[i] * b[j];
        }
        __syncthreads();
    }
    for (int i = 0; i < 4; ++i) for (int j = 0; j < 4; ++j) epi(m0 + ty * 4 + i, n0 + tx * 4 + j, acc[i][j]);
}

__global__ void __launch_bounds__(256) n_inproj(const bf16_t* __restrict__ hA, const float* __restrict__ w_in, bf16_t* __restrict__ proj, float* __restrict__ small) {
    const int nt = blockIdx.x, m0 = blockIdx.y * 64;
    auto al = [&](int m, int k) { return bf2f(hA[(size_t)m * DM + k]); };
    if (nt < 96) {
        auto bl = [&](int k, int n) { return w_in[(size_t)k * IN_DIM + win_col(n)]; };
        auto ep = [&](int m, int n, float v) { proj[(size_t)m * PJ + n] = f2bf(v); };
        ngemm_tile(m0, nt * 64, DM, al, bl, ep);
    } else {
        auto bl = [&](int k, int n) { return n < 32 ? w_in[(size_t)k * IN_DIM + win_col_small(n)] : 0.f; };
        auto ep = [&](int m, int n, float v) { if (n < 32) small[(size_t)m * 32 + n] = v; };
        ngemm_tile(m0, 0, DM, al, bl, ep);
    }
}

__global__ void __launch_bounds__(256) n_gla_rec(const bf16_t* __restrict__ proj, const float* __restrict__ small, const float* __restrict__ w_gk_up,
                                                 const float* __restrict__ b_gk, float* __restrict__ o  ) {
    __shared__ float sq[128], sk[128], sa[128], sv[32], red[8][32];
    const int es = blockIdx.x, h = blockIdx.y, b = blockIdx.z, tid = threadIdx.x;
    const int dg = tid >> 5, e = tid & 31;
    float st[16];
    for (int i = 0; i < 16; ++i) st[i] = 0.f;
    const float scale = 0.08838834764831845f;
    for (int s = 0; s < SEQ; ++s) {
        const size_t t = (size_t)b * SEQ + s;
        if (tid < 128) {
            const int d = tid;
            float g = b_gk[h * 128 + d];
            for (int r = 0; r < 16; ++r) g += small[t * 32 + r] * w_gk_up[r * 512 + h * 128 + d];
            sa[d] = __expf(logsigmoidf(g) * (1.f / 16.f));
            sq[d] = bf2f(proj[t * PJ + PQ + h * 128 + d]) * scale;
            sk[d] = bf2f(proj[t * PJ + PK + h * 128 + d]);
        } else if (tid < 160) {
            sv[tid - 128] = bf2f(proj[t * PJ + PV + h * 256 + es * 32 + (tid - 128)]);
        }
        __syncthreads();
        float part = 0.f; const float v = sv[e];
#pragma unroll
        for (int i = 0; i < 16; ++i) { const int d = dg * 16 + i; st[i] = st[i] * sa[d] + sk[d] * v; part += sq[d] * st[i]; }
        red[dg][e] = part;
        __syncthreads();
        if (tid < 32) { float a = 0.f; for (int i = 0; i < 8; ++i) a += red[i][tid]; o[t * DM + h * 256 + es * 32 + tid] = a; }
        __syncthreads();
    }
}

__global__ void __launch_bounds__(256) n_gla_out(const float* __restrict__ o, const bf16_t* __restrict__ proj, const float* __restrict__ w_gla_norm, bf16_t* __restrict__ mix) {
    __shared__ float red[4];
    const int t = blockIdx.x, tid = threadIdx.x;
    for (int h = 0; h < 4; ++h) {
        const float v = o[(size_t)t * DM + h * 256 + tid];
        float s = v * v;
        for (int of = 32; of > 0; of >>= 1) s += __shfl_xor(s, of);
        __syncthreads();
        if ((tid & 63) == 0) red[tid >> 6] = s;
        __syncthreads();
        s = red[0] + red[1] + red[2] + red[3];
        const float r = rsqrtf(s / 256.f + EPS);
        const float g = bf2f(proj[(size_t)t * PJ + PG + h * 256 + tid]);
        mix[(size_t)t * DM + h * 256 + tid] = f2bf(v * r * w_gla_norm[tid] * siluf(g));
    }
}

__global__ void __launch_bounds__(256) n_ssd_rec(const bf16_t* __restrict__ proj, const float* __restrict__ small, const float* __restrict__ w_conv, const float* __restrict__ b_conv,
                                                 const float* __restrict__ dt_bias, const float* __restrict__ a_log, const float* __restrict__ d_skip, float* __restrict__ y  ) {
    __shared__ float sx[64], sB[128], sC[128];
    const int head = blockIdx.x, b = blockIdx.y, tid = threadIdx.x, g = head >> 2;
    const int p = tid >> 2, ng = tid & 3;
    float st[32];
    for (int i = 0; i < 32; ++i) st[i] = 0.f;
    const float a = -__expf(a_log[head]), dsk = d_skip[head], dtb = dt_bias[head];
    for (int s = 0; s < SEQ; ++s) {
        const size_t t = (size_t)b * SEQ + s;
        for (int c = tid; c < 320; c += 256) {
            const int ch = c < 64 ? head * 64 + c : (c < 192 ? 1024 + g * 128 + (c - 64) : 1536 + g * 128 + (c - 192));
            float acc = b_conv[ch];
            for (int k = 0; k < 4; ++k) { const int ss = s - 3 + k; if (ss >= 0) acc += w_conv[k * 2048 + ch] * bf2f(proj[((size_t)b * SEQ + ss) * PJ + PX + ch]); }
            acc = siluf(acc);
            if (c < 64) sx[c] = acc; else if (c < 192) sB[c - 64] = acc; else sC[c - 192] = acc;
        }
        __syncthreads();
        const float dt = softplusf(small[t * 32 + 16 + head] + dtb);
        const float dA = __expf(dt * a);
        const float xv = sx[p], xdt = xv * dt;
        float part = 0.f;
#pragma unroll
        for (int i = 0; i < 32; ++i) { const int n = ng * 32 + i; st[i] = st[i] * dA + xdt * sB[n]; part += sC[n] * st[i]; }
        part += __shfl_xor(part, 1); part += __shfl_xor(part, 2);
        if (ng == 0) y[t * DM + 1024 + head * 64 + p] = part + dsk * xv;
        __syncthreads();
    }
}

__global__ void __launch_bounds__(256) n_ssd_out(const float* __restrict__ y, const bf16_t* __restrict__ proj, const float* __restrict__ w_ssd_norm, bf16_t* __restrict__ mix) {
    __shared__ float red[4];
    const int t = blockIdx.x, tid = threadIdx.x;
    for (int g = 0; g < 4; ++g) {
        const int c = g * 256 + tid;
        const float v = y[(size_t)t * DM + 1024 + c] * siluf(bf2f(proj[(size_t)t * PJ + PZ + c]));
        float s = v * v;
        for (int of = 32; of > 0; of >>= 1) s += __shfl_xor(s, of);
        __syncthreads();
        if ((tid & 63) == 0) red[tid >> 6] = s;
        __syncthreads();
        s = red[0] + red[1] + red[2] + red[3];
        const float r = rsqrtf(s / 256.f + EPS);
        mix[(size_t)t * DM + 1024 + c] = f2bf(v * r * w_ssd_norm[c]);
    }
}

__global__ void __launch_bounds__(256) n_outproj(const bf16_t* __restrict__ mix, const float* __restrict__ w_out, const float* __restrict__ x, float* __restrict__ x1) {
    auto al = [&](int m, int k) { return bf2f(mix[(size_t)m * DM + k]); };
    auto bl = [&](int k, int n) { return w_out[(size_t)k * DM + n]; };
    auto ep = [&](int m, int n, float v) { x1[(size_t)m * DM + n] = x[(size_t)m * DM + n] + v; };
    ngemm_tile(blockIdx.y * 64, blockIdx.x * 64, DM, al, bl, ep);
}

__global__ void __launch_bounds__(256) n_router(const float* __restrict__ x1, const float* __restrict__ w_norm, const float* __restrict__ w_rg, const float* __restrict__ b_rg,
                                                const float* __restrict__ w_re, const float* __restrict__ b_re, bf16_t* __restrict__ h2, int* __restrict__ tok_e, float* __restrict__ tok_w,
                                                int* __restrict__ cnt, int* __restrict__ list) {
    __shared__ float red[4][36]; __shared__ float sred[4];
    const int t = blockIdx.x, tid = threadIdx.x;
    float v[8]; float s = 0.f;
    for (int i = 0; i < 8; ++i) { v[i] = x1[(size_t)t * DM + tid + i * 256]; s += v[i] * v[i]; }
    for (int o = 32; o > 0; o >>= 1) s += __shfl_xor(s, o);
    if ((tid & 63) == 0) sred[tid >> 6] = s;
    __syncthreads();
    s = sred[0] + sred[1] + sred[2] + sred[3];
    const float r = rsqrtf(s / DM + EPS);
    float lg[36];
    for (int j = 0; j < 36; ++j) lg[j] = 0.f;
    for (int i = 0; i < 8; ++i) {
        const int k = tid + i * 256; const float hv = v[i] * r * w_norm[k];
        h2[(size_t)t * DM + k] = f2bf(hv);
        for (int j = 0; j < 4; ++j) lg[j] += hv * w_rg[k * 4 + j];
        for (int j = 0; j < 32; ++j) lg[4 + j] += hv * w_re[k * 32 + j];
    }
    for (int j = 0; j < 36; ++j) { float a = lg[j]; for (int o = 32; o > 0; o >>= 1) a += __shfl_xor(a, o); if ((tid & 63) == 0) red[tid >> 6][j] = a; }
    __syncthreads();
    if (tid == 0) {
        float gl[4]; int gi = 0; float gm = -1e30f;
        for (int j = 0; j < 4; ++j) { gl[j] = red[0][j] + red[1][j] + red[2][j] + red[3][j] + b_rg[j]; if (gl[j] > gm) { gm = gl[j]; gi = j; } }
        float gs = 0.f; for (int j = 0; j < 4; ++j) gs += __expf(gl[j] - gm);
        const float gw = 1.f / gs;
        float el[8]; int i0 = 0; float m0 = -1e30f;
        for (int j = 0; j < 8; ++j) { const int c = 4 + gi * 8 + j; el[j] = red[0][c] + red[1][c] + red[2][c] + red[3][c] + b_re[gi * 8 + j]; if (el[j] > m0) { m0 = el[j]; i0 = j; } }
        int i1 = -1; float m1 = -1e30f;
        for (int j = 0; j < 8; ++j) if (j != i0 && el[j] > m1) { m1 = el[j]; i1 = j; }
        const float e1 = __expf(m1 - m0);
        const float w0 = gw / (1.f + e1), w1 = gw * e1 / (1.f + e1);
        const int ex0 = gi * 8 + i0, ex1 = gi * 8 + i1;
        tok_e[t * 2] = ex0; tok_e[t * 2 + 1] = ex1; tok_w[t * 2] = w0; tok_w[t * 2 + 1] = w1;
        int p0 = atomicAdd(&cnt[ex0], 1); list[ex0 * T_TOK + p0] = t * 2;
        int p1 = atomicAdd(&cnt[ex1], 1); list[ex1 * T_TOK + p1] = t * 2 + 1;
    }
}

__device__ __forceinline__ int moe_off(const int* cnt, int e) { int o = 0; for (int i = 0; i < e; ++i) o += (cnt[i] + 255) & ~255; return o; }

__global__ void __launch_bounds__(256) n_moe_up(const bf16_t* __restrict__ h2, const float* __restrict__ w_gate, const float* __restrict__ w_up, const int* __restrict__ cnt,
                                                const int* __restrict__ list, bf16_t* __restrict__ hmid, float* __restrict__ tmp  ) {
    const int e = blockIdx.z, m0 = blockIdx.y * 64, n0 = blockIdx.x * 64, ne = cnt[e];
    if (m0 >= ne) return;
    const int off = moe_off(cnt, e);
    const int* le = list + (size_t)e * T_TOK;
    __shared__ float gsave[64][65];
    auto al = [&](int m, int k) { return m < ne ? bf2f(h2[(size_t)(le[m] >> 1) * DM + k]) : 0.f; };
    auto blg = [&](int k, int n) { return w_gate[((size_t)e * DM + k) * DEXP + n]; };
    auto blu = [&](int k, int n) { return w_up[((size_t)e * DM + k) * DEXP + n]; };
    auto epg = [&](int m, int n, float v) { gsave[m - m0][n - n0] = v; };
    ngemm_tile(m0, n0, DM, al, blg, epg);
    auto epu = [&](int m, int n, float v) { if (m < ne) hmid[(size_t)(off + m) * DEXP + n] = f2bf(siluf(gsave[m - m0][n - n0]) * v); };
    ngemm_tile(m0, n0, DM, al, blu, epu);
}

__global__ void __launch_bounds__(256) n_moe_down(const bf16_t* __restrict__ hmid, const float* __restrict__ w_down, const int* __restrict__ cnt, const int* __restrict__ list, bf16_t* __restrict__ y) {
    const int e = blockIdx.z, m0 = blockIdx.y * 64, n0 = blockIdx.x * 64, ne = cnt[e];
    if (m0 >= ne) return;
    const int off = moe_off(cnt, e);
    const int* le = list + (size_t)e * T_TOK;
    auto al = [&](int m, int k) { return m < ne ? bf2f(hmid[(size_t)(off + m) * DEXP + k]) : 0.f; };
    auto bl = [&](int k, int n) { return w_down[((size_t)e * DEXP + k) * DM + n]; };
    auto ep = [&](int m, int n, float v) { if (m < ne) y[(size_t)le[m] * DM + n] = f2bf(v); };
    ngemm_tile(m0, n0, DEXP, al, bl, ep);
}

__global__ void __launch_bounds__(256) n_final(const float* __restrict__ x1, const bf16_t* __restrict__ y, const float* __restrict__ tok_w, const float* __restrict__ w, float* __restrict__ out) {
    __shared__ float red[4];
    const int t = blockIdx.x, tid = threadIdx.x;
    const float w0 = tok_w[t * 2], w1 = tok_w[t * 2 + 1];
    float v[8]; float s = 0.f;
    for (int i = 0; i < 8; ++i) { const int k = tid + i * 256;
        v[i] = x1[(size_t)t * DM + k] + w0 * bf2f(y[((size_t)t * 2) * DM + k]) + w1 * bf2f(y[((size_t)t * 2 + 1) * DM + k]); s += v[i] * v[i]; }
    for (int o = 32; o > 0; o >>= 1) s += __shfl_xor(s, o);
    if ((tid & 63) == 0) red[tid >> 6] = s;
    __syncthreads();
    s = red[0] + red[1] + red[2] + red[3];
    const float r = rsqrtf(s / DM + EPS);
    for (int i = 0; i < 8; ++i) { const int k = tid + i * 256; out[(size_t)t * DM + k] = v[i] * r * w[k]; }
}

#include <hip/hip_cooperative_groups.h>
namespace cg = cooperative_groups;
#define LAS __attribute__((address_space(3)))
#define GAS __attribute__((address_space(1)))
typedef short bf16x8 __attribute__((ext_vector_type(8)));
typedef float f32x4 __attribute__((ext_vector_type(4)));
typedef float f32x2 __attribute__((ext_vector_type(2)));
typedef unsigned u32x4 __attribute__((ext_vector_type(4)));
typedef unsigned u32x2 __attribute__((ext_vector_type(2)));
#define LDS_WAIT() asm volatile("s_waitcnt lgkmcnt(0)" ::: "memory")
#define VM_WAIT() asm volatile("s_waitcnt vmcnt(0)" ::: "memory")
typedef __bf16 bf16x2_t __attribute__((ext_vector_type(2)));
__device__ __forceinline__ unsigned cvt_pk_bf16(float lo, float hi) { f32x2 f = {lo, hi}; bf16x2_t v = __builtin_convertvector(f, bf16x2_t); return __builtin_bit_cast(unsigned, v); }

namespace pg8 {
constexpr int BM = 256, BK = 64, HALF = 128, HTB = HALF * BK * 2, STAGE_BYTES = 8 * HTB, NXCD = 8, WGM = 8;
__host__ __device__ __forceinline__ int lds_byte(int r, int c) { const int st = (r >> 4) * 2 + (c >> 5), rr = r & 15, cc = c & 31, ob = rr * 64 + cc * 2; return st * 1024 + (ob ^ (((ob >> 9) & 1) << 5)); }
__host__ __device__ __forceinline__ void stage_rc(int b, int& R, int& C) { const int st = b / 1024, sb = b % 1024, swz = sb ^ (((sb >> 9) & 1) << 5); R = (st >> 1) * 16 + swz / 64; C = (st & 1) * 32 + (swz % 64) / 2; }
__host__ __device__ __forceinline__ int perm32(int rho) { const int n = rho >> 4, i = rho & 15; return 8 * (i >> 2) + 4 * n + (i & 3); }

struct Unit { int pm, pn, e, row0, ne; };

struct StaticOrder {
    static constexpr bool GATHER = false;
    const char* A; const char* Bt; size_t tstep;
    int nM, nN, nwg, G, c;
    __device__ void init(const bf16_t* A_, const bf16_t* Bt_, int M, int N, int K, int G_, int c_) { A = (const char*)A_; Bt = (const char*)Bt_; tstep = (size_t)BM * K * 2; nM = M / BM; nN = N / BM; nwg = nM * nN; G = G_; c = c_; }
    __device__ bool next(int i, Unit& u) const {
        const long L = (long)i * G + c; if (L >= nwg) return false;
        int wgid = (int)L; { const int q = nwg / NXCD, r = nwg % NXCD, xcd = wgid % NXCD, off = wgid / NXCD; wgid = (xcd < r ? xcd * (q + 1) : r * (q + 1) + (xcd - r) * q) + off; }
        const int nig = WGM * nN, gid = wgid / nig, fm = gid * WGM, gsz = (nM - fm) < WGM ? (nM - fm) : WGM;
        u.pm = fm + ((wgid % nig) % gsz); u.pn = (wgid % nig) / gsz; u.e = 0; u.row0 = 0; u.ne = 0; return true;
    }
    __device__ __forceinline__ const char* a_ptr(const Unit& u) const { return A + (size_t)u.pm * tstep; }
    __device__ __forceinline__ const char* b_ptr(const Unit& u) const { return Bt + (size_t)u.pn * tstep; }
    __device__ __forceinline__ int a_row(const Unit&, int) const { return 0; }
};

template <class Epi, class Sched, bool ALIGN_EPI = true, bool SP2 = true>
__device__ __forceinline__ void gemm_phase(LAS unsigned char* lds, const int K, const Sched& S, const Epi& E) {
    const int tid = threadIdx.x, wid = __builtin_amdgcn_readfirstlane(tid >> 6), lane = tid & 63, wr = wid >> 2, wc = wid & 3, fr = lane & 15, fq = lane >> 4;
    const int nt = K / BK;
    unsigned voffA[2], voffB[2]; int RA[2];
#pragma unroll
    for (int i = 0; i < 2; ++i) { int R, C; stage_rc(tid * 16 + i * 8192, R, C); const int Rb = Epi::PERM ? ((R & ~31) + perm32(R & 31)) : R;
        voffA[i] = Sched::GATHER ? (unsigned)(C * 2) : (unsigned)(R * K + C) * 2u; voffB[i] = (unsigned)(Rb * K + C) * 2u; RA[i] = R; }
    const size_t kstep = (size_t)(BK * 2);
    const size_t hstep = (size_t)HALF * K * 2;
    const size_t hstepA = Sched::GATHER ? 0 : hstep;
    const unsigned ldsw = (unsigned)wid * 1024u;
    const int aoff = lds_byte(wr * 64 + fr, fq * 8), boff = lds_byte(wc * 32 + fr, fq * 8);
#define PG8_SA(b, h) (((b) * 2 + (h)) * HTB)
#define PG8_SB(b, h) ((4 + (b) * 2 + (h)) * HTB)
#define PG8_STAGE(bufoff, gbase, voff) do { _Pragma("unroll") for (int _i = 0; _i < 2; ++_i) \
        __builtin_amdgcn_global_load_lds((const unsigned*)((const char*)(gbase) + (voff)[_i]), (LAS unsigned*)(lds + (bufoff) + ldsw + _i * 8192), 16, 0, 0); } while (0)
#define PG8_LDA(dst, b, h) do { _Pragma("unroll") for (int m = 0; m < 4; ++m) _Pragma("unroll") for (int k = 0; k < 2; ++k) dst[m][k] = *(const LAS bf16x8*)(lds + PG8_SA(b, h) + aoff + m * 2048 + k * 1024); } while (0)
#define PG8_LDB(dst, b, h) do { _Pragma("unroll") for (int n = 0; n < 2; ++n) _Pragma("unroll") for (int k = 0; k < 2; ++k) dst[n][k] = *(const LAS bf16x8*)(lds + PG8_SB(b, h) + boff + n * 2048 + k * 1024); } while (0)
#define PG8_MMA(ai, bj, At, Bt) do { __builtin_amdgcn_s_setprio(1); _Pragma("unroll") for (int m = 0; m < 4; ++m) _Pragma("unroll") for (int n = 0; n < 2; ++n) _Pragma("unroll") for (int k = 0; k < 2; ++k) \
        acc[ai][bj][m][n] = __builtin_amdgcn_mfma_f32_16x16x32_bf16(Bt[n][k], At[m][k], acc[ai][bj][m][n], 0, 0, 0); __builtin_amdgcn_s_setprio(0); } while (0)
#define PG8_WAIT_V(n) asm volatile("s_waitcnt vmcnt(" #n ")" ::: "memory")
#define PG8_WAIT_L(n) asm volatile("s_waitcnt lgkmcnt(" #n ")" ::: "memory")
#define PG8_BAR __builtin_amdgcn_s_barrier()
#define PG8_SCHED __builtin_amdgcn_sched_barrier(0)
    Unit cur, nxt; int ui = 0;
    if (!S.next(0, cur)) return;
    f32x4 acc[2][2][4][2];
#pragma unroll
    for (int a = 0; a < 2; ++a)
#pragma unroll
        for (int b = 0; b < 2; ++b)
#pragma unroll
            for (int m = 0; m < 4; ++m)
#pragma unroll
                for (int n = 0; n < 2; ++n) acc[a][b][m][n] = (f32x4){0.f, 0.f, 0.f, 0.f};
    bf16x8 At[4][2], B0[2][2], B1[2][2];
    const char* cA = S.a_ptr(cur); const char* cB = S.b_ptr(cur);
    unsigned gC0[2], gC1[2], gN0[2], gN1[2];
#pragma unroll
    for (int i = 0; i < 2; ++i) {
        if constexpr (Sched::GATHER) { gC0[i] = voffA[i] + (unsigned)S.a_row(cur, RA[i]) * (unsigned)(K * 2); gC1[i] = voffA[i] + (unsigned)S.a_row(cur, HALF + RA[i]) * (unsigned)(K * 2); }
        else { gC0[i] = voffA[i]; gC1[i] = voffA[i]; }
        gN0[i] = gC0[i]; gN1[i] = gC1[i];
    }
    if constexpr (SP2) {
        PG8_STAGE(PG8_SB(0, 0), cB, voffB); PG8_STAGE(PG8_SB(0, 1), cB + hstep, voffB); PG8_STAGE(PG8_SA(0, 0), cA, gC0); PG8_STAGE(PG8_SA(0, 1), cA + hstepA, gC1);
        if (wr == 1) PG8_BAR;
        PG8_WAIT_V(2); PG8_BAR;
        PG8_STAGE(PG8_SB(1, 0), cB + kstep, voffB); PG8_STAGE(PG8_SA(1, 0), cA + kstep, gC0); PG8_STAGE(PG8_SB(1, 1), cB + hstep + kstep, voffB);
        PG8_WAIT_V(6); PG8_BAR;
    } else {
        PG8_STAGE(PG8_SB(0, 0), cB, voffB); PG8_STAGE(PG8_SA(0, 0), cA, gC0); PG8_STAGE(PG8_SB(0, 1), cB + hstep, voffB); PG8_STAGE(PG8_SA(0, 1), cA + hstepA, gC1);
        if (wr == 1) PG8_BAR;
        PG8_WAIT_V(4); PG8_BAR;
        PG8_STAGE(PG8_SB(1, 0), cB + kstep, voffB); PG8_STAGE(PG8_SA(1, 0), cA + kstep, gC0); PG8_STAGE(PG8_SB(1, 1), cB + hstep + kstep, voffB);
        PG8_WAIT_V(6); PG8_BAR;
    }
    for (;;) {
        const bool has_next = S.next(ui + 1, nxt);
        const char* nA = has_next ? S.a_ptr(nxt) : cA; const char* nB = has_next ? S.b_ptr(nxt) : cB;
        if constexpr (Sched::GATHER) {
#pragma unroll
            for (int i = 0; i < 2; ++i) {
                if (has_next) { gN0[i] = voffA[i] + (unsigned)S.a_row(nxt, RA[i]) * (unsigned)(K * 2); gN1[i] = voffA[i] + (unsigned)S.a_row(nxt, HALF + RA[i]) * (unsigned)(K * 2); }
                else { gN0[i] = gC0[i]; gN1[i] = gC1[i]; }
            }
        }
        for (int t = 0; t < nt; t += 2) {
            const bool last = (t == nt - 2);
            const char* a1 = cA + (size_t)(t + 1) * kstep;
            const char* a2 = last ? nA : cA + (size_t)(t + 2) * kstep; const char* b2 = last ? nB : cB + (size_t)(t + 2) * kstep;
            const char* a3 = a2 + kstep; const char* b3 = b2 + kstep;
            unsigned s0[2], s1[2];
#pragma unroll
            for (int i = 0; i < 2; ++i) { if constexpr (Sched::GATHER) { s0[i] = last ? gN0[i] : gC0[i]; s1[i] = last ? gN1[i] : gC1[i]; } else { s0[i] = gC0[i]; s1[i] = gC1[i]; } }
            if constexpr (SP2) {
            PG8_LDB(B0, 0, 0); PG8_LDB(B1, 0, 1); PG8_SCHED; PG8_LDA(At, 0, 0); PG8_STAGE(PG8_SA(1, 1), a1 + hstepA, gC1);
            PG8_WAIT_V(8); PG8_WAIT_L(0); PG8_BAR; PG8_MMA(0, 0, At, B0); PG8_MMA(0, 1, At, B1); PG8_BAR; PG8_SCHED;
            PG8_LDA(At, 0, 1); PG8_STAGE(PG8_SB(0, 0), b2, voffB); PG8_STAGE(PG8_SB(0, 1), b2 + hstep, voffB); PG8_STAGE(PG8_SA(0, 0), a2, s0);
            PG8_WAIT_V(8); PG8_WAIT_L(0); PG8_BAR; PG8_MMA(1, 0, At, B0); PG8_MMA(1, 1, At, B1); PG8_BAR; PG8_SCHED;
            PG8_LDB(B0, 1, 0); PG8_LDB(B1, 1, 1); PG8_SCHED; PG8_LDA(At, 1, 0); PG8_STAGE(PG8_SA(0, 1), a2 + hstepA, s1);
            PG8_WAIT_V(8); PG8_WAIT_L(0); PG8_BAR; PG8_MMA(0, 0, At, B0); PG8_MMA(0, 1, At, B1); PG8_BAR; PG8_SCHED;
            PG8_LDA(At, 1, 1); PG8_STAGE(PG8_SB(1, 0), b3, voffB); PG8_STAGE(PG8_SB(1, 1), b3 + hstep, voffB); PG8_STAGE(PG8_SA(1, 0), a3, s0);
            PG8_WAIT_V(8); PG8_WAIT_L(0); PG8_BAR; PG8_MMA(1, 0, At, B0); PG8_MMA(1, 1, At, B1); PG8_BAR; PG8_SCHED;
            } else {
            PG8_LDB(B0, 0, 0); PG8_SCHED; PG8_LDA(At, 0, 0); PG8_STAGE(PG8_SA(1, 1), a1 + hstepA, gC1);
            PG8_WAIT_L(8); PG8_BAR; PG8_WAIT_L(0); PG8_MMA(0, 0, At, B0); PG8_BAR; PG8_SCHED;
            PG8_LDB(B1, 0, 1); PG8_STAGE(PG8_SB(0, 0), b2, voffB);
            PG8_BAR; PG8_WAIT_L(0); PG8_MMA(0, 1, At, B1); PG8_BAR;
            PG8_LDA(At, 0, 1); PG8_STAGE(PG8_SA(0, 0), a2, s0);
            PG8_BAR; PG8_WAIT_L(0); PG8_MMA(1, 0, At, B0); PG8_BAR; PG8_SCHED;
            PG8_STAGE(PG8_SB(0, 1), b2 + hstep, voffB);
            PG8_WAIT_V(6); PG8_BAR; PG8_MMA(1, 1, At, B1); PG8_BAR;
            PG8_LDB(B0, 1, 0); PG8_SCHED; PG8_LDA(At, 1, 0); PG8_STAGE(PG8_SA(0, 1), a2 + hstepA, s1);
            PG8_WAIT_L(8); PG8_BAR; PG8_WAIT_L(0); PG8_MMA(0, 0, At, B0); PG8_BAR; PG8_SCHED;
            PG8_LDB(B1, 1, 1); PG8_STAGE(PG8_SB(1, 0), b3, voffB);
            PG8_BAR; PG8_WAIT_L(0); PG8_MMA(0, 1, At, B1); PG8_BAR;
            PG8_LDA(At, 1, 1); PG8_STAGE(PG8_SA(1, 0), a3, s0);
            PG8_BAR; PG8_WAIT_L(0); PG8_MMA(1, 0, At, B0); PG8_BAR; PG8_SCHED;
            PG8_STAGE(PG8_SB(1, 1), b3 + hstep, voffB);
            PG8_WAIT_V(6); PG8_BAR; PG8_MMA(1, 1, At, B1); PG8_BAR;
            }
        }
        if constexpr (ALIGN_EPI) { if (wr == 0) PG8_BAR; }
        E(acc, cur, wr, wc, fr, fq);
        if (!has_next) break;
#pragma unroll
        for (int a = 0; a < 2; ++a)
#pragma unroll
            for (int b = 0; b < 2; ++b)
#pragma unroll
                for (int m = 0; m < 4; ++m)
#pragma unroll
                    for (int n = 0; n < 2; ++n) acc[a][b][m][n] = (f32x4){0.f, 0.f, 0.f, 0.f};
        cur = nxt; cA = nA; cB = nB; ++ui;
#pragma unroll
        for (int i = 0; i < 2; ++i) { gC0[i] = gN0[i]; gC1[i] = gN1[i]; }
        if constexpr (ALIGN_EPI) { if (wr == 1) PG8_BAR; }
    }
    PG8_WAIT_V(0);
    if constexpr (!ALIGN_EPI) { if (wr == 0) PG8_BAR; }
    PG8_BAR;
#undef PG8_SA
#undef PG8_SB
#undef PG8_STAGE
#undef PG8_LDA
#undef PG8_LDB
#undef PG8_MMA
#undef PG8_WAIT_V
#undef PG8_WAIT_L
#undef PG8_BAR
#undef PG8_SCHED
}

struct EpiBf16 {
    static constexpr bool PERM = true;
    bf16_t* O; int ldc;
    __device__ __forceinline__ void operator()(const f32x4 (&acc)[2][2][4][2], const Unit& u, int wr, int wc, int fr, int fq) const {
        const int row0 = u.pm * BM + wr * 64 + fr, col0 = u.pn * BM + wc * 32 + 8 * fq;
#pragma unroll
        for (int ai = 0; ai < 2; ++ai)
#pragma unroll
            for (int m = 0; m < 4; ++m) { bf16_t* rowp = O + (size_t)(row0 + ai * HALF + m * 16) * ldc + col0;
#pragma unroll
                for (int bj = 0; bj < 2; ++bj) { const f32x4 v0 = acc[ai][bj][m][0], v1 = acc[ai][bj][m][1];
                    u32x4 w; w.x = cvt_pk_bf16(v0[0], v0[1]); w.y = cvt_pk_bf16(v0[2], v0[3]); w.z = cvt_pk_bf16(v1[0], v1[1]); w.w = cvt_pk_bf16(v1[2], v1[3]);
                    *(u32x4*)(rowp + bj * HALF) = w; } }
    }
};
struct EpiResF32 {
    static constexpr bool PERM = false;
    const float* base; float* C; int ldc;
    __device__ __forceinline__ void operator()(const f32x4 (&acc)[2][2][4][2], const Unit& u, int wr, int wc, int fr, int fq) const {
        const int row0 = u.pm * BM + wr * 64 + fr, col0 = u.pn * BM + wc * 32 + 4 * fq;
#pragma unroll
        for (int ai = 0; ai < 2; ++ai)
#pragma unroll
            for (int m = 0; m < 4; ++m) { const size_t off = (size_t)(row0 + ai * HALF + m * 16) * ldc + col0;
#pragma unroll
                for (int bj = 0; bj < 2; ++bj)
#pragma unroll
                    for (int n = 0; n < 2; ++n) *(f32x4*)(C + off + bj * HALF + n * 16) = *(const f32x4*)(base + off + bj * HALF + n * 16) + acc[ai][bj][m][n]; }
    }
};
}
#define RLX_AGENT __ATOMIC_RELAXED, __HIP_MEMORY_SCOPE_AGENT
#define XB_TMO      128
#define XB_XCNT(j)  (256  + 64 * (j))
#define XB_XSUB(j)  (1280 + 64 * (j))
#define XB_XGEN(j)  (2304 + 64 * (j))
#define XB_TOP      3328
#define XB_TOPGEN   3392
#define XCD_BAR_WORDS 3456
#define XB_SPIN_CAP (1u << 18)

__device__ __forceinline__ unsigned xb_ld(unsigned* p)              { return __hip_atomic_load(p, __ATOMIC_RELAXED, __HIP_MEMORY_SCOPE_AGENT); }
__device__ __forceinline__ unsigned xb_add(unsigned* p, unsigned v) { return __hip_atomic_fetch_add(p, v, __ATOMIC_RELAXED, __HIP_MEMORY_SCOPE_AGENT); }
__device__ __forceinline__ unsigned xb_xcc_id() { return (unsigned)__builtin_amdgcn_s_getreg((3 << 11) | 20) & 0xFu; }
#define XB_SPIN(cond, bar) do { unsigned _sp = 0; while (cond) { __builtin_amdgcn_s_sleep(1); \
    if ((++_sp & 255u) == 0u) { if (xb_ld(&(bar)[XB_TMO])) break; if (_sp > XB_SPIN_CAP) { atomicAdd(&(bar)[XB_TMO], 1u); break; } } } } while (0)

struct XcdBarrier {
    unsigned* bar; unsigned x;
    volatile LAS unsigned* st;
};

__device__ __forceinline__ XcdBarrier xcd_barrier_post(unsigned* bar, volatile LAS unsigned* st) {
    XcdBarrier b; b.bar = bar; b.x = xb_xcc_id(); b.st = st;
    if (threadIdx.x == 0) (void)xb_add(&bar[XB_XCNT(b.x)], 1u);
    return b;
}
__device__ __forceinline__ void xcd_barrier_complete(unsigned* bar, unsigned x, unsigned& nloc, unsigned& nx) {
    const unsigned G = gridDim.x * gridDim.y * gridDim.z;
    unsigned sum, cnt, mine, sp = 0u;
    for (;;) {
        sum = 0u; cnt = 0u; mine = 0u;
#pragma unroll
        for (unsigned j = 0; j < 16; ++j) { const unsigned c = xb_ld(&bar[XB_XCNT(j)]); sum += c; cnt += (c > 0u) ? 1u : 0u; mine = (j == x) ? c : mine; }
        if (sum == G) break;
        __builtin_amdgcn_s_sleep(1);
        if ((++sp & 255u) == 0u) { if (xb_ld(&bar[XB_TMO])) break; if (sp > XB_SPIN_CAP) { atomicAdd(&bar[XB_TMO], 1u); break; } }
    }
    nloc = mine > 0u ? mine : 1u; nx = cnt > 0u ? cnt : 1u;
}

__device__ __forceinline__ void xcd_barrier(const XcdBarrier& b) {
    asm volatile("s_waitcnt vmcnt(0)" ::: "memory");
    __syncthreads();
    if (threadIdx.x == 0) {
        unsigned* bar = b.bar;
        __builtin_amdgcn_s_waitcnt(0);
        unsigned nloc = b.st[0], nx = b.st[1];
        if (nloc == 0u) { xcd_barrier_complete(bar, b.x, nloc, nx); b.st[0] = nloc; b.st[1] = nx; }
        const unsigned old = xb_add(&bar[XB_XSUB(b.x)], 1u);
        const unsigned gen = old / nloc;
        if (old + 1u == (gen + 1u) * nloc) {
            __builtin_amdgcn_fence(__ATOMIC_RELEASE, "agent");
            asm volatile("s_waitcnt vmcnt(0)" ::: "memory");
            const unsigned og = xb_add(&bar[XB_TOP], 1u);
            const unsigned tg = og / nx;
            if (og + 1u == (tg + 1u) * nx) xb_add(&bar[XB_TOPGEN], 1u);
            else XB_SPIN(xb_ld(&bar[XB_TOPGEN]) == tg, bar);
            __builtin_amdgcn_fence(__ATOMIC_ACQUIRE, "agent");
            xb_add(&bar[XB_XGEN(b.x)], 1u);
            asm volatile("s_waitcnt vmcnt(0)" ::: "memory");
        } else {
            XB_SPIN(xb_ld(&bar[XB_XGEN(b.x)]) == gen, bar);
            __builtin_amdgcn_fence(__ATOMIC_ACQUIRE, "agent");
            asm volatile("s_waitcnt vmcnt(0)" ::: "memory");
        }
    }
    __syncthreads();
}

constexpr int NWAVES = 8, NTHREADS = 512;
constexpr int LDS_BYTES = 147456;
constexpr int NPHASES = 10;

constexpr int LDS_TAB = 131072;

struct MkArgs {
    const float* in[22]; float* out; unsigned char* ws; int ph_lo, ph_hi, flags, li;
};

__device__ __forceinline__ float wave_sum(float v) {
#pragma unroll
    for (int o = 1; o < 64; o <<= 1) v += __shfl_xor(v, o);
    return v;
}

__device__ __forceinline__ void transpose_item(const float* __restrict__ W, int ldw, int k0, int colA, int colB, bf16_t* __restrict__ WT, int Kdst, int drow0, LAS float* scr, int lane) {
    const int j = lane & 31; const int sc = j < 16 ? colA + j : colB + j - 16;
#pragma unroll 8
    for (int i = 0; i < 32; ++i) { const int kk = 2 * i + (lane >> 5); scr[kk * 33 + j] = W[(size_t)(k0 + kk) * ldw + sc]; }
    LDS_WAIT();
    const int c = lane & 7;
#pragma unroll
    for (int jj = 0; jj < 4; ++jj) { const int n = (lane >> 3) + 8 * jj; const LAS float* s = scr + (8 * c) * 33 + n;
        u32x4 o; o.x = cvt_pk_bf16(s[0 * 33], s[1 * 33]); o.y = cvt_pk_bf16(s[2 * 33], s[3 * 33]); o.z = cvt_pk_bf16(s[4 * 33], s[5 * 33]); o.w = cvt_pk_bf16(s[6 * 33], s[7 * 33]);
        *(u32x4*)(WT + (size_t)(drow0 + n) * Kdst + k0 + 8 * c) = o; }
    LDS_WAIT();
}

__device__ __forceinline__ void rms_row_to_bf16(const float* __restrict__ xrow, const float* __restrict__ w, bf16_t* __restrict__ orow, int lane) {
    const f32x4* xr = (const f32x4*)xrow + lane; const f32x4* wr = (const f32x4*)w + lane;
    f32x4 v[8]; float s = 0.f;
#pragma unroll
    for (int j = 0; j < 8; ++j) { v[j] = xr[64 * j]; s += (v[j].x * v[j].x + v[j].y * v[j].y) + (v[j].z * v[j].z + v[j].w * v[j].w); }
    const float r = rsqrtf(wave_sum(s) * (1.f / DM) + EPS);
    u32x2* o8 = (u32x2*)orow + lane;
#pragma unroll
    for (int j = 0; j < 8; ++j) { const f32x4 ww = wr[64 * j]; u32x2 o; o.x = cvt_pk_bf16(v[j].x * r * ww.x, v[j].y * r * ww.y); o.y = cvt_pk_bf16(v[j].z * r * ww.z, v[j].w * r * ww.w); o8[64 * j] = o; }
}

__device__ __forceinline__ void phase0(const MkArgs& a, LAS unsigned char* lds, int wave, int lane) {
    unsigned char* ws = a.ws;
    LAS float* scr = (LAS float*)(lds + wave * 16384);
    const int gw = blockIdx.x * NWAVES + wave, NGW = gridDim.x * NWAVES;
    bf16_t* WinT = (bf16_t*)(ws + WS_WINT); bf16_t* WsT = (bf16_t*)(ws + WS_WST); bf16_t* WoutT = (bf16_t*)(ws + WS_WOUTT);
    constexpr int I_IN = 32 * 192, I_S = 32, I_OUT = 32 * 64, NITEMS = I_IN + I_S + I_OUT;
    for (int it = gw; it < NITEMS; it += NGW) {
        int r = it;
        if (r < I_IN) { const int kb = r / 192, nb = r % 192, n0 = nb * 32; const int sc = win_col(n0); transpose_item(a.in[2], IN_DIM, kb * 64, sc, sc + 16, WinT, DM, n0, scr, lane); continue; } r -= I_IN;
        if (r < I_S) { transpose_item(a.in[2], IN_DIM, r * 64, WI_GK, WI_DT, WsT, DM, 0, scr, lane); continue; } r -= I_S;
        { const int kb = r / 64, nb = r % 64; transpose_item(a.in[12], DM, kb * 64, nb * 32, nb * 32 + 16, WoutT, DM, nb * 32, scr, lane); }
    }
    {
        bf16_t* WrT = (bf16_t*)(ws + WS_WRT);
        for (int idx = gw * 64 + lane; idx < 48 * DM; idx += NGW * 64) { const int n = idx / DM, k = idx % DM;
            const float v = a.in[13][k] * (n < 4 ? a.in[14][k * 4 + n] : (n < 36 ? a.in[16][k * 32 + n - 4] : 0.f));
            const bf16_t hi = f2bf(v); WrT[idx] = hi; WrT[48 * DM + idx] = f2bf(v - bf2f(hi)); }
    }
    bf16_t* hA = (bf16_t*)(ws + WS_HA);
    for (int m = gw; m < T_TOK; m += NGW) rms_row_to_bf16(a.in[0] + (size_t)m * DM, a.in[1], hA + (size_t)m * DM, lane);
}

__device__ __forceinline__ void skinny32_phase(const bf16_t* __restrict__ A, const bf16_t* __restrict__ BsT, float* __restrict__ out, LAS unsigned char* lds, int wave, int lane) {
    const int fr = lane & 15, fq = lane >> 4, mi = wave & 3, kh = wave >> 2;
    LAS f32x4* red = (LAS f32x4*)lds;
    for (int mt = blockIdx.x; mt < T_TOK / 64; mt += gridDim.x) {
        const bf16_t* ap = A + (size_t)(mt * 64 + mi * 16 + fr) * DM + kh * 1024 + fq * 8;
        const bf16_t* bp0 = BsT + (size_t)fr * DM + kh * 1024 + fq * 8;
        const bf16_t* bp1 = bp0 + (size_t)16 * DM;
        f32x4 acc0 = {0.f, 0.f, 0.f, 0.f}, acc1 = {0.f, 0.f, 0.f, 0.f};
#pragma unroll 8
        for (int ks = 0; ks < 32; ++ks) {
            const bf16x8 av = *(const bf16x8*)(ap + ks * 32), b0 = *(const bf16x8*)(bp0 + ks * 32), b1 = *(const bf16x8*)(bp1 + ks * 32);
            acc0 = __builtin_amdgcn_mfma_f32_16x16x32_bf16(av, b0, acc0, 0, 0, 0);
            acc1 = __builtin_amdgcn_mfma_f32_16x16x32_bf16(av, b1, acc1, 0, 0, 0);
        }
        if (kh == 1) { red[(mi * 2 + 0) * 64 + lane] = acc0; red[(mi * 2 + 1) * 64 + lane] = acc1; }
        __syncthreads();
        if (kh == 0) {
            acc0 += red[(mi * 2 + 0) * 64 + lane]; acc1 += red[(mi * 2 + 1) * 64 + lane];
#pragma unroll
            for (int j = 0; j < 4; ++j) { float* o = out + (size_t)(mt * 64 + mi * 16 + 4 * fq + j) * 32; o[fr] = acc0[j]; o[16 + fr] = acc1[j]; }
        }
        __syncthreads();
    }
}

__device__ __forceinline__ void phase1(const MkArgs& a, LAS unsigned char* lds, int wave, int lane) {
    unsigned char* ws = a.ws;
    const bf16_t* hA = (const bf16_t*)(ws + WS_HA);
    skinny32_phase(hA, (const bf16_t*)(ws + WS_WST), (float*)(ws + WS_SMALL), lds, wave, lane);
    pg8::StaticOrder S; S.init(hA, (const bf16_t*)(ws + WS_WINT), T_TOK, PJ, DM, gridDim.x, blockIdx.x);
    pg8::EpiBf16 E{(bf16_t*)(ws + WS_PROJ), PJ};
    pg8::gemm_phase<pg8::EpiBf16, pg8::StaticOrder>(lds, DM, S, E);
}

__device__ __forceinline__ void phase5(const MkArgs& a, LAS unsigned char* lds, float* x1) {
    unsigned char* ws = a.ws;
    pg8::StaticOrder S; S.init((const bf16_t*)(ws + WS_HA), (const bf16_t*)(ws + WS_WOUTT), T_TOK, DM, DM, gridDim.x, blockIdx.x);
    pg8::EpiResF32 E{a.in[0], x1, DM};
    pg8::gemm_phase<pg8::EpiResF32, pg8::StaticOrder>(lds, DM, S, E);
}


__device__ __forceinline__ void phase6(const MkArgs& a, LAS unsigned char* lds, const float* x1, int wave, int lane) {
    unsigned char* ws = a.ws;
    const int fr = lane & 15, fq = lane >> 4, mi = wave & 3, kh = wave >> 2;
    bf16_t* h2 = (bf16_t*)(ws + WS_HA);
    const bf16_t* WrT = (const bf16_t*)(ws + WS_WRT);
    float* rstd2 = (float*)(ws + WS_RSTD);
    int* cnt = (int*)(ws + WS_CTL); int* list = (int*)(ws + WS_LIST);
    int* tok_e = (int*)(ws + WS_TOKE); float* tok_w = (float*)(ws + WS_TOKW);
    LAS f32x4* red = (LAS f32x4*)lds;
    LAS float* redss = (LAS float*)(lds + 12288);
    LAS float* lg = (LAS float*)(lds + 12288 + 256);
    LAS float* ssum = (LAS float*)(lds + 12288 + 256 + 64 * 49 * 4);
    for (int mt = blockIdx.x; mt < T_TOK / 64; mt += gridDim.x) {
        const int row = mt * 64 + mi * 16 + fr;
        const float* xp = x1 + (size_t)row * DM + kh * 1024 + fq * 8;
        const float* wn = a.in[13] + kh * 1024 + fq * 8;
        bf16_t* hp = h2 + (size_t)row * DM + kh * 1024 + fq * 8;
        const bf16_t* bp = WrT + (size_t)fr * DM + kh * 1024 + fq * 8;
        f32x4 acc[3]; for (int n = 0; n < 3; ++n) acc[n] = (f32x4){0.f, 0.f, 0.f, 0.f};
        float ss = 0.f;
#pragma unroll 4
        for (int ks = 0; ks < 32; ++ks) {
            const f32x4 xa = *(const f32x4*)(xp + ks * 32), xb = *(const f32x4*)(xp + ks * 32 + 4);
            const f32x4 wa = *(const f32x4*)(wn + ks * 32), wb = *(const f32x4*)(wn + ks * 32 + 4);
            ss += (xa.x * xa.x + xa.y * xa.y) + (xa.z * xa.z + xa.w * xa.w) + (xb.x * xb.x + xb.y * xb.y) + (xb.z * xb.z + xb.w * xb.w);
            u32x4 hu; hu.x = cvt_pk_bf16(xa.x * wa.x, xa.y * wa.y); hu.y = cvt_pk_bf16(xa.z * wa.z, xa.w * wa.w); hu.z = cvt_pk_bf16(xb.x * wb.x, xb.y * wb.y); hu.w = cvt_pk_bf16(xb.z * wb.z, xb.w * wb.w);
            *(u32x4*)(hp + ks * 32) = hu;
            u32x4 hi; hi.x = cvt_pk_bf16(xa.x, xa.y); hi.y = cvt_pk_bf16(xa.z, xa.w); hi.z = cvt_pk_bf16(xb.x, xb.y); hi.w = cvt_pk_bf16(xb.z, xb.w);
            u32x4 lo;
            lo.x = cvt_pk_bf16(xa.x - __uint_as_float(hi.x << 16), xa.y - __uint_as_float(hi.x & 0xffff0000u));
            lo.y = cvt_pk_bf16(xa.z - __uint_as_float(hi.y << 16), xa.w - __uint_as_float(hi.y & 0xffff0000u));
            lo.z = cvt_pk_bf16(xb.x - __uint_as_float(hi.z << 16), xb.y - __uint_as_float(hi.z & 0xffff0000u));
            lo.w = cvt_pk_bf16(xb.z - __uint_as_float(hi.w << 16), xb.w - __uint_as_float(hi.w & 0xffff0000u));
            const bf16x8 ah = __builtin_bit_cast(bf16x8, hi), al = __builtin_bit_cast(bf16x8, lo);
#pragma unroll
            for (int n = 0; n < 3; ++n) {
                const bf16x8 bh = *(const bf16x8*)(bp + (size_t)n * 16 * DM + ks * 32), bl = *(const bf16x8*)(bp + (size_t)(48 + n * 16) * DM + ks * 32);
                acc[n] = __builtin_amdgcn_mfma_f32_16x16x32_bf16(ah, bh, acc[n], 0, 0, 0);
                acc[n] = __builtin_amdgcn_mfma_f32_16x16x32_bf16(al, bh, acc[n], 0, 0, 0);
                acc[n] = __builtin_amdgcn_mfma_f32_16x16x32_bf16(ah, bl, acc[n], 0, 0, 0);
            }
        }
        ss += __shfl_xor(ss, 16); ss += __shfl_xor(ss, 32);
        if (kh == 1) { for (int n = 0; n < 3; ++n) red[(mi * 3 + n) * 64 + lane] = acc[n]; if (fq == 0) redss[mi * 16 + fr] = ss; }
        __syncthreads();
        if (kh == 0) {
            for (int n = 0; n < 3; ++n) { acc[n] += red[(mi * 3 + n) * 64 + lane];
#pragma unroll
                for (int j = 0; j < 4; ++j) lg[(mi * 16 + 4 * fq + j) * 49 + n * 16 + fr] = acc[n][j]; }
            if (fq == 0) ssum[mi * 16 + fr] = ss + redss[mi * 16 + fr];
        }
        __syncthreads();
        if (wave == 0) {
            const int t = mt * 64 + lane;
            const float r = rsqrtf(ssum[lane] * (1.f / DM) + EPS);
            rstd2[t] = r;
            const LAS float* l = lg + lane * 49;
            float gm = -1e30f; int gi = 0; float gl[4];
#pragma unroll
            for (int j = 0; j < 4; ++j) { gl[j] = l[j] * r + a.in[15][j]; if (gl[j] > gm) { gm = gl[j]; gi = j; } }
            float gs = 0.f;
#pragma unroll
            for (int j = 0; j < 4; ++j) gs += __expf(gl[j] - gm);
            const float gw_ = 1.f / gs;
            float m0 = -1e30f, m1 = -1e30f; int i0 = 0, i1 = 0;
            for (int j = 0; j < 8; ++j) { const float v = l[4 + gi * 8 + j] * r + a.in[17][gi * 8 + j];
                if (v > m0) { m1 = m0; i1 = i0; m0 = v; i0 = j; } else if (v > m1) { m1 = v; i1 = j; } }
            const float e1 = __expf(m1 - m0);
            const float w0 = gw_ / (1.f + e1), w1 = gw_ * e1 / (1.f + e1);
            const int ex0 = gi * 8 + i0, ex1 = gi * 8 + i1;
            tok_e[t * 2] = ex0; tok_e[t * 2 + 1] = ex1; tok_w[t * 2] = w0; tok_w[t * 2 + 1] = w1;
            const int p0 = atomicAdd(&cnt[ex0], 1); list[ex0 * T_TOK + p0] = t * 2;
            const int p1 = atomicAdd(&cnt[ex1], 1); list[ex1 * T_TOK + p1] = t * 2 + 1;
        }
        __syncthreads();
    }
    LAS float* scr = (LAS float*)(lds + 32768 + wave * 8704);
    const int gw = blockIdx.x * NWAVES + wave, NGW = gridDim.x * NWAVES;
    bf16_t* WguT = (bf16_t*)(ws + WS_WGUT); bf16_t* WdT = (bf16_t*)(ws + WS_WDT);
    constexpr int I_G = 32 * 32 * 16, I_D = 32 * 8 * 64;
    for (int it = gw; it < 2 * I_G + I_D; it += NGW) {
        int r = it;
        if (r < 2 * I_G) { const int up = r >= I_G; if (up) r -= I_G; const int e = r / 512, q = r % 512, kb = q / 16, nb = q % 16, n0 = nb * 32;
            const float* W = (up ? a.in[19] : a.in[18]) + (size_t)e * DM * DEXP;
            transpose_item(W, DEXP, kb * 64, n0, n0 + 16, WguT, DM, e * 1024 + (n0 >> 7) * 256 + up * 128 + (n0 & 127), scr, lane); continue; }
        r -= 2 * I_G;
        { const int e = r / 512, q = r % 512, kb = q / 64, nb = q % 64, n0 = nb * 32;
          transpose_item(a.in[20] + (size_t)e * DEXP * DM, DM, kb * 64, n0, n0 + 16, WdT, DEXP, e * DM + n0, scr, lane); }
    }
}

template <bool GATHER_T>
struct MoeOrderT {
    static constexpr bool GATHER = GATHER_T;
    const char* A; const char* Bt; const int* list; const LAS int* tab; int NT, K, G, c, nwg; size_t bstride;
    __device__ bool next(int i, pg8::Unit& u) const {
        const long L = (long)i * G + c; if (L >= nwg) return false;
        int wgid = (int)L; { const int q = nwg / 8, r = nwg % 8, xcd = wgid % 8, off = wgid / 8; wgid = (xcd < r ? xcd * (q + 1) : r * (q + 1) + (xcd - r) * q) + off; }
        int e = 0;
        for (; e < 31; ++e) { const int te = __builtin_amdgcn_readfirstlane(tab[33 + e] - tab[32 + e]); if (wgid < te * NT) break; wgid -= te * NT; }
        const int te = __builtin_amdgcn_readfirstlane(tab[33 + e] - tab[32 + e]), tp = __builtin_amdgcn_readfirstlane(tab[32 + e]);
        const int pn = wgid / te, mt = wgid % te;
        u.pm = tp + mt; u.pn = pn; u.e = e; u.row0 = mt * 256; u.ne = __builtin_amdgcn_readfirstlane(tab[e]); return true;
    }
    __device__ __forceinline__ const char* a_ptr(const pg8::Unit& u) const { return GATHER ? A : A + (size_t)u.pm * 256 * K * 2; }
    __device__ __forceinline__ const char* b_ptr(const pg8::Unit& u) const { return Bt + (size_t)u.e * bstride + (size_t)u.pn * 256 * K * 2; }
    __device__ __forceinline__ int a_row(const pg8::Unit& u, int r) const { const int rr = u.row0 + r; return rr < u.ne ? (list[(size_t)u.e * T_TOK + rr] >> 1) : 0; }
};
__device__ __forceinline__ int moe_tables(const int* cnt, LAS int* tab) {
    if (threadIdx.x < 32) tab[threadIdx.x] = __hip_atomic_load(cnt + threadIdx.x, __ATOMIC_RELAXED, __HIP_MEMORY_SCOPE_AGENT);
    __syncthreads();
    if (threadIdx.x == 0) { int p = 0; for (int e = 0; e < 32; ++e) { tab[32 + e] = p; p += (tab[e] + 255) >> 8; } tab[64] = p; }
    __syncthreads();
    return __builtin_amdgcn_readfirstlane(tab[64]);
}
struct EpiSwiGLU {
    static constexpr bool PERM = true;
    bf16_t* H; const int* list; const float* rstd;
    __device__ __forceinline__ void operator()(const f32x4 (&acc)[2][2][4][2], const pg8::Unit& u, int wr, int wc, int fr, int fq) const {
#pragma unroll
        for (int ai = 0; ai < 2; ++ai)
#pragma unroll
            for (int m = 0; m < 4; ++m) { const int rt = ai * 128 + wr * 64 + m * 16 + fr; const int rr = u.row0 + rt;
                const float rs = rr < u.ne ? rstd[list[(size_t)u.e * T_TOK + rr] >> 1] : 0.f;
                const f32x4 g0 = acc[ai][0][m][0] * rs, g1 = acc[ai][0][m][1] * rs, u0 = acc[ai][1][m][0] * rs, u1 = acc[ai][1][m][1] * rs;
                float h[8];
#pragma unroll
                for (int j = 0; j < 4; ++j) { h[j] = g0[j] / (1.f + __expf(-g0[j])) * u0[j]; h[4 + j] = g1[j] / (1.f + __expf(-g1[j])) * u1[j]; }
                u32x4 w; w.x = cvt_pk_bf16(h[0], h[1]); w.y = cvt_pk_bf16(h[2], h[3]); w.z = cvt_pk_bf16(h[4], h[5]); w.w = cvt_pk_bf16(h[6], h[7]);
                *(u32x4*)(H + (size_t)(u.pm * 256 + rt) * DEXP + u.pn * 128 + wc * 32 + 8 * fq) = w; }
    }
};
struct EpiDown {
    static constexpr bool PERM = true;
    bf16_t* Y; const int* list;
    __device__ __forceinline__ void operator()(const f32x4 (&acc)[2][2][4][2], const pg8::Unit& u, int wr, int wc, int fr, int fq) const {
#pragma unroll
        for (int ai = 0; ai < 2; ++ai)
#pragma unroll
            for (int m = 0; m < 4; ++m) { const int rr = u.row0 + ai * 128 + wr * 64 + m * 16 + fr;
                if (rr < u.ne) { const int slot = list[(size_t)u.e * T_TOK + rr]; bf16_t* rowp = Y + (size_t)slot * DM + u.pn * 256 + wc * 32 + 8 * fq;
#pragma unroll
                    for (int bj = 0; bj < 2; ++bj) { const f32x4 v0 = acc[ai][bj][m][0], v1 = acc[ai][bj][m][1];
                        u32x4 w; w.x = cvt_pk_bf16(v0[0], v0[1]); w.y = cvt_pk_bf16(v0[2], v0[3]); w.z = cvt_pk_bf16(v1[0], v1[1]); w.w = cvt_pk_bf16(v1[2], v1[3]);
                        *(u32x4*)(rowp + bj * 128) = w; } } }
    }
};
__device__ __forceinline__ void phase7(const MkArgs& a, LAS unsigned char* lds) {
    unsigned char* ws = a.ws;
    LAS int* tab = (LAS int*)(lds + LDS_TAB);
    const int tiles = moe_tables((const int*)(ws + WS_CTL), tab);
    MoeOrderT<true> S; S.A = (const char*)(ws + WS_HA); S.Bt = (const char*)(ws + WS_WGUT); S.list = (const int*)(ws + WS_LIST); S.tab = tab; S.NT = 4; S.K = DM; S.G = gridDim.x; S.c = blockIdx.x; S.nwg = tiles * 4; S.bstride = (size_t)1024 * DM * 2;
    EpiSwiGLU E{(bf16_t*)(ws + WS_HMID), (const int*)(ws + WS_LIST), (const float*)(ws + WS_RSTD)};
    pg8::gemm_phase<EpiSwiGLU, MoeOrderT<true>>(lds, DM, S, E);
}
__device__ __forceinline__ void phase8(const MkArgs& a, LAS unsigned char* lds) {
    unsigned char* ws = a.ws;
    LAS int* tab = (LAS int*)(lds + LDS_TAB);
    const int tiles = moe_tables((const int*)(ws + WS_CTL), tab);
    MoeOrderT<false> S; S.A = (const char*)(ws + WS_HMID); S.Bt = (const char*)(ws + WS_WDT); S.list = (const int*)(ws + WS_LIST); S.tab = tab; S.NT = 8; S.K = DEXP; S.G = gridDim.x; S.c = blockIdx.x; S.nwg = tiles * 8; S.bstride = (size_t)DM * DEXP * 2;
    EpiDown E{(bf16_t*)(ws + WS_Y), (const int*)(ws + WS_LIST)};
    pg8::gemm_phase<EpiDown, MoeOrderT<false>>(lds, DEXP, S, E);
}
__device__ __forceinline__ void phase9(const MkArgs& a, int wave, int lane) {
    unsigned char* ws = a.ws;
    const bf16_t* Y = (const bf16_t*)(ws + WS_Y); const float* tok_w = (const float*)(ws + WS_TOKW);
    const int gw = blockIdx.x * NWAVES + wave, NGW = gridDim.x * NWAVES;
    for (int t = gw; t < T_TOK; t += NGW) {
        const float w0 = tok_w[t * 2], w1 = tok_w[t * 2 + 1];
        f32x4* xr = (f32x4*)(a.out + (size_t)t * DM) + lane;
        const u32x2* y0 = (const u32x2*)(Y + (size_t)(t * 2) * DM) + lane; const u32x2* y1 = (const u32x2*)(Y + (size_t)(t * 2 + 1) * DM) + lane;
        const f32x4* wf = (const f32x4*)a.in[21] + lane;
        f32x4 v[8]; float s = 0.f;
#pragma unroll
        for (int j = 0; j < 8; ++j) { v[j] = xr[64 * j]; const u32x2 p = y0[64 * j], q = y1[64 * j];
            v[j].x += w0 * __uint_as_float(p.x << 16) + w1 * __uint_as_float(q.x << 16);
            v[j].y += w0 * __uint_as_float(p.x & 0xffff0000u) + w1 * __uint_as_float(q.x & 0xffff0000u);
            v[j].z += w0 * __uint_as_float(p.y << 16) + w1 * __uint_as_float(q.y << 16);
            v[j].w += w0 * __uint_as_float(p.y & 0xffff0000u) + w1 * __uint_as_float(q.y & 0xffff0000u);
            s += (v[j].x * v[j].x + v[j].y * v[j].y) + (v[j].z * v[j].z + v[j].w * v[j].w); }
        const float r = rsqrtf(wave_sum(s) * (1.f / DM) + EPS);
#pragma unroll
        for (int j = 0; j < 8; ++j) { const f32x4 ww = wf[64 * j]; xr[64 * j] = (f32x4){v[j].x * r * ww.x, v[j].y * r * ww.y, v[j].z * r * ww.z, v[j].w * r * ww.w}; }
    }
}

__device__ __forceinline__ bf16x8 ldfrag(const LAS bf16_t* base, int stride, int r0, int k0, int fr, int fq) {
    return *(const LAS bf16x8*)(base + (r0 + fr) * stride + k0 + fq * 8);
}
#define MFMA16(X, Y, C) __builtin_amdgcn_mfma_f32_16x16x32_bf16((X), (Y), (C), 0, 0, 0)
__device__ __forceinline__ u32x2 pack4(f32x4 v) { u32x2 o; o.x = cvt_pk_bf16(v[0], v[1]); o.y = cvt_pk_bf16(v[2], v[3]); return o; }
__device__ __forceinline__ float bflo(unsigned u) { return __uint_as_float(u << 16); }
__device__ __forceinline__ float bfhi(unsigned u) { return __uint_as_float(u & 0xffff0000u); }

template <class SC>
__device__ __forceinline__ void load_transposed(const bf16_t* __restrict__ src, size_t ld, int ntp, int ncol8, LAS unsigned* dst32, int dstride32, int tid, SC scale) {
    for (int u = tid; u < ntp * ncol8; u += NTHREADS) {
        const int tp = u % ntp, cg = u / ntp;
        const bf16_t* p = src + (size_t)(2 * tp) * ld + cg * 8;
        const u32x4 r0 = *(const u32x4*)p, r1 = *(const u32x4*)(p + ld);
        const float s0 = scale(2 * tp, cg), s1 = scale(2 * tp + 1, cg);
#pragma unroll
        for (int i = 0; i < 4; ++i) {
            dst32[(cg * 8 + 2 * i) * dstride32 + tp] = cvt_pk_bf16(bflo(r0[i]) * s0, bflo(r1[i]) * s1);
            dst32[(cg * 8 + 2 * i + 1) * dstride32 + tp] = cvt_pk_bf16(bfhi(r0[i]) * s0, bfhi(r1[i]) * s1);
        }
    }
}
struct NoScale { __device__ __forceinline__ float operator()(int, int) const { return 1.f; } };


typedef short s16x4 __attribute__((ext_vector_type(4)));
__device__ __forceinline__ bf16x8 ldfrag_tr(const LAS bf16_t* T, int stride, int k0, int c0, int lane) {
    const int idx = lane & 15, q = idx >> 2, p = idx & 3, fq = lane >> 4;
    const LAS bf16_t* ptr = T + (k0 + 8 * fq + q) * stride + c0 + 4 * p;
    const s16x4 lo = __builtin_amdgcn_ds_read_tr16_b64_v4i16((LAS s16x4*)ptr), hi = __builtin_amdgcn_ds_read_tr16_b64_v4i16((LAS s16x4*)(ptr + 4 * stride));
    return (bf16x8){lo[0], lo[1], lo[2], lo[3], hi[0], hi[1], hi[2], hi[3]};
}
__device__ __forceinline__ float fast_logsigmoid(float g) { return fminf(g, 0.f) - __logf(1.f + __expf(-fabsf(g))); }
__device__ __forceinline__ float fast_silu(float v) { return v * __builtin_amdgcn_rcpf(1.f + __expf(-v)); }
__device__ __forceinline__ void unpack8(u32x4 r, float (&f)[8]) { f[0] = bflo(r.x); f[1] = bfhi(r.x); f[2] = bflo(r.y); f[3] = bfhi(r.y); f[4] = bflo(r.z); f[5] = bfhi(r.z); f[6] = bflo(r.w); f[7] = bfhi(r.w); }
__device__ __forceinline__ u32x4 pack8(const float (&f)[8]) { u32x4 w; w.x = cvt_pk_bf16(f[0], f[1]); w.y = cvt_pk_bf16(f[2], f[3]); w.z = cvt_pk_bf16(f[4], f[5]); w.w = cvt_pk_bf16(f[6], f[7]); return w; }

__device__ __forceinline__ void gla_p2_item(const MkArgs& a, LAS unsigned char* lds, int item, int tid, int wave, int lane) {
    unsigned char* ws = a.ws;
    const int c = item & 63, bh = item >> 6, h = bh & 3, b = bh >> 2;
    const size_t t0 = (size_t)b * SEQ + c * 64;
    const bf16_t* proj = (const bf16_t*)(ws + WS_PROJ); const float* small = (const float*)(ws + WS_SMALL);
    bf16_t* QT = (bf16_t*)(ws + WS_QT); bf16_t* KT = (bf16_t*)(ws + WS_KT); bf16_t* GS = (bf16_t*)(ws + WS_GS); float* GDEC = (float*)(ws + WS_GDEC);
    LAS bf16_t* vS = (LAS bf16_t*)(lds);
    LAS bf16_t* kd = (LAS bf16_t*)(lds + 33792);
    LAS float* Gs = (LAS float*)(lds + 51200);
    LAS float* gk = (LAS float*)(lds + 84992);
    LAS float* part = (LAS float*)(lds + 89088);
    LAS float* tot = (LAS float*)(lds + 91136);
    float gkv[2]; u32x4 vv[4], qv[2], kv[2];
#pragma unroll
    for (int i = 0; i < 2; ++i) { const int u = tid + i * NTHREADS; gkv[i] = small[(t0 + (u >> 4)) * 32 + (u & 15)]; }
#pragma unroll
    for (int i = 0; i < 4; ++i) { const int u = tid + i * NTHREADS, t = u >> 5, c8 = u & 31; vv[i] = *(const u32x4*)(proj + (t0 + t) * PJ + PV + h * 256 + c8 * 8); }
#pragma unroll
    for (int i = 0; i < 2; ++i) { const int u = tid + i * NTHREADS, t = u >> 4, d8 = u & 15;
        qv[i] = *(const u32x4*)(proj + (t0 + t) * PJ + PQ + h * 128 + d8 * 8); kv[i] = *(const u32x4*)(proj + (t0 + t) * PJ + PK + h * 128 + d8 * 8); }
    const int d = tid & 127, tq = tid >> 7;
    float wg[16];
#pragma unroll
    for (int r = 0; r < 16; ++r) wg[r] = a.in[3][r * 512 + h * 128 + d];
    const float bias = a.in[4][h * 128 + d];
#pragma unroll
    for (int i = 0; i < 2; ++i) gk[tid + i * NTHREADS] = gkv[i];
#pragma unroll
    for (int i = 0; i < 4; ++i) { const int u = tid + i * NTHREADS, t = u >> 5, c8 = u & 31; *(LAS u32x4*)(vS + t * 264 + c8 * 8) = vv[i]; }
    __syncthreads();
    float G[16]; float run = 0.f;
#pragma unroll
    for (int i = 0; i < 16; ++i) { const int t = tq * 16 + i; float g = bias;
#pragma unroll
        for (int r4 = 0; r4 < 4; ++r4) { const f32x4 gv = *(const LAS f32x4*)(gk + t * 16 + r4 * 4);
            g += gv[0] * wg[r4 * 4] + gv[1] * wg[r4 * 4 + 1] + gv[2] * wg[r4 * 4 + 2] + gv[3] * wg[r4 * 4 + 3]; }
        run += fast_logsigmoid(g) * (1.f / 16.f); G[i] = run; }
    part[tq * 128 + d] = run;
    __syncthreads();
    {   float off = 0.f, total = 0.f;
#pragma unroll
        for (int q = 0; q < 4; ++q) { const float pv = part[q * 128 + d]; total += pv; if (q < tq) off += pv; }
#pragma unroll
        for (int i = 0; i < 16; ++i) Gs[(tq * 16 + i) * 132 + d] = G[i] + off;
        if (tq == 0) { tot[d] = total; GDEC[item * 128 + d] = __expf(total); } }
    __syncthreads();
    const float scale = 0.08838834764831845f;
#pragma unroll
    for (int i = 0; i < 2; ++i) { const int u = tid + i * NTHREADS, t = u >> 4, d8 = u & 15;
        const f32x4 g0 = *(const LAS f32x4*)(Gs + t * 132 + d8 * 8), g1 = *(const LAS f32x4*)(Gs + t * 132 + d8 * 8 + 4);
        const f32x4 z0 = *(const LAS f32x4*)(tot + d8 * 8), z1 = *(const LAS f32x4*)(tot + d8 * 8 + 4);
        float q[8], k[8], qo[8], ko[8], kdo[8]; unpack8(qv[i], q); unpack8(kv[i], k);
#pragma unroll
        for (int j = 0; j < 8; ++j) { const float Gj = j < 4 ? g0[j] : g1[j - 4], Tj = j < 4 ? z0[j] : z1[j - 4];
            qo[j] = q[j] * scale * __expf(Gj); ko[j] = k[j] * __expf(-Gj); kdo[j] = k[j] * __expf(Tj - Gj); }
        *(u32x4*)(QT + (t0 + t) * 512 + h * 128 + d8 * 8) = pack8(qo);
        *(u32x4*)(KT + (t0 + t) * 512 + h * 128 + d8 * 8) = pack8(ko);
        *(LAS u32x4*)(kd + t * 136 + d8 * 8) = pack8(kdo); }
    __syncthreads();
    const int fr = lane & 15, fq = lane >> 4;
    bf16_t* gs = GS + (size_t)item * 32768;
#pragma unroll
    for (int et = 0; et < 2; ++et) {
        const int e0 = wave * 32 + et * 16;
        const bf16x8 y0 = ldfrag_tr(vS, 264, 0, e0, lane), y1 = ldfrag_tr(vS, 264, 32, e0, lane);
#pragma unroll
        for (int dt_ = 0; dt_ < 8; ++dt_) {
            f32x4 acc = {0.f, 0.f, 0.f, 0.f};
            acc = MFMA16(ldfrag_tr(kd, 136, 0, dt_ * 16, lane), y0, acc);
            acc = MFMA16(ldfrag_tr(kd, 136, 32, dt_ * 16, lane), y1, acc);
            *(u32x2*)(gs + (e0 + fr) * 128 + dt_ * 16 + 4 * fq) = pack4(acc);
        }
    }
    __syncthreads();
}
__device__ __forceinline__ void scan_phase(const MkArgs& a, int flags) {
    unsigned char* ws = a.ws;
    const int u = blockIdx.x * NTHREADS + threadIdx.x, NU = gridDim.x * NTHREADS;
    if (flags & 1) {
        bf16_t* GS = (bf16_t*)(ws + WS_GS); const float* GDEC = (const float*)(ws + WS_GDEC);
        for (int v = u; v < 16 * 8192; v += NU) {
            const int bh = v >> 13, rem = v & 8191, e = rem >> 5, d0 = (rem & 31) * 4;
            f32x4 S = {0.f, 0.f, 0.f, 0.f};
            for (int c0 = 0; c0 < 64; c0 += 8) {
                u32x2 loc[8]; f32x4 dec[8];
#pragma unroll
                for (int i = 0; i < 8; ++i) { const int item = bh * 64 + c0 + i; loc[i] = *(const u32x2*)(GS + (size_t)item * 32768 + e * 128 + d0); dec[i] = *(const f32x4*)(GDEC + item * 128 + d0); }
#pragma unroll
                for (int i = 0; i < 8; ++i) { const int item = bh * 64 + c0 + i; *(u32x2*)(GS + (size_t)item * 32768 + e * 128 + d0) = pack4(S);
                    S = S * dec[i] + (f32x4){bflo(loc[i].x), bfhi(loc[i].x), bflo(loc[i].y), bfhi(loc[i].y)}; }
            }
        }
    }
    if (flags & 2) {
        bf16_t* SS = (bf16_t*)(ws + WS_SS); const float* ACS = (const float*)(ws + WS_ACS);
        for (int v = u; v < 64 * 2048; v += NU) {
            const int bhd = v >> 11, rem = v & 2047, b = bhd >> 4, head = bhd & 15;
            f32x4 S = {0.f, 0.f, 0.f, 0.f};
            for (int c0 = 0; c0 < 32; c0 += 8) {
                u32x2 loc[8]; float dec[8];
#pragma unroll
                for (int i = 0; i < 8; ++i) { const int c = c0 + i; const size_t item = ((size_t)b * 32 + c) * 16 + head; loc[i] = *(const u32x2*)(SS + item * 8192 + rem * 4);
                    dec[i] = __expf(ACS[((size_t)b * SEQ + c * 128 + 127) * 16 + head]); }
#pragma unroll
                for (int i = 0; i < 8; ++i) { const int c = c0 + i; const size_t item = ((size_t)b * 32 + c) * 16 + head; *(u32x2*)(SS + item * 8192 + rem * 4) = pack4(S);
                    S = S * dec[i] + (f32x4){bflo(loc[i].x), bfhi(loc[i].x), bflo(loc[i].y), bfhi(loc[i].y)}; }
            }
        }
    }
}


__device__ __forceinline__ void gla_p4_item(const MkArgs& a, LAS unsigned char* lds, int item, int tid, int wave, int lane) {
    unsigned char* ws = a.ws;
    const int c = item & 63, bh = item >> 6, h = bh & 3, b = bh >> 2;
    const size_t t0 = (size_t)b * SEQ + c * 64;
    const bf16_t* proj = (const bf16_t*)(ws + WS_PROJ);
    const bf16_t* QT = (const bf16_t*)(ws + WS_QT); const bf16_t* KT = (const bf16_t*)(ws + WS_KT); const bf16_t* gs = (const bf16_t*)(ws + WS_GS) + (size_t)item * 32768;
    bf16_t* mix = (bf16_t*)(ws + WS_HA);
    LAS bf16_t* qs = (LAS bf16_t*)(lds);
    LAS bf16_t* ks = (LAS bf16_t*)(lds + 17408);
    LAS bf16_t* vS = (LAS bf16_t*)(lds + 34816);
    LAS bf16_t* P = (LAS bf16_t*)(lds + 68608);
    LAS float* red = (LAS float*)(lds + 77824);
    const int fr = lane & 15, fq = lane >> 4;
    u32x4 vv[4], qv[2], kv[2];
#pragma unroll
    for (int i = 0; i < 4; ++i) { const int u = tid + i * NTHREADS, t = u >> 5, c8 = u & 31; vv[i] = *(const u32x4*)(proj + (t0 + t) * PJ + PV + h * 256 + c8 * 8); }
#pragma unroll
    for (int i = 0; i < 2; ++i) { const int u = tid + i * NTHREADS, t = u >> 4, d8 = u & 15;
        qv[i] = *(const u32x4*)(QT + (t0 + t) * 512 + h * 128 + d8 * 8); kv[i] = *(const u32x4*)(KT + (t0 + t) * 512 + h * 128 + d8 * 8); }
    bf16x8 sx[2][4];
#pragma unroll
    for (int et = 0; et < 2; ++et)
#pragma unroll
        for (int kk = 0; kk < 4; ++kk) sx[et][kk] = *(const bf16x8*)(gs + (wave * 32 + et * 16 + fr) * 128 + kk * 32 + fq * 8);
    u32x2 gg[4][2];
#pragma unroll
    for (int mt = 0; mt < 4; ++mt)
#pragma unroll
        for (int et = 0; et < 2; ++et) gg[mt][et] = *(const u32x2*)(proj + (t0 + mt * 16 + fr) * PJ + PG + h * 256 + wave * 32 + et * 16 + 4 * fq);
#pragma unroll
    for (int i = 0; i < 4; ++i) { const int u = tid + i * NTHREADS, t = u >> 5, c8 = u & 31; *(LAS u32x4*)(vS + t * 264 + c8 * 8) = vv[i]; }
#pragma unroll
    for (int i = 0; i < 2; ++i) { const int u = tid + i * NTHREADS, t = u >> 4, d8 = u & 15; *(LAS u32x4*)(qs + t * 136 + d8 * 8) = qv[i]; *(LAS u32x4*)(ks + t * 136 + d8 * 8) = kv[i]; }
    __syncthreads();
    {
        const int it = wave >> 1;
#pragma unroll
        for (int jj_ = 0; jj_ < 2; ++jj_) { const int jt = (wave & 1) * 2 + jj_;
            f32x4 acc = {0.f, 0.f, 0.f, 0.f};
            if (jt <= it) {
#pragma unroll
                for (int kk = 0; kk < 4; ++kk) acc = MFMA16(ldfrag(ks, 136, jt * 16, kk * 32, fr, fq), ldfrag(qs, 136, it * 16, kk * 32, fr, fq), acc);
                if (jt == it) {
#pragma unroll
                    for (int j = 0; j < 4; ++j) if (4 * fq + j > fr) acc[j] = 0.f;
                }
            }
            *(LAS u32x2*)(P + (it * 16 + fr) * 72 + jt * 16 + 4 * fq) = pack4(acc); }
    }
    __syncthreads();
    f32x4 o[4][2];
#pragma unroll
    for (int mt = 0; mt < 4; ++mt)
#pragma unroll
        for (int et = 0; et < 2; ++et) o[mt][et] = (f32x4){0.f, 0.f, 0.f, 0.f};
#pragma unroll
    for (int et = 0; et < 2; ++et) { const int e0 = wave * 32 + et * 16;
#pragma unroll
        for (int kk = 0; kk < 2; ++kk) { const bf16x8 x = ldfrag_tr(vS, 264, kk * 32, e0, lane);
#pragma unroll
            for (int mt = 0; mt < 4; ++mt) if (mt * 16 + 15 >= kk * 32) o[mt][et] = MFMA16(x, ldfrag(P, 72, mt * 16, kk * 32, fr, fq), o[mt][et]); }
#pragma unroll
        for (int kk = 0; kk < 4; ++kk) {
#pragma unroll
            for (int mt = 0; mt < 4; ++mt) o[mt][et] = MFMA16(sx[et][kk], ldfrag(qs, 136, mt * 16, kk * 32, fr, fq), o[mt][et]); }
    }
#pragma unroll
    for (int mt = 0; mt < 4; ++mt) { float s = 0.f;
#pragma unroll
        for (int et = 0; et < 2; ++et)
#pragma unroll
            for (int j = 0; j < 4; ++j) s += o[mt][et][j] * o[mt][et][j];
        s += __shfl_xor(s, 16); s += __shfl_xor(s, 32);
        if (fq == 0) red[wave * 64 + mt * 16 + fr] = s; }
    __syncthreads();
#pragma unroll
    for (int mt = 0; mt < 4; ++mt) { const int i = mt * 16 + fr; float s = 0.f;
#pragma unroll
        for (int w = 0; w < 8; ++w) s += red[w * 64 + i];
        const float r = rsqrtf(s * (1.f / 256.f) + EPS);
#pragma unroll
        for (int et = 0; et < 2; ++et) { const int e = wave * 32 + et * 16 + 4 * fq;
            const u32x2 g = gg[mt][et]; const f32x4 wn = *(const f32x4*)(a.in[5] + e);
            f32x4 v = o[mt][et] * r * wn; v[0] *= fast_silu(bflo(g.x)); v[1] *= fast_silu(bfhi(g.x)); v[2] *= fast_silu(bflo(g.y)); v[3] *= fast_silu(bfhi(g.y));
            *(u32x2*)(mix + (t0 + i) * DM + h * 256 + e) = pack4(v); } }
    __syncthreads();
}

__device__ __forceinline__ void ssd_p2_item(const MkArgs& a, LAS unsigned char* lds, int item, int tid, int wave, int lane) {
    unsigned char* ws = a.ws;
    const int g = item & 3, c = (item >> 2) & 31, b = item >> 7;
    const size_t t0 = (size_t)b * SEQ + c * 128;
    const bf16_t* proj = (const bf16_t*)(ws + WS_PROJ); const float* small = (const float*)(ws + WS_SMALL);
    bf16_t* XC = (bf16_t*)(ws + WS_XC); bf16_t* BC = (bf16_t*)(ws + WS_BC); bf16_t* CC = (bf16_t*)(ws + WS_CC); bf16_t* SS = (bf16_t*)(ws + WS_SS);
    float* DT = (float*)(ws + WS_DT); float* ACS = (float*)(ws + WS_ACS);
    LAS bf16_t* xsd = (LAS bf16_t*)(lds);
    LAS bf16_t* Bs = (LAS bf16_t*)(lds + 67584);
    LAS float* fac = (LAS float*)(lds + 102400);
    const int c8 = lane, kind = c8 < 32 ? 0 : (c8 < 48 ? 1 : 2);
    const int xch = kind == 0 ? g * 256 + c8 * 8 : (kind == 1 ? 1024 + g * 128 + (c8 - 32) * 8 : 1536 + g * 128 + (c8 - 48) * 8);
    const int tb = wave * 16;
    const bf16_t* src = proj + (t0 + tb) * PJ + PX + xch;
    u32x4 raw[19];
#pragma unroll
    for (int i = 0; i < 19; ++i) { raw[i] = (u32x4){0u, 0u, 0u, 0u}; if (i >= 3 || tb > 0 || c > 0) raw[i] = *(const u32x4*)(src + ((long)i - 3) * PJ); }
    if (wave < 4) {
        const int head = g * 4 + wave; const float av = -__expf(a.in[9][head]), dtb = a.in[8][head];
        const float d0 = softplusf(small[(t0 + 2 * lane) * 32 + 16 + head] + dtb), d1 = softplusf(small[(t0 + 2 * lane + 1) * 32 + 16 + head] + dtb);
        const float a0 = d0 * av, a1 = d1 * av;
        float v = a0 + a1;
#pragma unroll
        for (int o = 1; o < 64; o <<= 1) { const float u = __shfl_up(v, o); if (lane >= o) v += u; }
        const float ex = v - (a0 + a1), alast = __shfl(v, 63);
        fac[wave * 128 + 2 * lane] = d0 * __expf(alast - (ex + a0)); fac[wave * 128 + 2 * lane + 1] = d1 * __expf(alast - v);
        DT[(t0 + 2 * lane) * 16 + head] = d0; DT[(t0 + 2 * lane + 1) * 16 + head] = d1;
        ACS[(t0 + 2 * lane) * 16 + head] = ex + a0; ACS[(t0 + 2 * lane + 1) * 16 + head] = v;
    }
    float wk[4][8], bs[8];
#pragma unroll
    for (int k = 0; k < 4; ++k) { const f32x4 w0 = *(const f32x4*)(a.in[6] + k * 2048 + xch), w1 = *(const f32x4*)(a.in[6] + k * 2048 + xch + 4);
#pragma unroll
        for (int j = 0; j < 4; ++j) { wk[k][j] = w0[j]; wk[k][4 + j] = w1[j]; } }
    { const f32x4 b0 = *(const f32x4*)(a.in[7] + xch), b1 = *(const f32x4*)(a.in[7] + xch + 4);
#pragma unroll
      for (int j = 0; j < 4; ++j) { bs[j] = b0[j]; bs[4 + j] = b1[j]; } }
    __syncthreads();
    {
        bf16_t* gdst = kind == 0 ? XC + (t0 + tb) * 1024 + g * 256 + c8 * 8 : (kind == 1 ? BC + (t0 + tb) * 512 + g * 128 + (c8 - 32) * 8 : CC + (t0 + tb) * 512 + g * 128 + (c8 - 48) * 8);
        const size_t gld = kind == 0 ? 1024 : 512;
        float u0[8], u1[8], u2[8], u3[8];
        unpack8(raw[0], u0); unpack8(raw[1], u1); unpack8(raw[2], u2);
#pragma unroll
        for (int i = 0; i < 16; ++i) {
            unpack8(raw[i + 3], u3);
            float o[8];
#pragma unroll
            for (int j = 0; j < 8; ++j) o[j] = fast_silu(bs[j] + wk[0][j] * u0[j] + wk[1][j] * u1[j] + wk[2][j] * u2[j] + wk[3][j] * u3[j]);
            *(u32x4*)(gdst + (size_t)i * gld) = pack8(o);
            if (kind == 0) { const float f = fac[(c8 >> 3) * 128 + tb + i];
#pragma unroll
                for (int j = 0; j < 8; ++j) o[j] *= f;
                *(LAS u32x4*)(xsd + (tb + i) * 264 + c8 * 8) = pack8(o); }
            else if (kind == 1) *(LAS u32x4*)(Bs + (tb + i) * 136 + (c8 - 32) * 8) = pack8(o);
#pragma unroll
            for (int j = 0; j < 8; ++j) { u0[j] = u1[j]; u1[j] = u2[j]; u2[j] = u3[j]; }
        }
    }
    __syncthreads();
    {
        const int fr = lane & 15, fq = lane >> 4, r = wave >> 1;
        bf16_t* ss = SS + (((size_t)b * 32 + c) * 16 + g * 4 + r) * 8192;
#pragma unroll
        for (int pi = 0; pi < 2; ++pi) { const int pt = (wave & 1) * 2 + pi;
            bf16x8 y[4];
#pragma unroll
            for (int kk = 0; kk < 4; ++kk) y[kk] = ldfrag_tr(xsd, 264, kk * 32, r * 64 + pt * 16, lane);
#pragma unroll
            for (int nt = 0; nt < 8; ++nt) { f32x4 acc = {0.f, 0.f, 0.f, 0.f};
#pragma unroll
                for (int kk = 0; kk < 4; ++kk) acc = MFMA16(ldfrag_tr(Bs, 136, kk * 32, nt * 16, lane), y[kk], acc);
                *(u32x2*)(ss + (pt * 16 + fr) * 128 + nt * 16 + 4 * fq) = pack4(acc); } }
    }
    __syncthreads();
}

__device__ __forceinline__ void ssd_p4_item(const MkArgs& a, LAS unsigned char* lds, int item, int tid, int wave, int lane) {
    unsigned char* ws = a.ws;
    const int g = item & 3, c = (item >> 2) & 31, b = item >> 7;
    const size_t t0 = (size_t)b * SEQ + c * 128;
    const bf16_t* proj = (const bf16_t*)(ws + WS_PROJ);
    const bf16_t* XC = (const bf16_t*)(ws + WS_XC); const bf16_t* BC = (const bf16_t*)(ws + WS_BC); const bf16_t* CC = (const bf16_t*)(ws + WS_CC); const bf16_t* SS = (const bf16_t*)(ws + WS_SS);
    const float* DT = (const float*)(ws + WS_DT); const float* ACS = (const float*)(ws + WS_ACS);
    bf16_t* mix = (bf16_t*)(ws + WS_HA);
    LAS bf16_t* Cs = (LAS bf16_t*)(lds);
    LAS bf16_t* Bs = (LAS bf16_t*)(lds + 34816);
    LAS bf16_t* xs = (LAS bf16_t*)(lds + 69632);
    LAS bf16_t* Ss = (LAS bf16_t*)(lds + 104448);
    LAS float* acs = (LAS float*)(lds + 139264);
    const int fr = lane & 15, fq = lane >> 4, w = wave;
    acs[tid] = ACS[(t0 + (tid & 127)) * 16 + g * 4 + (tid >> 7)];
    for (int u = tid; u < 2048; u += NTHREADS) { const int r = u >> 4, cq = u & 15;
        *(LAS u32x4*)(Cs + r * 136 + cq * 8) = *(const u32x4*)(CC + (t0 + r) * 512 + g * 128 + cq * 8);
        *(LAS u32x4*)(Bs + r * 136 + cq * 8) = *(const u32x4*)(BC + (t0 + r) * 512 + g * 128 + cq * 8); }
    u32x4 xr[4], sr[4]; float dtr[4];
#define SSD4_LOAD(hp) do { _Pragma("unroll") for (int i = 0; i < 4; ++i) { const int u = tid + i * NTHREADS, t = u >> 4, cq = u & 15; \
        xr[i] = *(const u32x4*)(XC + (t0 + t) * 1024 + g * 256 + (hp) * 128 + cq * 8); dtr[i] = DT[(t0 + t) * 16 + g * 4 + (hp) * 2 + (cq >> 3)]; \
        sr[i] = *(const u32x4*)(SS + (((size_t)b * 32 + c) * 16 + g * 4 + (hp) * 2) * 8192 + (size_t)t * 128 + cq * 8); } } while (0)
#define SSD4_STORE() do { _Pragma("unroll") for (int i = 0; i < 4; ++i) { const int u = tid + i * NTHREADS, t = u >> 4, cq = u & 15; float f[8]; unpack8(xr[i], f); \
        _Pragma("unroll") for (int j = 0; j < 8; ++j) f[j] *= dtr[i]; *(LAS u32x4*)(xs + t * 136 + cq * 8) = pack8(f); *(LAS u32x4*)(Ss + t * 136 + cq * 8) = sr[i]; } } while (0)
    SSD4_LOAD(0);
    __syncthreads();
    bf16x8 cf[4];
#pragma unroll
    for (int kk = 0; kk < 4; ++kk) cf[kk] = ldfrag(Cs, 136, w * 16, kk * 32, fr, fq);
    f32x4 cb[8];
#pragma unroll
    for (int st = 0; st < 8; ++st) { cb[st] = (f32x4){0.f, 0.f, 0.f, 0.f};
        if (st <= w) {
#pragma unroll
            for (int kk = 0; kk < 4; ++kk) cb[st] = MFMA16(ldfrag(Bs, 136, st * 16, kk * 32, fr, fq), cf[kk], cb[st]); } }
    SSD4_STORE();
    __syncthreads();
    const int l = w * 16 + fr;
    float ssq = 0.f;
    bf16_t* mrow = mix + (t0 + l) * DM + 1024 + g * 256 + 4 * fq;
#pragma unroll 1
    for (int hp = 0; hp < 2; ++hp) {
        if (hp == 0) SSD4_LOAD(1);
#pragma unroll 1
        for (int r2 = 0; r2 < 2; ++r2) {
            const int r = hp * 2 + r2;
            const float al = acs[r * 128 + l];
#pragma unroll
            for (int st = 0; st < 8; ++st) if (st <= (w | 1)) { f32x4 mv;
#pragma unroll
                for (int j = 0; j < 4; ++j) { const int s = st * 16 + 4 * fq + j; mv[j] = (s <= l) ? cb[st][j] * __expf(al - acs[r * 128 + s]) : 0.f; }
                *(LAS u32x2*)(Bs + l * 136 + st * 16 + 4 * fq) = pack4(mv); }
            LDS_WAIT();
            const float eal = __expf(al), dsk = a.in[10][g * 4 + r];
            const bf16_t* xcp = XC + (t0 + l) * 1024 + g * 256 + r * 64 + 4 * fq; const bf16_t* zp = proj + (t0 + l) * PJ + PZ + g * 256 + r * 64 + 4 * fq;
            u32x2 xv[4], zv[4];
#pragma unroll
            for (int pt = 0; pt < 4; ++pt) { xv[pt] = *(const u32x2*)(xcp + pt * 16); zv[pt] = *(const u32x2*)(zp + pt * 16); }
#pragma unroll
            for (int pt = 0; pt < 4; ++pt) {
                f32x4 ad = {0.f, 0.f, 0.f, 0.f}, ao = {0.f, 0.f, 0.f, 0.f};
#pragma unroll
                for (int kk = 0; kk < 4; ++kk) if (kk <= (w >> 1)) ad = MFMA16(ldfrag_tr(xs, 136, kk * 32, r2 * 64 + pt * 16, lane), ldfrag(Bs, 136, w * 16, kk * 32, fr, fq), ad);
#pragma unroll
                for (int kk = 0; kk < 4; ++kk) ao = MFMA16(ldfrag(Ss, 136, r2 * 64 + pt * 16, kk * 32, fr, fq), cf[kk], ao);
                f32x4 y = ad + ao * eal;
                y[0] = (y[0] + dsk * bflo(xv[pt].x)) * fast_silu(bflo(zv[pt].x)); y[1] = (y[1] + dsk * bfhi(xv[pt].x)) * fast_silu(bfhi(zv[pt].x));
                y[2] = (y[2] + dsk * bflo(xv[pt].y)) * fast_silu(bflo(zv[pt].y)); y[3] = (y[3] + dsk * bfhi(xv[pt].y)) * fast_silu(bfhi(zv[pt].y));
                ssq += (y[0] * y[0] + y[1] * y[1]) + (y[2] * y[2] + y[3] * y[3]);
                *(u32x2*)(mrow + r * 64 + pt * 16) = pack4(y);
            }
            LDS_WAIT();
        }
        if (hp == 0) { __syncthreads(); SSD4_STORE(); __syncthreads(); }
    }
#undef SSD4_LOAD
#undef SSD4_STORE
    ssq += __shfl_xor(ssq, 16); ssq += __shfl_xor(ssq, 32);
    const float rs = rsqrtf(ssq * (1.f / 256.f) + EPS);
    VM_WAIT();
#pragma unroll 4
    for (int q = 0; q < 16; ++q) { const f32x4 wn = *(const f32x4*)(a.in[11] + g * 256 + q * 16 + 4 * fq); const u32x2 v = *(const u32x2*)(mrow + q * 16);
        *(u32x2*)(mrow + q * 16) = pack4((f32x4){bflo(v.x), bfhi(v.x), bflo(v.y), bfhi(v.y)} * rs * wn); }
    __syncthreads();
}

__device__ __forceinline__ void phase2(const MkArgs& a, LAS unsigned char* lds, int tid, int wave, int lane) {
    if (a.flags & 64) for (int it = blockIdx.x; it < 512; it += gridDim.x) ssd_p2_item(a, lds, it, tid, wave, lane);
    if (a.flags & 2) for (int it = blockIdx.x; it < 512; it += gridDim.x) ssd_p2_item(a, lds, it, tid, wave, lane);
    if (a.flags & 1) for (int it = blockIdx.x; it < 1024; it += gridDim.x) gla_p2_item(a, lds, it, tid, wave, lane);
    if (a.flags & 1024) for (int it = blockIdx.x; it < 1024; it += gridDim.x) gla_p2_item(a, lds, it, tid, wave, lane);
}
__device__ __forceinline__ void phase4(const MkArgs& a, LAS unsigned char* lds, int tid, int wave, int lane) {
#ifndef NO_SSD4
    if (a.flags & 128) for (int it = blockIdx.x; it < 512; it += gridDim.x) ssd_p4_item(a, lds, it, tid, wave, lane);
    if (a.flags & 2) for (int it = blockIdx.x; it < 512; it += gridDim.x) ssd_p4_item(a, lds, it, tid, wave, lane);
#endif
#ifndef NO_GLA4
    if (a.flags & 1) for (int it = blockIdx.x; it < 1024; it += gridDim.x) gla_p4_item(a, lds, it, tid, wave, lane);
#endif
}
__global__ void __launch_bounds__(NTHREADS, 2) mk_fwd(MkArgs a) {
    extern __shared__ __attribute__((aligned(16))) unsigned char lds_raw[];
    LAS unsigned char* lds = (LAS unsigned char*)lds_raw;
    const int tid = threadIdx.x, lane = tid & 63, wave = __builtin_amdgcn_readfirstlane(tid >> 6);
    const int lo = a.ph_lo, hi = a.ph_hi;
    volatile LAS unsigned* bst = (volatile LAS unsigned*)(lds + LDS_BYTES - 64);
    if (tid < 16) bst[tid] = 0u;
    __syncthreads();
    XcdBarrier bar = xcd_barrier_post((unsigned*)(a.ws + WS_BAR) + a.li * XCD_BAR_WORDS, bst);
#ifndef ONLY_PHASE
#define ONLY_PHASE -1
#endif
#define IN(k) ((ONLY_PHASE < 0 || ONLY_PHASE == (k)) && lo <= (k) && (k) < hi)
#define SEAM(k) do { if (IN(k) && IN((k) + 1)) { xcd_barrier(bar); } } while (0)
    if (IN(0)) { phase0(a, lds, wave, lane); if (a.flags & 8) phase0(a, lds, wave, lane); }
    SEAM(0);
    if (IN(1)) { phase1(a, lds, wave, lane); }
    SEAM(1);
    if (IN(2)) { phase2(a, lds, tid, wave, lane); if (a.flags & 16) phase2(a, lds, tid, wave, lane); }
    SEAM(2);
    if (IN(3)) { scan_phase(a, a.flags); }
    SEAM(3);
    if (IN(4)) { phase4(a, lds, tid, wave, lane); if (a.flags & 32) phase4(a, lds, tid, wave, lane); }
    SEAM(4);
    if (IN(5)) { phase5(a, lds, a.out); }
    SEAM(5);
    if (IN(6)) { phase6(a, lds, a.out, wave, lane); }
    SEAM(6);
    if (IN(7)) { phase7(a, lds); }
    SEAM(7);
    if (IN(8)) { phase8(a, lds); }
    SEAM(8);
    if (IN(9)) { phase9(a, wave, lane); }
#undef IN
#undef SEAM
}

typedef short s16x4 __attribute__((ext_vector_type(4)));
__global__ void n_trtest(unsigned* flag) {
    __shared__ unsigned short T[32 * 72];
    for (int i = threadIdx.x; i < 32 * 72; i += 64) { const int r = i / 72, c = i % 72; T[i] = (unsigned short)(r * 16 + (c & 15) + 1000 * (c >> 4)); }
    __syncthreads();
    const int lane = threadIdx.x, idx = lane & 15, q = idx >> 2, p = idx & 3, fq = lane >> 4;
    const s16x4 v = __builtin_amdgcn_ds_read_tr16_b64_v4i16((__attribute__((address_space(3))) s16x4*)(T + (8 * fq + q) * 72 + 4 * p));
    bool bad = false;
    for (int j = 0; j < 4; ++j) if ((unsigned short)v[j] != (unsigned short)((8 * fq + j) * 16 + idx)) bad = true;
    if (bad) atomicOr(flag, 1u);
}
__global__ void n_poison(float* out, const unsigned* flag) { if (threadIdx.x == 0 && flag[0] != 0u) out[0] += 1000.f; }
#ifndef PROBE_FLAGS
#define PROBE_FLAGS 0
#endif
static int g_grid = 0;
static void launch_mk(MkArgs a, int lo, int hi, int li, hipStream_t stream) {
    if (g_grid == 0) {
        int dev = 0, cus = 0, per_cu = 0;
        hipGetDevice(&dev);
        hipDeviceGetAttribute(&cus, hipDeviceAttributeMultiprocessorCount, dev);
        hipFuncSetAttribute((const void*)mk_fwd, hipFuncAttributeMaxDynamicSharedMemorySize, LDS_BYTES);
        hipOccupancyMaxActiveBlocksPerMultiprocessor(&per_cu, (const void*)mk_fwd, NTHREADS, LDS_BYTES);
        if (per_cu < 1) { fprintf(stderr, "kernel_launch: occupancy query says %d blocks/CU\n", per_cu); per_cu = 1; }
        g_grid = cus * per_cu;
        fprintf(stderr, "kernel_launch: grid %d (%d CUs x %d)\n", g_grid, cus, per_cu);
    }
    a.ph_lo = lo; a.ph_hi = hi; a.li = li;
    void* args[] = {&a};
    hipError_t e = hipLaunchCooperativeKernel((const void*)mk_fwd, dim3(g_grid), dim3(NTHREADS), args, LDS_BYTES, stream);
    if (e != hipSuccess) fprintf(stderr, "cooperative launch failed: %s (grid %d)\n", hipGetErrorString(e), g_grid);
}

extern "C" void kernel_launch(void* const* d_in, const int* in_sizes, int n_in, void* d_out, int out_size, void* d_ws, size_t ws_size, hipStream_t stream) {
    if (ws_size < WS_END) { fprintf(stderr, "kernel_launch: workspace too small: %zu < %zu\n", ws_size, (size_t)WS_END); return; }
    const float* x = (const float*)d_in[0];
    const float* w_gk_up = (const float*)d_in[3];
    const float* b_gk = (const float*)d_in[4];
    const float* w_gla_norm = (const float*)d_in[5];
    const float* w_conv = (const float*)d_in[6];
    const float* b_conv = (const float*)d_in[7];
    const float* dt_bias = (const float*)d_in[8];
    const float* a_log = (const float*)d_in[9];
    const float* d_skip = (const float*)d_in[10];
    const float* w_ssd_norm = (const float*)d_in[11];
    const float* w_norm_ffn = (const float*)d_in[13];
    const float* w_rg = (const float*)d_in[14];
    const float* b_rg = (const float*)d_in[15];
    const float* w_re = (const float*)d_in[16];
    const float* b_re = (const float*)d_in[17];
    const float* w_gate = (const float*)d_in[18];
    const float* w_up = (const float*)d_in[19];
    const float* w_down = (const float*)d_in[20];
    const float* w_final = (const float*)d_in[21];
    char* ws = (char*)d_ws;
    float* out = (float*)d_out;
    int* cnt = (int*)(ws + WS_CTL);
    float* small = (float*)(ws + WS_SMALL);
    int* tok_e = (int*)(ws + WS_TOKE);
    float* tok_w = (float*)(ws + WS_TOKW);
    int* list = (int*)(ws + WS_LIST);
    bf16_t* hA = (bf16_t*)(ws + WS_HA);
    bf16_t* proj = (bf16_t*)(ws + WS_PROJ);
    bf16_t* ybuf = (bf16_t*)(ws + WS_Y);
    bf16_t* hmid = (bf16_t*)(ws + WS_HMID);
    bf16_t* mix = hA;
    bf16_t* h2 = hA;
    float* x1 = (float*)(ws + WS_PROJ);
    float* oy = out; (void)x1; (void)h2; (void)hmid; (void)ybuf; (void)list; (void)tok_w; (void)tok_e; (void)cnt; (void)x;
    (void)w_norm_ffn; (void)w_rg; (void)b_rg; (void)w_re; (void)b_re; (void)w_gate; (void)w_up; (void)w_down; (void)w_final;
    MkArgs a{};
    for (int i = 0; i < 22; ++i) a.in[i] = (const float*)d_in[i];
    a.out = out; a.ws = (unsigned char*)d_ws;

    (void)hipMemsetAsync(ws + WS_CTL, 0, 262144, stream);
    a.flags = 3 | PROBE_FLAGS;
    launch_mk(a, 0, 10, 0, stream);
#ifdef TRTEST
    n_trtest<<<1, 64, 0, stream>>>((unsigned*)(ws + WS_CTL + 512));
    n_poison<<<1, 64, 0, stream>>>(out, (const unsigned*)(ws + WS_CTL + 512));
#endif
    (void)w_conv; (void)b_conv; (void)dt_bias; (void)a_log; (void)d_skip; (void)w_ssd_norm; (void)oy; (void)small; (void)proj; (void)mix;
    (void)w_gk_up; (void)b_gk; (void)w_gla_norm;
}
```

```cpp
#include <hip/hip_runtime.h>
#include <cstdio>
#include <cstdint>

typedef unsigned short bf16_t;

constexpr int T_TOK = 16384, SEQ = 4096, NB = 4, DM = 2048;
constexpr int IN_DIM = 6176;
constexpr int PJ = 6144;
constexpr int PQ = 0, PK = 512, PV = 1024, PG = 2048, PZ = 3072, PX = 4096, PB = 5120, PC = 5632;
constexpr int WI_GK = 3072, WI_Z = 3088, WI_XBC = 4112, WI_DT = 6160;
constexpr int NEXP = 32, DEXP = 512;
constexpr float EPS = 1e-6f;

__device__ __forceinline__ float bf2f(bf16_t b) { return __uint_as_float(((unsigned)b) << 16); }
__device__ __forceinline__ bf16_t f2bf(float f) { unsigned u = __float_as_uint(f); u += 0x7FFFu + ((u >> 16) & 1u); return (bf16_t)(u >> 16); }
__device__ __forceinline__ float siluf(float v) { return v / (1.f + __expf(-v)); }
__device__ __forceinline__ float softplusf(float v) { return v > 20.f ? v : log1pf(__expf(v)); }
__device__ __forceinline__ float logsigmoidf(float v) { return fminf(v, 0.f) - log1pf(__expf(-fabsf(v))); }
__device__ __forceinline__ int win_col(int j) { return j < 3072 ? j : (j < 4096 ? j - 3072 + WI_Z : j - 4096 + WI_XBC); }
__device__ __forceinline__ int win_col_small(int j) { return j < 16 ? WI_GK + j : WI_DT + (j - 16); }

constexpr size_t MiB = 1024 * 1024;
constexpr size_t WS_CTL = 0;
constexpr size_t WS_BAR = 65536;
constexpr size_t WS_SMALL = 1 * MiB;
constexpr size_t WS_TOKE = WS_SMALL + 2 * MiB;
constexpr size_t WS_TOKW = WS_TOKE + MiB / 8;
constexpr size_t WS_LIST = WS_TOKW + MiB / 8;
constexpr size_t WS_RSTD = 6 * MiB;
constexpr size_t WS_WRT = 7 * MiB;
constexpr size_t WS_HA = 8 * MiB;
constexpr size_t WS_PROJ = WS_HA + 64 * MiB;
constexpr size_t WS_SCR = WS_PROJ + 192 * MiB;
constexpr size_t WS_Y = WS_SCR;
constexpr size_t WS_HMID = WS_SCR + 128 * MiB;
constexpr size_t WS_QT = WS_SCR;
constexpr size_t WS_KT = WS_QT + 16 * MiB;
constexpr size_t WS_GS = WS_KT + 16 * MiB;
constexpr size_t WS_GDEC = WS_GS + 64 * MiB;
constexpr size_t WS_XC = WS_GDEC + 1 * MiB;
constexpr size_t WS_BC = WS_XC + 32 * MiB;
constexpr size_t WS_CC = WS_BC + 16 * MiB;
constexpr size_t WS_SS = WS_CC + 16 * MiB;
constexpr size_t WS_DT = WS_SS + 32 * MiB;
constexpr size_t WS_ACS = WS_DT + 1 * MiB;
static_assert(WS_ACS + 1 * MiB <= WS_SCR + 200 * MiB, "mixer scratch");
constexpr size_t WS_WINT = WS_SCR + 200 * MiB;
constexpr size_t WS_WST = WS_WINT + 24 * MiB;
constexpr size_t WS_WOUTT = WS_WST + 1 * MiB;
constexpr size_t WS_H2U = WS_WOUTT + 8 * MiB;
constexpr size_t WS_END = WS_H2U + 64 * MiB;
constexpr size_t WS_WGUT = WS_PROJ;
constexpr size_t WS_WDT = WS_PROJ + 128 * MiB;

#include <hip/hip_cooperative_groups.h>
namespace cg = cooperative_groups;
#define LAS __attribute__((address_space(3)))
#define GAS __attribute__((address_space(1)))
typedef short bf16x8 __attribute__((ext_vector_type(8)));
typedef float f32x4 __attribute__((ext_vector_type(4)));
typedef float f32x2 __attribute__((ext_vector_type(2)));
typedef unsigned u32x4 __attribute__((ext_vector_type(4)));
typedef unsigned u32x2 __attribute__((ext_vector_type(2)));
#define LDS_WAIT() asm volatile("s_waitcnt lgkmcnt(0)" ::: "memory")
#define VM_WAIT() asm volatile("s_waitcnt vmcnt(0)" ::: "memory")
typedef __bf16 bf16x2_t __attribute__((ext_vector_type(2)));
__device__ __forceinline__ unsigned cvt_pk_bf16(float lo, float hi) { f32x2 f = {lo, hi}; bf16x2_t v = __builtin_convertvector(f, bf16x2_t); return __builtin_bit_cast(unsigned, v); }

__device__ __forceinline__ float bflo(unsigned u) { return __uint_as_float(u << 16); }
__device__ __forceinline__ float bfhi(unsigned u) { return __uint_as_float(u & 0xffff0000u); }

namespace pg8 {
constexpr int BM = 256, BK = 64, HALF = 128, HTB = HALF * BK * 2, STAGE_BYTES = 8 * HTB, NXCD = 8, WGM = 8;
__host__ __device__ __forceinline__ int lds_byte(int r, int c) { const int st = (r >> 4) * 2 + (c >> 5), rr = r & 15, cc = c & 31, ob = rr * 64 + cc * 2; return st * 1024 + (ob ^ (((ob >> 9) & 1) << 5)); }
__host__ __device__ __forceinline__ void stage_rc(int b, int& R, int& C) { const int st = b / 1024, sb = b % 1024, swz = sb ^ (((sb >> 9) & 1) << 5); R = (st >> 1) * 16 + swz / 64; C = (st & 1) * 32 + (swz % 64) / 2; }
__host__ __device__ __forceinline__ int perm32(int rho) { const int n = rho >> 4, i = rho & 15; return 8 * (i >> 2) + 4 * n + (i & 3); }

struct Unit { int pm, pn, e, row0, ne; };

struct StaticOrder {
    static constexpr bool GATHER = false; static constexpr int A_AUX = 0;
    const char* A; const char* Bt; size_t tstep;
    int nM, nN, nwg, G, c;
    __device__ void init(const bf16_t* A_, const bf16_t* Bt_, int M, int N, int K, int G_, int c_) { A = (const char*)A_; Bt = (const char*)Bt_; tstep = (size_t)BM * K * 2; nM = M / BM; nN = N / BM; nwg = nM * nN; G = G_; c = c_; }
    __device__ bool next(int i, Unit& u) const {
        const long L = (long)i * G + c; if (L >= nwg) return false;
        int wgid = (int)L; { const int q = nwg / NXCD, r = nwg % NXCD, xcd = wgid % NXCD, off = wgid / NXCD; wgid = (xcd < r ? xcd * (q + 1) : r * (q + 1) + (xcd - r) * q) + off; }
        const int nig = WGM * nN, gid = wgid / nig, fm = gid * WGM, gsz = (nM - fm) < WGM ? (nM - fm) : WGM;
        u.pm = fm + ((wgid % nig) % gsz); u.pn = (wgid % nig) / gsz; u.e = 0; u.row0 = 0; u.ne = 0; return true;
    }
    __device__ __forceinline__ const char* a_ptr(const Unit& u) const { return A + (size_t)u.pm * tstep; }
    __device__ __forceinline__ const char* b_ptr(const Unit& u) const { return Bt + (size_t)u.pn * tstep; }
    __device__ __forceinline__ int a_row(const Unit&, int) const { return 0; }
    __device__ __forceinline__ void a_ready(const Unit&) const {}
    __device__ __forceinline__ void done(const Unit&, int) const {}
};

template <class Epi, class Sched, bool ALIGN_EPI = true, bool SP2 = true>
__device__ __forceinline__ void gemm_phase(LAS unsigned char* lds, const int K, const Sched& S, const Epi& E) {
    const int tid = threadIdx.x, wid = __builtin_amdgcn_readfirstlane(tid >> 6), lane = tid & 63, wr = wid >> 2, wc = wid & 3, fr = lane & 15, fq = lane >> 4;
    const int nt = K / BK;
    unsigned voffA[2], voffB[2]; int RA[2];
#pragma unroll
    for (int i = 0; i < 2; ++i) { int R, C; stage_rc(tid * 16 + i * 8192, R, C); const int Rb = Epi::PERM ? ((R & ~31) + perm32(R & 31)) : R;
        voffA[i] = Sched::GATHER ? (unsigned)(C * 2) : (unsigned)(R * K + C) * 2u; voffB[i] = (unsigned)(Rb * K + C) * 2u; RA[i] = R; }
    const size_t kstep = (size_t)(BK * 2);
    const size_t hstep = (size_t)HALF * K * 2;
    const size_t hstepA = Sched::GATHER ? 0 : hstep;
    const unsigned ldsw = (unsigned)wid * 1024u;
    const int aoff = lds_byte(wr * 64 + fr, fq * 8), boff = lds_byte(wc * 32 + fr, fq * 8);
#define PG8_SA(b, h) (((b) * 2 + (h)) * HTB)
#define PG8_SB(b, h) ((4 + (b) * 2 + (h)) * HTB)
#define PG8_STAGE_X(bufoff, gbase, voff, AUX) do { _Pragma("unroll") for (int _i = 0; _i < 2; ++_i) \
        __builtin_amdgcn_global_load_lds((const unsigned*)((const char*)(gbase) + (voff)[_i]), (LAS unsigned*)(lds + (bufoff) + ldsw + _i * 8192), 16, 0, AUX); } while (0)
#define PG8_STAGE(bufoff, gbase, voff) PG8_STAGE_X(bufoff, gbase, voff, 0)
#define PG8_STAGEA(bufoff, gbase, voff) PG8_STAGE_X(bufoff, gbase, voff, Sched::A_AUX)
#define PG8_LDA(dst, b, h) do { _Pragma("unroll") for (int m = 0; m < 4; ++m) _Pragma("unroll") for (int k = 0; k < 2; ++k) dst[m][k] = *(const LAS bf16x8*)(lds + PG8_SA(b, h) + aoff + m * 2048 + k * 1024); } while (0)
#define PG8_LDB(dst, b, h) do { _Pragma("unroll") for (int n = 0; n < 2; ++n) _Pragma("unroll") for (int k = 0; k < 2; ++k) dst[n][k] = *(const LAS bf16x8*)(lds + PG8_SB(b, h) + boff + n * 2048 + k * 1024); } while (0)
#define PG8_MMA(ai, bj, At, Bt) do { __builtin_amdgcn_s_setprio(1); _Pragma("unroll") for (int m = 0; m < 4; ++m) _Pragma("unroll") for (int n = 0; n < 2; ++n) _Pragma("unroll") for (int k = 0; k < 2; ++k) \
        acc[ai][bj][m][n] = __builtin_amdgcn_mfma_f32_16x16x32_bf16(Bt[n][k], At[m][k], acc[ai][bj][m][n], 0, 0, 0); __builtin_amdgcn_s_setprio(0); } while (0)
#define PG8_WAIT_V(n) asm volatile("s_waitcnt vmcnt(" #n ")" ::: "memory")
#define PG8_WAIT_L(n) asm volatile("s_waitcnt lgkmcnt(" #n ")" ::: "memory")
#define PG8_BAR __builtin_amdgcn_s_barrier()
#define PG8_SCHED __builtin_amdgcn_sched_barrier(0)
    Unit cur, nxt; int ui = 0;
    if (!S.next(0, cur)) return;
    f32x4 acc[2][2][4][2];
#pragma unroll
    for (int a = 0; a < 2; ++a)
#pragma unroll
        for (int b = 0; b < 2; ++b)
#pragma unroll
            for (int m = 0; m < 4; ++m)
#pragma unroll
                for (int n = 0; n < 2; ++n) acc[a][b][m][n] = (f32x4){0.f, 0.f, 0.f, 0.f};
    bf16x8 At[4][2], B0[2][2], B1[2][2];
    const char* cA = S.a_ptr(cur); const char* cB = S.b_ptr(cur);
    S.a_ready(cur);
    unsigned gC0[2], gC1[2], gN0[2], gN1[2];
#pragma unroll
    for (int i = 0; i < 2; ++i) {
        if constexpr (Sched::GATHER) { gC0[i] = voffA[i] + (unsigned)S.a_row(cur, RA[i]) * (unsigned)(K * 2); gC1[i] = voffA[i] + (unsigned)S.a_row(cur, HALF + RA[i]) * (unsigned)(K * 2); }
        else { gC0[i] = voffA[i]; gC1[i] = voffA[i]; }
        gN0[i] = gC0[i]; gN1[i] = gC1[i];
    }
    if constexpr (SP2) {
        PG8_STAGE(PG8_SB(0, 0), cB, voffB); PG8_STAGE(PG8_SB(0, 1), cB + hstep, voffB); PG8_STAGEA(PG8_SA(0, 0), cA, gC0); PG8_STAGEA(PG8_SA(0, 1), cA + hstepA, gC1);
        if (wr == 1) PG8_BAR;
        PG8_WAIT_V(2); PG8_BAR;
        PG8_STAGE(PG8_SB(1, 0), cB + kstep, voffB); PG8_STAGEA(PG8_SA(1, 0), cA + kstep, gC0); PG8_STAGE(PG8_SB(1, 1), cB + hstep + kstep, voffB);
        PG8_WAIT_V(6); PG8_BAR;
    } else {
        PG8_STAGE(PG8_SB(0, 0), cB, voffB); PG8_STAGEA(PG8_SA(0, 0), cA, gC0); PG8_STAGE(PG8_SB(0, 1), cB + hstep, voffB); PG8_STAGEA(PG8_SA(0, 1), cA + hstepA, gC1);
        if (wr == 1) PG8_BAR;
        PG8_WAIT_V(4); PG8_BAR;
        PG8_STAGE(PG8_SB(1, 0), cB + kstep, voffB); PG8_STAGEA(PG8_SA(1, 0), cA + kstep, gC0); PG8_STAGE(PG8_SB(1, 1), cB + hstep + kstep, voffB);
        PG8_WAIT_V(6); PG8_BAR;
    }
    for (;;) {
        const bool has_next = S.next(ui + 1, nxt);
        const char* nA = has_next ? S.a_ptr(nxt) : cA; const char* nB = has_next ? S.b_ptr(nxt) : cB;
        if constexpr (Sched::GATHER) {
#pragma unroll
            for (int i = 0; i < 2; ++i) {
                if (has_next) { gN0[i] = voffA[i] + (unsigned)S.a_row(nxt, RA[i]) * (unsigned)(K * 2); gN1[i] = voffA[i] + (unsigned)S.a_row(nxt, HALF + RA[i]) * (unsigned)(K * 2); }
                else { gN0[i] = gC0[i]; gN1[i] = gC1[i]; }
            }
        }
        for (int t = 0; t < nt; t += 2) {
            const bool last = (t == nt - 2);
            const char* a1 = cA + (size_t)(t + 1) * kstep;
            const char* a2 = last ? nA : cA + (size_t)(t + 2) * kstep; const char* b2 = last ? nB : cB + (size_t)(t + 2) * kstep;
            const char* a3 = a2 + kstep; const char* b3 = b2 + kstep;
            if (last && has_next) S.a_ready(nxt);
            unsigned s0[2], s1[2];
#pragma unroll
            for (int i = 0; i < 2; ++i) { if constexpr (Sched::GATHER) { s0[i] = last ? gN0[i] : gC0[i]; s1[i] = last ? gN1[i] : gC1[i]; } else { s0[i] = gC0[i]; s1[i] = gC1[i]; } }
            if constexpr (SP2) {
            PG8_LDB(B0, 0, 0); PG8_LDB(B1, 0, 1); PG8_SCHED; PG8_LDA(At, 0, 0); PG8_STAGEA(PG8_SA(1, 1), a1 + hstepA, gC1);
            PG8_WAIT_V(8); PG8_WAIT_L(0); PG8_BAR; PG8_MMA(0, 0, At, B0); PG8_MMA(0, 1, At, B1); PG8_BAR; PG8_SCHED;
            PG8_LDA(At, 0, 1); PG8_STAGE(PG8_SB(0, 0), b2, voffB); PG8_STAGE(PG8_SB(0, 1), b2 + hstep, voffB); PG8_STAGEA(PG8_SA(0, 0), a2, s0);
            PG8_WAIT_V(8); PG8_WAIT_L(0); PG8_BAR; PG8_MMA(1, 0, At, B0); PG8_MMA(1, 1, At, B1); PG8_BAR; PG8_SCHED;
            PG8_LDB(B0, 1, 0); PG8_LDB(B1, 1, 1); PG8_SCHED; PG8_LDA(At, 1, 0); PG8_STAGEA(PG8_SA(0, 1), a2 + hstepA, s1);
            PG8_WAIT_V(8); PG8_WAIT_L(0); PG8_BAR; PG8_MMA(0, 0, At, B0); PG8_MMA(0, 1, At, B1); PG8_BAR; PG8_SCHED;
            PG8_LDA(At, 1, 1); PG8_STAGE(PG8_SB(1, 0), b3, voffB); PG8_STAGE(PG8_SB(1, 1), b3 + hstep, voffB); PG8_STAGEA(PG8_SA(1, 0), a3, s0);
            PG8_WAIT_V(8); PG8_WAIT_L(0); PG8_BAR; PG8_MMA(1, 0, At, B0); PG8_MMA(1, 1, At, B1); PG8_BAR; PG8_SCHED;
            } else {
            PG8_LDB(B0, 0, 0); PG8_SCHED; PG8_LDA(At, 0, 0); PG8_STAGEA(PG8_SA(1, 1), a1 + hstepA, gC1);
            PG8_WAIT_L(8); PG8_BAR; PG8_WAIT_L(0); PG8_MMA(0, 0, At, B0); PG8_BAR; PG8_SCHED;
            PG8_LDB(B1, 0, 1); PG8_STAGE(PG8_SB(0, 0), b2, voffB);
            PG8_BAR; PG8_WAIT_L(0); PG8_MMA(0, 1, At, B1); PG8_BAR;
            PG8_LDA(At, 0, 1); PG8_STAGEA(PG8_SA(0, 0), a2, s0);
            PG8_BAR; PG8_WAIT_L(0); PG8_MMA(1, 0, At, B0); PG8_BAR; PG8_SCHED;
            PG8_STAGE(PG8_SB(0, 1), b2 + hstep, voffB);
            PG8_WAIT_V(6); PG8_BAR; PG8_MMA(1, 1, At, B1); PG8_BAR;
            PG8_LDB(B0, 1, 0); PG8_SCHED; PG8_LDA(At, 1, 0); PG8_STAGEA(PG8_SA(0, 1), a2 + hstepA, s1);
            PG8_WAIT_L(8); PG8_BAR; PG8_WAIT_L(0); PG8_MMA(0, 0, At, B0); PG8_BAR; PG8_SCHED;
            PG8_LDB(B1, 1, 1); PG8_STAGE(PG8_SB(1, 0), b3, voffB);
            PG8_BAR; PG8_WAIT_L(0); PG8_MMA(0, 1, At, B1); PG8_BAR;
            PG8_LDA(At, 1, 1); PG8_STAGEA(PG8_SA(1, 0), a3, s0);
            PG8_BAR; PG8_WAIT_L(0); PG8_MMA(1, 0, At, B0); PG8_BAR; PG8_SCHED;
            PG8_STAGE(PG8_SB(1, 1), b3 + hstep, voffB);
            PG8_WAIT_V(6); PG8_BAR; PG8_MMA(1, 1, At, B1); PG8_BAR;
            }
        }
        if constexpr (ALIGN_EPI) { if (wr == 0) PG8_BAR; }
        E(acc, cur, wr, wc, fr, fq); S.done(cur, lane);
        if (!has_next) break;
#pragma unroll
        for (int a = 0; a < 2; ++a)
#pragma unroll
            for (int b = 0; b < 2; ++b)
#pragma unroll
                for (int m = 0; m < 4; ++m)
#pragma unroll
                    for (int n = 0; n < 2; ++n) acc[a][b][m][n] = (f32x4){0.f, 0.f, 0.f, 0.f};
        cur = nxt; cA = nA; cB = nB; ++ui;
#pragma unroll
        for (int i = 0; i < 2; ++i) { gC0[i] = gN0[i]; gC1[i] = gN1[i]; }
        if constexpr (ALIGN_EPI) { if (wr == 1) PG8_BAR; }
    }
    PG8_WAIT_V(0);
    if constexpr (!ALIGN_EPI) { if (wr == 0) PG8_BAR; }
    PG8_BAR;
#undef PG8_SA
#undef PG8_SB
#undef PG8_STAGE
#undef PG8_STAGEA
#undef PG8_STAGE_X
#undef PG8_LDA
#undef PG8_LDB
#undef PG8_MMA
#undef PG8_WAIT_V
#undef PG8_WAIT_L
#undef PG8_BAR
#undef PG8_SCHED
}

struct EpiBf16 {
    static constexpr bool PERM = true;
    bf16_t* O; int ldc;
    __device__ __forceinline__ void operator()(const f32x4 (&acc)[2][2][4][2], const Unit& u, int wr, int wc, int fr, int fq) const {
        const int row0 = u.pm * BM + wr * 64 + fr, col0 = u.pn * BM + wc * 32 + 8 * fq;
#pragma unroll
        for (int ai = 0; ai < 2; ++ai)
#pragma unroll
            for (int m = 0; m < 4; ++m) { bf16_t* rowp = O + (size_t)(row0 + ai * HALF + m * 16) * ldc + col0;
#pragma unroll
                for (int bj = 0; bj < 2; ++bj) { const f32x4 v0 = acc[ai][bj][m][0], v1 = acc[ai][bj][m][1];
                    u32x4 w; w.x = cvt_pk_bf16(v0[0], v0[1]); w.y = cvt_pk_bf16(v0[2], v0[3]); w.z = cvt_pk_bf16(v1[0], v1[1]); w.w = cvt_pk_bf16(v1[2], v1[3]);
                    *(u32x4*)(rowp + bj * HALF) = w; } }
    }
};
struct EpiResF32 {
    static constexpr bool PERM = true;
    const float* base; float* C; int ldc; bf16_t* H;
    __device__ __forceinline__ void operator()(const f32x4 (&acc)[2][2][4][2], const Unit& u, int wr, int wc, int fr, int fq) const {
        const int row0 = u.pm * BM + wr * 64 + fr, col0 = u.pn * BM + wc * 32 + 8 * fq;
#pragma unroll
        for (int ai = 0; ai < 2; ++ai)
#pragma unroll
            for (int m = 0; m < 4; ++m) { const size_t off = (size_t)(row0 + ai * HALF + m * 16) * ldc + col0;
#pragma unroll
                for (int bj = 0; bj < 2; ++bj) {
                    const f32x4 v0 = *(const f32x4*)(base + off + bj * HALF) + acc[ai][bj][m][0], v1 = *(const f32x4*)(base + off + bj * HALF + 4) + acc[ai][bj][m][1];
                    *(f32x4*)(C + off + bj * HALF) = v0; *(f32x4*)(C + off + bj * HALF + 4) = v1;
                    u32x4 h; h.x = cvt_pk_bf16(v0[0], v0[1]); h.y = cvt_pk_bf16(v0[2], v0[3]); h.z = cvt_pk_bf16(v1[0], v1[1]); h.w = cvt_pk_bf16(v1[2], v1[3]);
                    *(u32x4*)(H + off + bj * HALF) = h; } }
    }
};
}
#define RLX_AGENT __ATOMIC_RELAXED, __HIP_MEMORY_SCOPE_AGENT
#define XB_TMO      128
#define XB_XCNT(j)  (256  + 64 * (j))
#define XB_XSUB(j)  (1280 + 64 * (j))
#define XB_XGEN(j)  (2304 + 64 * (j))
#define XB_TOP      3328
#define XB_TOPGEN   3392
#define XCD_BAR_WORDS 3456
#define XB_SPIN_CAP (1u << 18)

__device__ __forceinline__ unsigned xb_ld(unsigned* p)              { return __hip_atomic_load(p, __ATOMIC_RELAXED, __HIP_MEMORY_SCOPE_AGENT); }
__device__ __forceinline__ unsigned xb_add(unsigned* p, unsigned v) { return __hip_atomic_fetch_add(p, v, __ATOMIC_RELAXED, __HIP_MEMORY_SCOPE_AGENT); }
__device__ __forceinline__ unsigned xb_xcc_id() { return (unsigned)__builtin_amdgcn_s_getreg((3 << 11) | 20) & 0xFu; }
#define XB_SPIN(cond, bar) do { unsigned _sp = 0; while (cond) { __builtin_amdgcn_s_sleep(1); \
    if ((++_sp & 255u) == 0u) { if (xb_ld(&(bar)[XB_TMO])) break; if (_sp > XB_SPIN_CAP) { atomicAdd(&(bar)[XB_TMO], 1u); break; } } } } while (0)

struct XcdBarrier {
    unsigned* bar; unsigned x;
    volatile LAS unsigned* st;
};

__device__ __forceinline__ XcdBarrier xcd_barrier_post(unsigned* bar, volatile LAS unsigned* st) {
    XcdBarrier b; b.bar = bar; b.x = xb_xcc_id(); b.st = st;
    if (threadIdx.x == 0) (void)xb_add(&bar[XB_XCNT(b.x)], 1u);
    return b;
}
__device__ __forceinline__ void xcd_barrier_complete(unsigned* bar, unsigned x, unsigned& nloc, unsigned& nx) {
    const unsigned G = gridDim.x * gridDim.y * gridDim.z;
    unsigned sum, cnt, mine, sp = 0u;
    for (;;) {
        sum = 0u; cnt = 0u; mine = 0u;
#pragma unroll
        for (unsigned j = 0; j < 16; ++j) { const unsigned c = xb_ld(&bar[XB_XCNT(j)]); sum += c; cnt += (c > 0u) ? 1u : 0u; mine = (j == x) ? c : mine; }
        if (sum == G) break;
        __builtin_amdgcn_s_sleep(1);
        if ((++sp & 255u) == 0u) { if (xb_ld(&bar[XB_TMO])) break; if (sp > XB_SPIN_CAP) { atomicAdd(&bar[XB_TMO], 1u); break; } }
    }
    nloc = mine > 0u ? mine : 1u; nx = cnt > 0u ? cnt : 1u;
}

__device__ __forceinline__ void xcd_barrier(const XcdBarrier& b) {
    asm volatile("s_waitcnt vmcnt(0)" ::: "memory");
    __syncthreads();
    if (threadIdx.x == 0) {
        unsigned* bar = b.bar;
        __builtin_amdgcn_s_waitcnt(0);
        unsigned nloc = b.st[0], nx = b.st[1];
        if (nloc == 0u) { xcd_barrier_complete(bar, b.x, nloc, nx); b.st[0] = nloc; b.st[1] = nx; }
        const unsigned old = xb_add(&bar[XB_XSUB(b.x)], 1u);
        const unsigned gen = old / nloc;
        if (old + 1u == (gen + 1u) * nloc) {
            __builtin_amdgcn_fence(__ATOMIC_RELEASE, "agent");
            asm volatile("s_waitcnt vmcnt(0)" ::: "memory");
            const unsigned og = xb_add(&bar[XB_TOP], 1u);
            const unsigned tg = og / nx;
            if (og + 1u == (tg + 1u) * nx) xb_add(&bar[XB_TOPGEN], 1u);
            else XB_SPIN(xb_ld(&bar[XB_TOPGEN]) == tg, bar);
            __builtin_amdgcn_fence(__ATOMIC_ACQUIRE, "agent");
            xb_add(&bar[XB_XGEN(b.x)], 1u);
            asm volatile("s_waitcnt vmcnt(0)" ::: "memory");
        } else {
            XB_SPIN(xb_ld(&bar[XB_XGEN(b.x)]) == gen, bar);
            __builtin_amdgcn_fence(__ATOMIC_ACQUIRE, "agent");
            asm volatile("s_waitcnt vmcnt(0)" ::: "memory");
        }
    }
    __syncthreads();
}

constexpr int NWAVES = 8, NTHREADS = 512;
constexpr int LDS_BYTES = 147456;
constexpr int NPHASES = 10;

constexpr int LDS_TAB = 131072;

#define STAMP(i) do { if (TSEL >= 100 && blockIdx.x == 0 && threadIdx.x == 0) ((unsigned long long*)(a.ws + WS_CTL + 24576))[i] = __builtin_amdgcn_s_memrealtime(); } while (0)
#ifndef TSEL
#define TSEL -1
#endif
#ifndef P8_ALIGN
#define P8_ALIGN true
#endif
#ifndef P8_SP2
#define P8_SP2 true
#endif
#ifndef WD_STATIC
#ifndef MOE_MERGED
#define MOE_MERGED 0
#endif
#define WD_STATIC (MOE_MERGED ? 16384 : 4096)
#endif
struct MkArgs {
    const float* in[22]; float* out; unsigned char* ws; int ph_lo, ph_hi, flags, li;
};

__device__ __forceinline__ float wave_sum(float v) {
#pragma unroll
    for (int o = 1; o < 64; o <<= 1) v += __shfl_xor(v, o);
    return v;
}

struct TrItem { const float* W; int ldw, k0, colA, colB; bf16_t* WT; int Kdst, drow0; const float* kscale; };
__device__ __forceinline__ void tr_load(const TrItem& t, int lane, f32x4 (&v)[8]) {
    const int n4 = (lane & 7) * 4, kr = lane >> 3; const int sc = n4 < 16 ? t.colA + n4 : t.colB + n4 - 16;
#pragma unroll
    for (int i = 0; i < 8; ++i) v[i] = __builtin_nontemporal_load((const f32x4*)(t.W + (size_t)(t.k0 + i * 8 + kr) * t.ldw + sc));
}
__device__ __forceinline__ void tr_to_lds(LAS float* scr, int lane, const f32x4 (&v)[8]) {
    const int n4 = (lane & 7) * 4, kr = lane >> 3;
#pragma unroll
    for (int i = 0; i < 8; ++i) { LAS float* s = scr + (i * 8 + kr) * 33 + n4; s[0] = v[i][0]; s[1] = v[i][1]; s[2] = v[i][2]; s[3] = v[i][3]; }
}
__device__ __forceinline__ void tr_store(const TrItem& t, const LAS float* scr, int lane) {
    const int c = lane & 7;
    f32x4 k0v = {1.f, 1.f, 1.f, 1.f}, k1v = {1.f, 1.f, 1.f, 1.f};
    if (t.kscale) { k0v = *(const f32x4*)(t.kscale + t.k0 + 8 * c); k1v = *(const f32x4*)(t.kscale + t.k0 + 8 * c + 4); }
#pragma unroll
    for (int jj = 0; jj < 4; ++jj) { const int n = (lane >> 3) + 8 * jj; const LAS float* s = scr + (8 * c) * 33 + n;
        u32x4 o; o.x = cvt_pk_bf16(s[0 * 33] * k0v[0], s[1 * 33] * k0v[1]); o.y = cvt_pk_bf16(s[2 * 33] * k0v[2], s[3 * 33] * k0v[3]); o.z = cvt_pk_bf16(s[4 * 33] * k1v[0], s[5 * 33] * k1v[1]); o.w = cvt_pk_bf16(s[6 * 33] * k1v[2], s[7 * 33] * k1v[3]);
        *(u32x4*)(t.WT + (size_t)(t.drow0 + n) * t.Kdst + t.k0 + 8 * c) = o; }
}
template <class F>
__device__ __forceinline__ void tr_run(F item_of, int first, int end, int step, LAS float* scr, int lane) {
    if (first >= end) return;
    TrItem cur = item_of(first); f32x4 v[8];
    tr_load(cur, lane, v);
    for (int it = first; it < end; it += step) {
        tr_to_lds(scr, lane, v);
        LDS_WAIT();
        const int nx = it + step; TrItem nxt = cur;
        if (nx < end) { nxt = item_of(nx); tr_load(nxt, lane, v); }
        tr_store(cur, scr, lane);
        LDS_WAIT();
        cur = nxt;
    }
}
__device__ __forceinline__ TrItem tr_item_p0(const MkArgs& a, int r) {
    unsigned char* ws = a.ws;
    constexpr int I_IN = 32 * 192, I_S = 32;
    if (r < I_IN) { const int kb = r / 192, nb = r % 192, n0 = nb * 32; const int sc = win_col(n0); return TrItem{a.in[2], IN_DIM, kb * 64, sc, sc + 16, (bf16_t*)(ws + WS_WINT), DM, n0, nullptr}; } r -= I_IN;
    if (r < I_S) return TrItem{a.in[2], IN_DIM, r * 64, WI_GK, WI_DT, (bf16_t*)(ws + WS_WST), DM, 0, nullptr}; r -= I_S;
    const int kb = r / 64, nb = r % 64; return TrItem{a.in[12], DM, kb * 64, nb * 32, nb * 32 + 16, (bf16_t*)(ws + WS_WOUTT), DM, nb * 32, nullptr};
}
__device__ __forceinline__ TrItem tr_item_gu(const MkArgs& a, int r) {
    constexpr int I_G = 32 * 32 * 16;
    const int up = r >= I_G; if (up) r -= I_G; const int e = r / 512, q = r % 512, kb = q / 16, nb = q % 16, n0 = nb * 32;
    return TrItem{(up ? a.in[19] : a.in[18]) + (size_t)e * DM * DEXP, DEXP, kb * 64, n0, n0 + 16, (bf16_t*)(a.ws + WS_WGUT), DM, e * 1024 + (n0 >> 7) * 256 + up * 128 + (n0 & 127), a.in[13]};
}
__device__ __forceinline__ TrItem tr_item_d(const MkArgs& a, int r) {
    const int e = r / 512, q = r % 512, kb = q / 64, nb = q % 64, n0 = nb * 32;
    return TrItem{a.in[20] + (size_t)e * DEXP * DM, DM, kb * 64, n0, n0 + 16, (bf16_t*)(a.ws + WS_WDT), DEXP, e * DM + n0, nullptr};
}

__device__ __forceinline__ void rms_row_to_bf16(const float* __restrict__ xrow, const float* __restrict__ w, bf16_t* __restrict__ orow, int lane) {
    const f32x4* xr = (const f32x4*)xrow + lane; const f32x4* wr = (const f32x4*)w + lane;
    f32x4 v[8]; float s = 0.f;
#pragma unroll
    for (int j = 0; j < 8; ++j) { v[j] = xr[64 * j]; s += (v[j].x * v[j].x + v[j].y * v[j].y) + (v[j].z * v[j].z + v[j].w * v[j].w); }
    const float r = rsqrtf(wave_sum(s) * (1.f / DM) + EPS);
    u32x2* o8 = (u32x2*)orow + lane;
#pragma unroll
    for (int j = 0; j < 8; ++j) { const f32x4 ww = wr[64 * j]; u32x2 o; o.x = cvt_pk_bf16(v[j].x * r * ww.x, v[j].y * r * ww.y); o.y = cvt_pk_bf16(v[j].z * r * ww.z, v[j].w * r * ww.w); o8[64 * j] = o; }
}

__device__ __forceinline__ void phase0(const MkArgs& a, LAS unsigned char* lds, int wave, int lane) {
    unsigned char* ws = a.ws;
    LAS float* scr = (LAS float*)(lds + wave * 16384);
    const int gw = blockIdx.x * NWAVES + wave, NGW = gridDim.x * NWAVES;
    constexpr int NITEMS = 32 * 192 + 32 + 32 * 64;
    tr_run([&](int r) { return tr_item_p0(a, r); }, gw, NITEMS, NGW, scr, lane);
    {
        bf16_t* WrT = (bf16_t*)(ws + WS_WRT);
        for (int idx = gw * 64 + lane; idx < 48 * DM; idx += NGW * 64) { const int n = idx / DM, k = idx % DM;
            const float v = a.in[13][k] * (n < 4 ? a.in[14][k * 4 + n] : (n < 36 ? a.in[16][k * 32 + n - 4] : 0.f));
            const bf16_t hi = f2bf(v); WrT[idx] = hi; WrT[48 * DM + idx] = f2bf(v - bf2f(hi)); }
    }
    bf16_t* hA = (bf16_t*)(ws + WS_HA);
    {
        const f32x4* wr = (const f32x4*)a.in[1] + lane;
        f32x4 v[8], nv[8];
        if (gw < T_TOK) { const f32x4* xr = (const f32x4*)(a.in[0] + (size_t)gw * DM) + lane;
#pragma unroll
            for (int j = 0; j < 8; ++j) v[j] = __builtin_nontemporal_load(xr + 64 * j); }
        for (int m = gw; m < T_TOK; m += NGW) {
            const int mn = m + NGW;
            if (mn < T_TOK) { const f32x4* xr = (const f32x4*)(a.in[0] + (size_t)mn * DM) + lane;
#pragma unroll
                for (int j = 0; j < 8; ++j) nv[j] = __builtin_nontemporal_load(xr + 64 * j); }
            float s = 0.f;
#pragma unroll
            for (int j = 0; j < 8; ++j) s += (v[j].x * v[j].x + v[j].y * v[j].y) + (v[j].z * v[j].z + v[j].w * v[j].w);
            const float r = rsqrtf(wave_sum(s) * (1.f / DM) + EPS);
            u32x2* o8 = (u32x2*)(hA + (size_t)m * DM) + lane;
#pragma unroll
            for (int j = 0; j < 8; ++j) { const f32x4 ww = wr[64 * j]; u32x2 o; o.x = cvt_pk_bf16(v[j].x * r * ww.x, v[j].y * r * ww.y); o.y = cvt_pk_bf16(v[j].z * r * ww.z, v[j].w * r * ww.w); o8[64 * j] = o; }
#pragma unroll
            for (int j = 0; j < 8; ++j) v[j] = nv[j];
        }
    }
}

__device__ __forceinline__ void skinny32_phase(const bf16_t* __restrict__ A, const bf16_t* __restrict__ BsT, float* __restrict__ out, LAS unsigned char* lds, int wave, int lane) {
    const int fr = lane & 15, fq = lane >> 4, tid = threadIdx.x;
    LAS f32x4* red = (LAS f32x4*)lds;
    for (int mt = blockIdx.x; mt < T_TOK / 64; mt += gridDim.x) {
        const bf16_t* ap = A + (size_t)(mt * 64 + fr) * DM + wave * 256 + fq * 8;
        const bf16_t* bp = BsT + (size_t)fr * DM + wave * 256 + fq * 8;
        f32x4 acc[4][2];
#pragma unroll
        for (int m = 0; m < 4; ++m) { acc[m][0] = (f32x4){0.f, 0.f, 0.f, 0.f}; acc[m][1] = (f32x4){0.f, 0.f, 0.f, 0.f}; }
        bf16x8 av[8][4], bv[8][2];
#pragma unroll
        for (int ks = 0; ks < 8; ++ks) {
#pragma unroll
            for (int m = 0; m < 4; ++m) av[ks][m] = *(const bf16x8*)(ap + (size_t)m * 16 * DM + ks * 32);
            bv[ks][0] = *(const bf16x8*)(bp + ks * 32); bv[ks][1] = *(const bf16x8*)(bp + (size_t)16 * DM + ks * 32); }
#pragma unroll
        for (int ks = 0; ks < 8; ++ks)
#pragma unroll
            for (int m = 0; m < 4; ++m) { acc[m][0] = __builtin_amdgcn_mfma_f32_16x16x32_bf16(av[ks][m], bv[ks][0], acc[m][0], 0, 0, 0); acc[m][1] = __builtin_amdgcn_mfma_f32_16x16x32_bf16(av[ks][m], bv[ks][1], acc[m][1], 0, 0, 0); }
#pragma unroll
        for (int m = 0; m < 4; ++m) { red[(wave * 8 + m * 2 + 0) * 64 + lane] = acc[m][0]; red[(wave * 8 + m * 2 + 1) * 64 + lane] = acc[m][1]; }
        __syncthreads();
        {
            const int slot = tid >> 6, ln = tid & 63, m = slot >> 1, n = slot & 1;
            f32x4 v = red[slot * 64 + ln];
#pragma unroll
            for (int w = 1; w < 8; ++w) v += red[(w * 8 + slot) * 64 + ln];
#pragma unroll
            for (int j = 0; j < 4; ++j) out[(size_t)(mt * 64 + m * 16 + 4 * (ln >> 4) + j) * 32 + n * 16 + (ln & 15)] = v[j];
        }
        __syncthreads();
    }
}

__device__ __forceinline__ void phase1(const MkArgs& a, LAS unsigned char* lds, int wave, int lane) {
    unsigned char* ws = a.ws;
    const bf16_t* hA = (const bf16_t*)(ws + WS_HA);
    skinny32_phase(hA, (const bf16_t*)(ws + WS_WST), (float*)(ws + WS_SMALL), lds, wave, lane);
    pg8::StaticOrder S; S.init(hA, (const bf16_t*)(ws + WS_WINT), T_TOK, PJ, DM, gridDim.x, blockIdx.x);
    pg8::EpiBf16 E{(bf16_t*)(ws + WS_PROJ), PJ};
    pg8::gemm_phase<pg8::EpiBf16, pg8::StaticOrder>(lds, DM, S, E);
}

__device__ __forceinline__ void phase5(const MkArgs& a, LAS unsigned char* lds, float* x1) {
    unsigned char* ws = a.ws;
    pg8::StaticOrder S; S.init((const bf16_t*)(ws + WS_HA), (const bf16_t*)(ws + WS_WOUTT), T_TOK, DM, DM, gridDim.x, blockIdx.x);
    pg8::EpiResF32 E{a.in[0], x1, DM, (bf16_t*)(ws + WS_H2U)};
    pg8::gemm_phase<pg8::EpiResF32, pg8::StaticOrder>(lds, DM, S, E);
}


__device__ __forceinline__ void phase6(const MkArgs& a, LAS unsigned char* lds, const float* x1, int wave, int lane) {
    unsigned char* ws = a.ws;
    const int fr = lane & 15, fq = lane >> 4, tid = threadIdx.x;
    const bf16_t* WrT = (const bf16_t*)(ws + WS_WRT);
    float* rstd2 = (float*)(ws + WS_RSTD);
    int* cnt = (int*)(ws + WS_CTL); int* list = (int*)(ws + WS_LIST);
    int* tok_e = (int*)(ws + WS_TOKE); float* tok_w = (float*)(ws + WS_TOKW);
    LAS f32x4* red = (LAS f32x4*)lds;
    LAS float* redss = (LAS float*)(lds + 98304);
    LAS float* lg = (LAS float*)(lds + 100352);
    LAS float* ssum = (LAS float*)(lds + 112896);
    for (int mt = blockIdx.x; mt < T_TOK / 64; mt += gridDim.x) {
        const float* xp = x1 + (size_t)(mt * 64 + fr) * DM + wave * 256 + fq * 8;
        const bf16_t* bp = WrT + (size_t)fr * DM + wave * 256 + fq * 8;
        f32x4 acc[4][3];
#pragma unroll
        for (int m = 0; m < 4; ++m)
#pragma unroll
            for (int n = 0; n < 3; ++n) acc[m][n] = (f32x4){0.f, 0.f, 0.f, 0.f};
        float ss[4] = {0.f, 0.f, 0.f, 0.f};
        f32x4 XA[4][2], XB[4][2]; bf16x8 BA[3][2], BB[3][2];
#define R_LOAD(ks_, X, B) do { _Pragma("unroll") for (int m_ = 0; m_ < 4; ++m_) { \
            X[m_][0] = __builtin_nontemporal_load((const f32x4*)(xp + (size_t)m_ * 16 * DM + (ks_) * 32)); X[m_][1] = __builtin_nontemporal_load((const f32x4*)(xp + (size_t)m_ * 16 * DM + (ks_) * 32 + 4)); } \
            _Pragma("unroll") for (int n_ = 0; n_ < 3; ++n_) { B[n_][0] = *(const bf16x8*)(bp + (size_t)n_ * 16 * DM + (ks_) * 32); B[n_][1] = *(const bf16x8*)(bp + (size_t)(48 + n_ * 16) * DM + (ks_) * 32); } } while (0)
#define R_COMP(X, B) do { _Pragma("unroll") for (int m_ = 0; m_ < 4; ++m_) { const f32x4 xa = X[m_][0], xb = X[m_][1]; \
            ss[m_] += (xa.x * xa.x + xa.y * xa.y) + (xa.z * xa.z + xa.w * xa.w) + (xb.x * xb.x + xb.y * xb.y) + (xb.z * xb.z + xb.w * xb.w); \
            u32x4 hi; hi.x = cvt_pk_bf16(xa.x, xa.y); hi.y = cvt_pk_bf16(xa.z, xa.w); hi.z = cvt_pk_bf16(xb.x, xb.y); hi.w = cvt_pk_bf16(xb.z, xb.w); \
            u32x4 lo; \
            lo.x = cvt_pk_bf16(xa.x - bflo(hi.x), xa.y - bfhi(hi.x)); lo.y = cvt_pk_bf16(xa.z - bflo(hi.y), xa.w - bfhi(hi.y)); \
            lo.z = cvt_pk_bf16(xb.x - bflo(hi.z), xb.y - bfhi(hi.z)); lo.w = cvt_pk_bf16(xb.z - bflo(hi.w), xb.w - bfhi(hi.w)); \
            const bf16x8 ah = __builtin_bit_cast(bf16x8, hi), al = __builtin_bit_cast(bf16x8, lo); \
            _Pragma("unroll") for (int n_ = 0; n_ < 3; ++n_) { \
                acc[m_][n_] = __builtin_amdgcn_mfma_f32_16x16x32_bf16(ah, B[n_][0], acc[m_][n_], 0, 0, 0); \
                acc[m_][n_] = __builtin_amdgcn_mfma_f32_16x16x32_bf16(al, B[n_][0], acc[m_][n_], 0, 0, 0); \
                acc[m_][n_] = __builtin_amdgcn_mfma_f32_16x16x32_bf16(ah, B[n_][1], acc[m_][n_], 0, 0, 0); } } } while (0)
        STAMP(0);
        R_LOAD(0, XA, BA);
#pragma unroll 1
        for (int ks = 0; ks < 8; ks += 2) {
            R_LOAD(ks + 1, XB, BB);
            R_COMP(XA, BA);
            if (ks + 2 < 8) R_LOAD(ks + 2, XA, BA);
            R_COMP(XB, BB);
        }
#undef R_LOAD
#undef R_COMP
        STAMP(1);
#pragma unroll
        for (int m = 0; m < 4; ++m) { float s = ss[m]; s += __shfl_xor(s, 16); s += __shfl_xor(s, 32); if (fq == 0) redss[wave * 64 + m * 16 + fr] = s;
#pragma unroll
            for (int n = 0; n < 3; ++n) red[(wave * 12 + m * 3 + n) * 64 + lane] = acc[m][n]; }
        __syncthreads();
        for (int s = tid; s < 768; s += NTHREADS) { const int slot = s >> 6, ln = s & 63, m = slot / 3, n = slot % 3;
            f32x4 v = red[slot * 64 + ln];
#pragma unroll
            for (int w = 1; w < 8; ++w) v += red[(w * 12 + slot) * 64 + ln];
#pragma unroll
            for (int j = 0; j < 4; ++j) lg[(m * 16 + 4 * (ln >> 4) + j) * 49 + n * 16 + (ln & 15)] = v[j]; }
        if (tid < 64) { float s = 0.f;
#pragma unroll
            for (int w = 0; w < 8; ++w) s += redss[w * 64 + tid];
            ssum[tid] = s; }
        __syncthreads();
        STAMP(2);
        if (wave == 0) {
            const int t = mt * 64 + lane;
            const float r = rsqrtf(ssum[lane] * (1.f / DM) + EPS);
            rstd2[t] = r;
            const LAS float* l = lg + lane * 49;
            float gm = -1e30f; int gi = 0; float gl[4];
#pragma unroll
            for (int j = 0; j < 4; ++j) { gl[j] = l[j] * r + a.in[15][j]; if (gl[j] > gm) { gm = gl[j]; gi = j; } }
            float gs = 0.f;
#pragma unroll
            for (int j = 0; j < 4; ++j) gs += __expf(gl[j] - gm);
            const float gw_ = 1.f / gs;
            float m0 = -1e30f, m1 = -1e30f; int i0 = 0, i1 = 0;
            for (int j = 0; j < 8; ++j) { const float v = l[4 + gi * 8 + j] * r + a.in[17][gi * 8 + j];
                if (v > m0) { m1 = m0; i1 = i0; m0 = v; i0 = j; } else if (v > m1) { m1 = v; i1 = j; } }
            const float e1 = __expf(m1 - m0);
            const float w0 = gw_ / (1.f + e1), w1 = gw_ * e1 / (1.f + e1);
            const int ex0 = gi * 8 + i0, ex1 = gi * 8 + i1;
            tok_e[t * 2] = ex0; tok_e[t * 2 + 1] = ex1; tok_w[t * 2] = w0; tok_w[t * 2 + 1] = w1;
            LAS int* hist = (LAS int*)(lds + 113152);
            if (lane < 32) hist[lane] = 0;
            LDS_WAIT();
            const int p0 = atomicAdd((int*)(hist + ex0), 1);
            const int p1 = atomicAdd((int*)(hist + ex1), 1);
            LDS_WAIT();
            if (lane < 32) { const int hc = hist[lane]; if (hc > 0) hist[32 + lane] = atomicAdd(&cnt[lane * 64], hc); }
            LDS_WAIT();
            list[ex0 * T_TOK + hist[32 + ex0] + p0] = t * 2;
            list[ex1 * T_TOK + hist[32 + ex1] + p1] = t * 2 + 1;
        }
        STAMP(3);
        __syncthreads();
        STAMP(4);
    }
}
__device__ __forceinline__ void phase6b(const MkArgs& a, LAS unsigned char* lds, int wave, int lane) {
    LAS float* scr = (LAS float*)(lds + 32768 + wave * 8704);
    const int gw = blockIdx.x * NWAVES + wave, NGW = gridDim.x * NWAVES;
    tr_run([&](int r) { return tr_item_gu(a, r); }, gw, 2 * 32 * 32 * 16, NGW, scr, lane);
    tr_run([&](int r) { return tr_item_d(a, r); }, gw, WD_STATIC, NGW, scr, lane);
#ifdef WARM_H2U
    {
        const u32x4* p = (const u32x4*)(a.ws + WS_H2U); u32x4 acc = {0u, 0u, 0u, 0u};
        for (size_t i = (size_t)gw * 64 + lane; i < (size_t)T_TOK * DM * 2 / 16; i += (size_t)NGW * 64 * 4) {
            const u32x4 v0 = p[i], v1 = (i + (size_t)NGW * 64 < (size_t)T_TOK * DM / 8) ? p[i + (size_t)NGW * 64] : acc, v2 = (i + (size_t)NGW * 128 < (size_t)T_TOK * DM / 8) ? p[i + (size_t)NGW * 128] : acc, v3 = (i + (size_t)NGW * 192 < (size_t)T_TOK * DM / 8) ? p[i + (size_t)NGW * 192] : acc;
            acc ^= v0 ^ v1 ^ v2 ^ v3; }
        asm volatile("" :: "v"(acc));
    }
#endif
}
__device__ __forceinline__ void wdt_queue(const MkArgs& a, LAS unsigned char* lds, int wave, int lane) {
    unsigned char* ws = a.ws;
    unsigned* wq = (unsigned*)(ws + WS_CTL + 16384);
    LAS float* scr = (LAS float*)(lds + wave * 8704);
    LAS unsigned* slot = (LAS unsigned*)(lds + 8 * 8704);
    constexpr int I_D = 32 * 8 * 64;
    for (;;) {
        if (threadIdx.x == 0) slot[0] = WD_STATIC + atomicAdd(wq, 64u);
        __syncthreads();
        const unsigned base = slot[0];
        __syncthreads();
        if (base >= (unsigned)I_D) break;
        tr_run([&](int r) { return tr_item_d(a, r); }, (int)base + wave * 8, (int)base + wave * 8 + 8, 1, scr, lane);
    }
}

template <bool GATHER_T>
struct MoeOrderT {
    static constexpr bool GATHER = GATHER_T; static constexpr int A_AUX = (GATHER_T || !MOE_MERGED) ? 0 : 16;
    const char* A; const char* Bt; const int* list; const LAS int* tab; int NT, K, G, c, nwg; size_t bstride;
    __device__ bool next(int i, pg8::Unit& u) const {
        long L;
        if (GATHER || i < dmin) L = (long)i * G + c;
        else { if (c < n3) return false; L = (long)dmin * G + (long)(i - dmin) * (G - n3) + (c - n3); }
        if (L >= nwg) return false;
        int wgid = (int)L; { const int q = nwg / 8, r = nwg % 8, xcd = wgid % 8, off = wgid / 8; wgid = (xcd < r ? xcd * (q + 1) : r * (q + 1) + (xcd - r) * q) + off; }
        int e = 0;
        for (; e < 31; ++e) { const int te = __builtin_amdgcn_readfirstlane(tab[33 + e] - tab[32 + e]); if (wgid < te * NT) break; wgid -= te * NT; }
        const int te = __builtin_amdgcn_readfirstlane(tab[33 + e] - tab[32 + e]), tp = __builtin_amdgcn_readfirstlane(tab[32 + e]);
        const int pn = wgid / te, mt = wgid % te;
        u.pm = tp + mt; u.pn = pn; u.e = e; u.row0 = mt * 256; u.ne = __builtin_amdgcn_readfirstlane(tab[e]); return true;
    }
    __device__ __forceinline__ const char* a_ptr(const pg8::Unit& u) const { return GATHER ? A : A + (size_t)u.pm * 256 * K * 2; }
    __device__ __forceinline__ const char* b_ptr(const pg8::Unit& u) const { return Bt + (size_t)u.e * bstride + (size_t)u.pn * 256 * K * 2; }
    __device__ __forceinline__ int a_row(const pg8::Unit& u, int r) const { const int rr = u.row0 + r; return rr < u.ne ? (list[(size_t)u.e * T_TOK + rr] >> 1) : 0; }
    unsigned* ready; int n3, dmin;
    __device__ __forceinline__ void done(const pg8::Unit& u, int lane) const {
        if (GATHER && MOE_MERGED) { asm volatile("s_waitcnt vmcnt(0)" ::: "memory");
#ifdef HANDOFF_STRICT
            __builtin_amdgcn_fence(__ATOMIC_RELEASE, "agent"); asm volatile("s_waitcnt vmcnt(0)" ::: "memory");
#endif
            if (lane == 0) __hip_atomic_fetch_add(ready + 64 * u.pm, 1u, __ATOMIC_RELAXED, __HIP_MEMORY_SCOPE_AGENT); }
    }
    __device__ __forceinline__ void a_ready(const pg8::Unit& u) const {
        if (!GATHER && MOE_MERGED) {
            if (threadIdx.x < 64) {
                const unsigned long long t0 = __builtin_amdgcn_s_memrealtime();
                while ((unsigned)__builtin_amdgcn_readfirstlane(__hip_atomic_load(ready + 64 * u.pm, __ATOMIC_RELAXED, __HIP_MEMORY_SCOPE_AGENT)) < 32u) {
                    if (__builtin_amdgcn_s_memrealtime() - t0 > 2000000ull) break;
                    __builtin_amdgcn_s_sleep(2); }
            }
            asm volatile("" ::: "memory"); __builtin_amdgcn_s_barrier(); asm volatile("" ::: "memory");
#ifdef HANDOFF_STRICT
            __builtin_amdgcn_fence(__ATOMIC_ACQUIRE, "agent"); asm volatile("s_waitcnt vmcnt(0)" ::: "memory");
#endif
        }
    }
};
__device__ __forceinline__ int moe_tables(const int* cnt, LAS int* tab) {
    if (threadIdx.x < 32) tab[threadIdx.x] = __hip_atomic_load(cnt + threadIdx.x * 64, __ATOMIC_RELAXED, __HIP_MEMORY_SCOPE_AGENT);
    __syncthreads();
    if (threadIdx.x == 0) { int p = 0; for (int e = 0; e < 32; ++e) { tab[32 + e] = p; p += (tab[e] + 255) >> 8; } tab[64] = p; }
    __syncthreads();
    return __builtin_amdgcn_readfirstlane(tab[64]);
}
struct EpiSwiGLU {
    static constexpr bool PERM = true;
    bf16_t* H; const int* list; const float* rstd;
    __device__ __forceinline__ void operator()(const f32x4 (&acc)[2][2][4][2], const pg8::Unit& u, int wr, int wc, int fr, int fq) const {
#pragma unroll
        for (int ai = 0; ai < 2; ++ai)
#pragma unroll
            for (int m = 0; m < 4; ++m) { const int rt = ai * 128 + wr * 64 + m * 16 + fr; const int rr = u.row0 + rt;
                const float rs = rr < u.ne ? rstd[list[(size_t)u.e * T_TOK + rr] >> 1] : 0.f;
                const f32x4 g0 = acc[ai][0][m][0] * rs, g1 = acc[ai][0][m][1] * rs, u0 = acc[ai][1][m][0] * rs, u1 = acc[ai][1][m][1] * rs;
                float h[8];
#pragma unroll
                for (int j = 0; j < 4; ++j) { h[j] = g0[j] / (1.f + __expf(-g0[j])) * u0[j]; h[4 + j] = g1[j] / (1.f + __expf(-g1[j])) * u1[j]; }
                u32x4 w; w.x = cvt_pk_bf16(h[0], h[1]); w.y = cvt_pk_bf16(h[2], h[3]); w.z = cvt_pk_bf16(h[4], h[5]); w.w = cvt_pk_bf16(h[6], h[7]);
                unsigned long long* hp = (unsigned long long*)(H + (size_t)(u.pm * 256 + rt) * DEXP + u.pn * 128 + wc * 32 + 8 * fq);
                if (MOE_MERGED) {
                    __hip_atomic_store(hp, ((unsigned long long)w.y << 32) | w.x, __ATOMIC_RELAXED, __HIP_MEMORY_SCOPE_AGENT);
                    __hip_atomic_store(hp + 1, ((unsigned long long)w.w << 32) | w.z, __ATOMIC_RELAXED, __HIP_MEMORY_SCOPE_AGENT);
                } else *(u32x4*)hp = w; }
    }
};
struct EpiDown {
    static constexpr bool PERM = true;
    bf16_t* Y; const int* list;
    __device__ __forceinline__ void operator()(const f32x4 (&acc)[2][2][4][2], const pg8::Unit& u, int wr, int wc, int fr, int fq) const {
#pragma unroll
        for (int ai = 0; ai < 2; ++ai)
#pragma unroll
            for (int m = 0; m < 4; ++m) { const int rr = u.row0 + ai * 128 + wr * 64 + m * 16 + fr;
                if (rr < u.ne) { const int slot = list[(size_t)u.e * T_TOK + rr]; bf16_t* rowp = Y + (size_t)slot * DM + u.pn * 256 + wc * 32 + 8 * fq;
#pragma unroll
                    for (int bj = 0; bj < 2; ++bj) { const f32x4 v0 = acc[ai][bj][m][0], v1 = acc[ai][bj][m][1];
                        u32x4 w; w.x = cvt_pk_bf16(v0[0], v0[1]); w.y = cvt_pk_bf16(v0[2], v0[3]); w.z = cvt_pk_bf16(v1[0], v1[1]); w.w = cvt_pk_bf16(v1[2], v1[3]);
                        *(u32x4*)(rowp + bj * 128) = w; } } }
    }
};
template <class BAR>
__device__ __forceinline__ void phase78(const MkArgs& a, LAS unsigned char* lds, BAR midbar) {
    unsigned char* ws = a.ws;
    LAS int* tab = (LAS int*)(lds + LDS_TAB);
    const int tiles = moe_tables((const int*)(ws + WS_CTL), tab);
    unsigned* ready = (unsigned*)(ws + WS_CTL + 131072);
    const int G = gridDim.x, c = blockIdx.x, U = tiles * 4, Dn = tiles * 8;
    {
        MoeOrderT<true> S; S.A = (const char*)(ws + WS_H2U); S.Bt = (const char*)(ws + WS_WGUT); S.list = (const int*)(ws + WS_LIST); S.tab = tab; S.NT = 4; S.K = DM; S.G = G; S.c = c; S.nwg = U; S.bstride = (size_t)1024 * DM * 2;
        S.ready = ready; S.n3 = 0; S.dmin = 0;
        EpiSwiGLU E{(bf16_t*)(ws + WS_HMID), (const int*)(ws + WS_LIST), (const float*)(ws + WS_RSTD)};
        pg8::gemm_phase<EpiSwiGLU, MoeOrderT<true>>(lds, DM, S, E);
    }
    midbar();
    {
        int n3 = U % G; int x = (Dn + 2 * n3) / G; int dmin = x - 2; if (dmin < 0) dmin = 0;
        if (!MOE_MERGED) { n3 = 0; dmin = 1 << 20; }
        MoeOrderT<false> S; S.A = (const char*)(ws + WS_HMID); S.Bt = (const char*)(ws + WS_WDT); S.list = (const int*)(ws + WS_LIST); S.tab = tab; S.NT = 8; S.K = DEXP; S.G = G; S.c = c; S.nwg = Dn; S.bstride = (size_t)DM * DEXP * 2;
        S.ready = ready; S.n3 = n3; S.dmin = dmin;
        EpiDown E{(bf16_t*)(ws + WS_Y), (const int*)(ws + WS_LIST)};
        pg8::gemm_phase<EpiDown, MoeOrderT<false>, P8_ALIGN, P8_SP2>(lds, DEXP, S, E);
    }
}
__device__ __forceinline__ void phase9(const MkArgs& a, int wave, int lane) {
    unsigned char* ws = a.ws;
    const bf16_t* Y = (const bf16_t*)(ws + WS_Y); const float* tok_w = (const float*)(ws + WS_TOKW);
    const int gw = blockIdx.x * NWAVES + wave, NGW = gridDim.x * NWAVES;
    const f32x4* wf = (const f32x4*)a.in[21] + lane;
    f32x4 v[8], nv[8]; u32x2 p[8], q[8], np[8], nq[8]; float w0 = 0.f, w1 = 0.f, nw0 = 0.f, nw1 = 0.f;
#define P9_LOAD(T, V, P, Q, W0, W1) do { W0 = tok_w[(T) * 2]; W1 = tok_w[(T) * 2 + 1]; const f32x4* xr_ = (const f32x4*)(a.out + (size_t)(T) * DM) + lane; \
        const u32x2* y0_ = (const u32x2*)(Y + (size_t)((T) * 2) * DM) + lane; const u32x2* y1_ = (const u32x2*)(Y + (size_t)((T) * 2 + 1) * DM) + lane; \
        _Pragma("unroll") for (int j = 0; j < 8; ++j) { V[j] = xr_[64 * j]; P[j] = __builtin_nontemporal_load(y0_ + 64 * j); Q[j] = __builtin_nontemporal_load(y1_ + 64 * j); } } while (0)
    if (gw < T_TOK) P9_LOAD(gw, v, p, q, w0, w1);
    for (int t = gw; t < T_TOK; t += NGW) {
        const int tn = t + NGW;
        if (tn < T_TOK) P9_LOAD(tn, nv, np, nq, nw0, nw1);
        float s = 0.f;
#pragma unroll
        for (int j = 0; j < 8; ++j) {
            v[j].x += w0 * bflo(p[j].x) + w1 * bflo(q[j].x); v[j].y += w0 * bfhi(p[j].x) + w1 * bfhi(q[j].x);
            v[j].z += w0 * bflo(p[j].y) + w1 * bflo(q[j].y); v[j].w += w0 * bfhi(p[j].y) + w1 * bfhi(q[j].y);
            s += (v[j].x * v[j].x + v[j].y * v[j].y) + (v[j].z * v[j].z + v[j].w * v[j].w); }
        const float r = rsqrtf(wave_sum(s) * (1.f / DM) + EPS);
        f32x4* xo = (f32x4*)(a.out + (size_t)t * DM) + lane;
#pragma unroll
        for (int j = 0; j < 8; ++j) { const f32x4 ww = wf[64 * j]; xo[64 * j] = (f32x4){v[j].x * r * ww.x, v[j].y * r * ww.y, v[j].z * r * ww.z, v[j].w * r * ww.w}; }
#pragma unroll
        for (int j = 0; j < 8; ++j) { v[j] = nv[j]; p[j] = np[j]; q[j] = nq[j]; }
        w0 = nw0; w1 = nw1;
    }
#undef P9_LOAD
}

__device__ __forceinline__ bf16x8 ldfrag(const LAS bf16_t* base, int stride, int r0, int k0, int fr, int fq) {
    return *(const LAS bf16x8*)(base + (r0 + fr) * stride + k0 + fq * 8);
}
#define MFMA16(X, Y, C) __builtin_amdgcn_mfma_f32_16x16x32_bf16((X), (Y), (C), 0, 0, 0)
__device__ __forceinline__ u32x2 pack4(f32x4 v) { u32x2 o; o.x = cvt_pk_bf16(v[0], v[1]); o.y = cvt_pk_bf16(v[2], v[3]); return o; }

template <class SC>
__device__ __forceinline__ void load_transposed(const bf16_t* __restrict__ src, size_t ld, int ntp, int ncol8, LAS unsigned* dst32, int dstride32, int tid, SC scale) {
    for (int u = tid; u < ntp * ncol8; u += NTHREADS) {
        const int tp = u % ntp, cg = u / ntp;
        const bf16_t* p = src + (size_t)(2 * tp) * ld + cg * 8;
        const u32x4 r0 = *(const u32x4*)p, r1 = *(const u32x4*)(p + ld);
        const float s0 = scale(2 * tp, cg), s1 = scale(2 * tp + 1, cg);
#pragma unroll
        for (int i = 0; i < 4; ++i) {
            dst32[(cg * 8 + 2 * i) * dstride32 + tp] = cvt_pk_bf16(bflo(r0[i]) * s0, bflo(r1[i]) * s1);
            dst32[(cg * 8 + 2 * i + 1) * dstride32 + tp] = cvt_pk_bf16(bfhi(r0[i]) * s0, bfhi(r1[i]) * s1);
        }
    }
}
struct NoScale { __device__ __forceinline__ float operator()(int, int) const { return 1.f; } };


typedef short s16x4 __attribute__((ext_vector_type(4)));
__device__ __forceinline__ bf16x8 ldfrag_tr(const LAS bf16_t* T, int stride, int k0, int c0, int lane) {
    const int idx = lane & 15, q = idx >> 2, p = idx & 3, fq = lane >> 4;
    const LAS bf16_t* ptr = T + (k0 + 8 * fq + q) * stride + c0 + 4 * p;
    const s16x4 lo = __builtin_amdgcn_ds_read_tr16_b64_v4i16((LAS s16x4*)ptr), hi = __builtin_amdgcn_ds_read_tr16_b64_v4i16((LAS s16x4*)(ptr + 4 * stride));
    return (bf16x8){lo[0], lo[1], lo[2], lo[3], hi[0], hi[1], hi[2], hi[3]};
}
__device__ __forceinline__ float fast_logsigmoid(float g) { return fminf(g, 0.f) - __logf(1.f + __expf(-fabsf(g))); }
__device__ __forceinline__ float fast_silu(float v) { return v * __builtin_amdgcn_rcpf(1.f + __expf(-v)); }
__device__ __forceinline__ void unpack8(u32x4 r, float (&f)[8]) { f[0] = bflo(r.x); f[1] = bfhi(r.x); f[2] = bflo(r.y); f[3] = bfhi(r.y); f[4] = bflo(r.z); f[5] = bfhi(r.z); f[6] = bflo(r.w); f[7] = bfhi(r.w); }
__device__ __forceinline__ u32x4 pack8(const float (&f)[8]) { u32x4 w; w.x = cvt_pk_bf16(f[0], f[1]); w.y = cvt_pk_bf16(f[2], f[3]); w.z = cvt_pk_bf16(f[4], f[5]); w.w = cvt_pk_bf16(f[6], f[7]); return w; }

#define GLA2_TILES(IT, GK, VV, QV, KV) do { const int c_ = (IT) & 63, bh_ = (IT) >> 6, h_ = bh_ & 3, b_ = bh_ >> 2; const size_t t0_ = (size_t)b_ * SEQ + c_ * 64; \
        _Pragma("unroll") for (int i = 0; i < 2; ++i) { const int u = tid + i * NTHREADS; GK[i] = small[(t0_ + (u >> 4)) * 32 + (u & 15)]; } \
        _Pragma("unroll") for (int i = 0; i < 4; ++i) { const int u = tid + i * NTHREADS, t = u >> 5, c8 = u & 31; VV[i] = *(const u32x4*)(proj + (t0_ + t) * PJ + PV + h_ * 256 + c8 * 8); } \
        _Pragma("unroll") for (int i = 0; i < 2; ++i) { const int u = tid + i * NTHREADS, t = u >> 4, d8 = u & 15; \
            QV[i] = *(const u32x4*)(proj + (t0_ + t) * PJ + PQ + h_ * 128 + d8 * 8); KV[i] = *(const u32x4*)(proj + (t0_ + t) * PJ + PK + h_ * 128 + d8 * 8); } } while (0)
__device__ __forceinline__ void gla_p2_loop(const MkArgs& a, LAS unsigned char* lds, int first, int end, int step, int tid, int wave, int lane) {
    unsigned char* ws = a.ws;
    const bf16_t* proj = (const bf16_t*)(ws + WS_PROJ); const float* small = (const float*)(ws + WS_SMALL);
    float gkv[2], ngk[2]; u32x4 vv[4], qv[2], kv[2], nvv[4], nqv[2], nkv[2];
    if (first < end) GLA2_TILES(first, gkv, vv, qv, kv);
    const int fr = lane & 15, fq = lane >> 4;
    bf16x8 wb1, wb2; float gbias; int hcur = -1;
    for (int item = first; item < end; item += step) {
    const int c = item & 63, bh = item >> 6, h = bh & 3, b = bh >> 2;
    const size_t t0 = (size_t)b * SEQ + c * 64;
    if (h != hcur) { hcur = h; float w8[8], hi8[8], lo8[8];
#pragma unroll
        for (int jx = 0; jx < 8; ++jx) { w8[jx] = a.in[3][(8 * (fq & 1) + jx) * 512 + h * 128 + wave * 16 + fr]; hi8[jx] = bf2f(f2bf(w8[jx])); lo8[jx] = fq < 2 ? w8[jx] - hi8[jx] : 0.f; }
        wb1 = __builtin_bit_cast(bf16x8, pack8(hi8)); wb2 = __builtin_bit_cast(bf16x8, pack8(lo8)); gbias = a.in[4][h * 128 + wave * 16 + fr]; }
    bf16_t* QT = (bf16_t*)(ws + WS_QT); bf16_t* KT = (bf16_t*)(ws + WS_KT); bf16_t* GS = (bf16_t*)(ws + WS_GS); float* GDEC = (float*)(ws + WS_GDEC);
    LAS bf16_t* vS = (LAS bf16_t*)(lds);
    LAS bf16_t* kd = (LAS bf16_t*)(lds + 33792);
    LAS float* Gs = (LAS float*)(lds + 51200);
    LAS float* gk = (LAS float*)(lds + 84992);
    LAS float* part = (LAS float*)(lds + 89088);
    LAS float* tot = (LAS float*)(lds + 91136);
#pragma unroll
    for (int i = 0; i < 2; ++i) gk[tid + i * NTHREADS] = gkv[i];
#pragma unroll
    for (int i = 0; i < 4; ++i) { const int u = tid + i * NTHREADS, t = u >> 5, c8 = u & 31; *(LAS u32x4*)(vS + t * 264 + c8 * 8) = vv[i]; }
    __syncthreads();
    if (item + step < end) GLA2_TILES(item + step, ngk, nvv, nqv, nkv);
    {
        float la[4][4];
#pragma unroll
        for (int tt = 0; tt < 4; ++tt) {
            const f32x4 x0 = *(const LAS f32x4*)(gk + (tt * 16 + fr) * 16 + 8 * (fq & 1)), x1 = *(const LAS f32x4*)(gk + (tt * 16 + fr) * 16 + 8 * (fq & 1) + 4);
            float xv[8] = {x0[0], x0[1], x0[2], x0[3], x1[0], x1[1], x1[2], x1[3]}, av[8];
#pragma unroll
            for (int jx = 0; jx < 8; ++jx) { const float hi = bf2f(f2bf(xv[jx])); av[jx] = fq < 2 ? hi : xv[jx] - hi; }
            const bf16x8 af = __builtin_bit_cast(bf16x8, pack8(av));
            f32x4 acc = {gbias, gbias, gbias, gbias};
            acc = MFMA16(af, wb1, acc); acc = MFMA16(af, wb2, acc);
#pragma unroll
            for (int jx = 0; jx < 4; ++jx) la[tt][jx] = fast_logsigmoid(acc[jx]) * (1.f / 16.f);
        }
        float base = 0.f;
#pragma unroll
        for (int tt = 0; tt < 4; ++tt) {
            const float c0 = la[tt][0], c1 = c0 + la[tt][1], c2 = c1 + la[tt][2], c3 = c2 + la[tt][3];
            float x = c3; float y = __shfl_up(x, 16); if (fq >= 1) x += y; y = __shfl_up(x, 32); if (fq >= 2) x += y;
            const float ex = base + x - c3;
            LAS float* gp = Gs + (tt * 16 + 4 * fq) * 132 + wave * 16 + fr;
            gp[0] = ex + c0; gp[132] = ex + c1; gp[264] = ex + c2; gp[396] = ex + c3;
            base += __shfl(x, 48 + fr);
        }
        if (fq == 0) { tot[wave * 16 + fr] = base; ((float*)(ws + WS_GDEC))[item * 128 + wave * 16 + fr] = __expf(base); }
    }
    __syncthreads();
    const float scale = 0.08838834764831845f;
#pragma unroll
    for (int i = 0; i < 2; ++i) { const int u = tid + i * NTHREADS, t = u >> 4, d8 = u & 15;
        const f32x4 g0 = *(const LAS f32x4*)(Gs + t * 132 + d8 * 8), g1 = *(const LAS f32x4*)(Gs + t * 132 + d8 * 8 + 4);
        const f32x4 z0 = *(const LAS f32x4*)(tot + d8 * 8), z1 = *(const LAS f32x4*)(tot + d8 * 8 + 4);
        float q[8], k[8], qo[8], ko[8], kdo[8]; unpack8(qv[i], q); unpack8(kv[i], k);
#pragma unroll
        for (int j = 0; j < 8; ++j) { const float Gj = j < 4 ? g0[j] : g1[j - 4], Tj = j < 4 ? z0[j] : z1[j - 4];
            qo[j] = q[j] * scale * __expf(Gj); ko[j] = k[j] * __expf(-Gj); kdo[j] = k[j] * __expf(Tj - Gj); }
        *(u32x4*)(QT + (t0 + t) * 512 + h * 128 + d8 * 8) = pack8(qo);
        *(u32x4*)(KT + (t0 + t) * 512 + h * 128 + d8 * 8) = pack8(ko);
        *(LAS u32x4*)(kd + t * 136 + d8 * 8) = pack8(kdo); }
    __syncthreads();
    bf16_t* gs = GS + (size_t)item * 32768;
#pragma unroll
    for (int et = 0; et < 2; ++et) {
        const int e0 = wave * 32 + et * 16;
        const bf16x8 y0 = ldfrag_tr(vS, 264, 0, e0, lane), y1 = ldfrag_tr(vS, 264, 32, e0, lane);
#pragma unroll
        for (int dt_ = 0; dt_ < 8; ++dt_) {
            f32x4 acc = {0.f, 0.f, 0.f, 0.f};
            acc = MFMA16(ldfrag_tr(kd, 136, 0, dt_ * 16, lane), y0, acc);
            acc = MFMA16(ldfrag_tr(kd, 136, 32, dt_ * 16, lane), y1, acc);
            *(u32x2*)(gs + (e0 + fr) * 128 + dt_ * 16 + 4 * fq) = pack4(acc);
        }
    }
    __syncthreads();
#pragma unroll
    for (int i = 0; i < 2; ++i) { gkv[i] = ngk[i]; qv[i] = nqv[i]; kv[i] = nkv[i]; }
#pragma unroll
    for (int i = 0; i < 4; ++i) vv[i] = nvv[i];
    }
}
#undef GLA2_TILES
__device__ __forceinline__ void scan_phase(const MkArgs& a, int flags) {
    unsigned char* ws = a.ws;
    const int u = blockIdx.x * NTHREADS + threadIdx.x, NU = gridDim.x * NTHREADS;
    if (flags & 1) {
        bf16_t* GS = (bf16_t*)(ws + WS_GS); const float* GDEC = (const float*)(ws + WS_GDEC);
        for (int v = u; v < 16 * 8192; v += NU) {
            const int bh = v >> 13, rem = v & 8191, e = rem >> 5, d0 = (rem & 31) * 4;
            f32x4 S = {0.f, 0.f, 0.f, 0.f};
            for (int c0 = 0; c0 < 64; c0 += 8) {
                u32x2 loc[8]; f32x4 dec[8];
#pragma unroll
                for (int i = 0; i < 8; ++i) { const int item = bh * 64 + c0 + i; loc[i] = *(const u32x2*)(GS + (size_t)item * 32768 + e * 128 + d0); dec[i] = *(const f32x4*)(GDEC + item * 128 + d0); }
#pragma unroll
                for (int i = 0; i < 8; ++i) { const int item = bh * 64 + c0 + i; *(u32x2*)(GS + (size_t)item * 32768 + e * 128 + d0) = pack4(S);
                    S = S * dec[i] + (f32x4){bflo(loc[i].x), bfhi(loc[i].x), bflo(loc[i].y), bfhi(loc[i].y)}; }
            }
        }
    }
    if (flags & 2) {
        bf16_t* SS = (bf16_t*)(ws + WS_SS); const float* ACS = (const float*)(ws + WS_ACS);
        for (int v = u; v < 64 * 2048; v += NU) {
            const int bhd = v >> 11, rem = v & 2047, b = bhd >> 4, head = bhd & 15;
            f32x4 S = {0.f, 0.f, 0.f, 0.f};
            for (int c0 = 0; c0 < 32; c0 += 8) {
                u32x2 loc[8]; float dec[8];
#pragma unroll
                for (int i = 0; i < 8; ++i) { const int c = c0 + i; const size_t item = ((size_t)b * 32 + c) * 16 + head; loc[i] = *(const u32x2*)(SS + item * 8192 + rem * 4);
                    dec[i] = __expf(ACS[((size_t)b * SEQ + c * 128 + 127) * 16 + head]); }
#pragma unroll
                for (int i = 0; i < 8; ++i) { const int c = c0 + i; const size_t item = ((size_t)b * 32 + c) * 16 + head; *(u32x2*)(SS + item * 8192 + rem * 4) = pack4(S);
                    S = S * dec[i] + (f32x4){bflo(loc[i].x), bfhi(loc[i].x), bflo(loc[i].y), bfhi(loc[i].y)}; }
            }
        }
    }
}


#define GLA4_TILES(IT) do { const int c_ = (IT) & 63, bh_ = (IT) >> 6, h_ = bh_ & 3, b_ = bh_ >> 2; const size_t t0_ = (size_t)b_ * SEQ + c_ * 64; \
        _Pragma("unroll") for (int i = 0; i < 4; ++i) { const int u = tid + i * NTHREADS, t = u >> 5, c8 = u & 31; vv[i] = *(const u32x4*)(proj + (t0_ + t) * PJ + PV + h_ * 256 + c8 * 8); } \
        _Pragma("unroll") for (int i = 0; i < 2; ++i) { const int u = tid + i * NTHREADS, t = u >> 4, d8 = u & 15; \
            qv[i] = *(const u32x4*)(QT + (t0_ + t) * 512 + h_ * 128 + d8 * 8); kv[i] = *(const u32x4*)(KT + (t0_ + t) * 512 + h_ * 128 + d8 * 8); } } while (0)
__device__ __forceinline__ void gla_p4_loop(const MkArgs& a, LAS unsigned char* lds, int first, int end, int step, int tid, int wave, int lane) {
    unsigned char* ws = a.ws;
    const bf16_t* proj = (const bf16_t*)(ws + WS_PROJ);
    const bf16_t* QT = (const bf16_t*)(ws + WS_QT); const bf16_t* KT = (const bf16_t*)(ws + WS_KT);
    u32x4 vv[4], qv[2], kv[2];
    if (first < end) GLA4_TILES(first);
    for (int item = first; item < end; item += step) {
    const int c = item & 63, bh = item >> 6, h = bh & 3, b = bh >> 2;
    const size_t t0 = (size_t)b * SEQ + c * 64;
    const bf16_t* gs = (const bf16_t*)(ws + WS_GS) + (size_t)item * 32768;
    bf16_t* mix = (bf16_t*)(ws + WS_HA);
    LAS bf16_t* qs = (LAS bf16_t*)(lds);
    LAS bf16_t* ks = (LAS bf16_t*)(lds + 17408);
    LAS bf16_t* vS = (LAS bf16_t*)(lds + 34816);
    LAS bf16_t* P = (LAS bf16_t*)(lds + 68608);
    LAS float* red = (LAS float*)(lds + 77824);
    const int fr = lane & 15, fq = lane >> 4;
    bf16x8 sx[2][4];
#pragma unroll
    for (int et = 0; et < 2; ++et)
#pragma unroll
        for (int kk = 0; kk < 4; ++kk) sx[et][kk] = *(const bf16x8*)(gs + (wave * 32 + et * 16 + fr) * 128 + kk * 32 + fq * 8);
    u32x2 gg[4][2];
#pragma unroll
    for (int mt = 0; mt < 4; ++mt)
#pragma unroll
        for (int et = 0; et < 2; ++et) gg[mt][et] = *(const u32x2*)(proj + (t0 + mt * 16 + fr) * PJ + PG + h * 256 + wave * 32 + et * 16 + 4 * fq);
#pragma unroll
    for (int i = 0; i < 4; ++i) { const int u = tid + i * NTHREADS, t = u >> 5, c8 = u & 31; *(LAS u32x4*)(vS + t * 264 + c8 * 8) = vv[i]; }
#pragma unroll
    for (int i = 0; i < 2; ++i) { const int u = tid + i * NTHREADS, t = u >> 4, d8 = u & 15; *(LAS u32x4*)(qs + t * 136 + d8 * 8) = qv[i]; *(LAS u32x4*)(ks + t * 136 + d8 * 8) = kv[i]; }
    __syncthreads();
    if (item + step < end) GLA4_TILES(item + step);
    {
        const int it = wave >> 1;
#pragma unroll
        for (int jj_ = 0; jj_ < 2; ++jj_) { const int jt = (wave & 1) * 2 + jj_;
            f32x4 acc = {0.f, 0.f, 0.f, 0.f};
            if (jt <= it) {
#pragma unroll
                for (int kk = 0; kk < 4; ++kk) acc = MFMA16(ldfrag(ks, 136, jt * 16, kk * 32, fr, fq), ldfrag(qs, 136, it * 16, kk * 32, fr, fq), acc);
                if (jt == it) {
#pragma unroll
                    for (int j = 0; j < 4; ++j) if (4 * fq + j > fr) acc[j] = 0.f;
                }
            }
            *(LAS u32x2*)(P + (it * 16 + fr) * 72 + jt * 16 + 4 * fq) = pack4(acc); }
    }
    __syncthreads();
    f32x4 o[4][2];
#pragma unroll
    for (int mt = 0; mt < 4; ++mt)
#pragma unroll
        for (int et = 0; et < 2; ++et) o[mt][et] = (f32x4){0.f, 0.f, 0.f, 0.f};
#pragma unroll
    for (int et = 0; et < 2; ++et) { const int e0 = wave * 32 + et * 16;
#pragma unroll
        for (int kk = 0; kk < 2; ++kk) { const bf16x8 x = ldfrag_tr(vS, 264, kk * 32, e0, lane);
#pragma unroll
            for (int mt = 0; mt < 4; ++mt) if (mt * 16 + 15 >= kk * 32) o[mt][et] = MFMA16(x, ldfrag(P, 72, mt * 16, kk * 32, fr, fq), o[mt][et]); }
#pragma unroll
        for (int kk = 0; kk < 4; ++kk) {
#pragma unroll
            for (int mt = 0; mt < 4; ++mt) o[mt][et] = MFMA16(sx[et][kk], ldfrag(qs, 136, mt * 16, kk * 32, fr, fq), o[mt][et]); }
    }
#pragma unroll
    for (int mt = 0; mt < 4; ++mt) { float s = 0.f;
#pragma unroll
        for (int et = 0; et < 2; ++et)
#pragma unroll
            for (int j = 0; j < 4; ++j) s += o[mt][et][j] * o[mt][et][j];
        s += __shfl_xor(s, 16); s += __shfl_xor(s, 32);
        if (fq == 0) red[wave * 64 + mt * 16 + fr] = s; }
    __syncthreads();
#pragma unroll
    for (int mt = 0; mt < 4; ++mt) { const int i = mt * 16 + fr; float s = 0.f;
#pragma unroll
        for (int w = 0; w < 8; ++w) s += red[w * 64 + i];
        const float r = rsqrtf(s * (1.f / 256.f) + EPS);
#pragma unroll
        for (int et = 0; et < 2; ++et) { const int e = wave * 32 + et * 16 + 4 * fq;
            const u32x2 g = gg[mt][et]; const f32x4 wn = *(const f32x4*)(a.in[5] + e);
            f32x4 v = o[mt][et] * r * wn; v[0] *= fast_silu(bflo(g.x)); v[1] *= fast_silu(bfhi(g.x)); v[2] *= fast_silu(bflo(g.y)); v[3] *= fast_silu(bfhi(g.y));
            *(u32x2*)(mix + (t0 + i) * DM + h * 256 + e) = pack4(v); } }
    __syncthreads();
    }
}
#undef GLA4_TILES

__device__ __forceinline__ void ssd_p2_item(const MkArgs& a, LAS unsigned char* lds, int item, int tid, int wave, int lane) {
    unsigned char* ws = a.ws;
    const int g = item & 3, c = (item >> 2) & 31, b = item >> 7;
    const size_t t0 = (size_t)b * SEQ + c * 128;
    const bf16_t* proj = (const bf16_t*)(ws + WS_PROJ); const float* small = (const float*)(ws + WS_SMALL);
    bf16_t* XC = (bf16_t*)(ws + WS_XC); bf16_t* BC = (bf16_t*)(ws + WS_BC); bf16_t* CC = (bf16_t*)(ws + WS_CC); bf16_t* SS = (bf16_t*)(ws + WS_SS);
    float* DT = (float*)(ws + WS_DT); float* ACS = (float*)(ws + WS_ACS);
    LAS bf16_t* xsd = (LAS bf16_t*)(lds);
    LAS bf16_t* Bs = (LAS bf16_t*)(lds + 67584);
    LAS float* fac = (LAS float*)(lds + 102400);
    const int c8 = lane, kind = c8 < 32 ? 0 : (c8 < 48 ? 1 : 2);
    const int xch = kind == 0 ? g * 256 + c8 * 8 : (kind == 1 ? 1024 + g * 128 + (c8 - 32) * 8 : 1536 + g * 128 + (c8 - 48) * 8);
    const int tb = wave * 16;
    const bf16_t* src = proj + (t0 + tb) * PJ + PX + xch;
    u32x4 raw[19];
#pragma unroll
    for (int i = 0; i < 19; ++i) { raw[i] = (u32x4){0u, 0u, 0u, 0u}; if (i >= 3 || tb > 0 || c > 0) raw[i] = *(const u32x4*)(src + ((long)i - 3) * PJ); }
    if (wave < 4) {
        const int head = g * 4 + wave; const float av = -__expf(a.in[9][head]), dtb = a.in[8][head];
        const float d0 = softplusf(small[(t0 + 2 * lane) * 32 + 16 + head] + dtb), d1 = softplusf(small[(t0 + 2 * lane + 1) * 32 + 16 + head] + dtb);
        const float a0 = d0 * av, a1 = d1 * av;
        float v = a0 + a1;
#pragma unroll
        for (int o = 1; o < 64; o <<= 1) { const float u = __shfl_up(v, o); if (lane >= o) v += u; }
        const float ex = v - (a0 + a1), alast = __shfl(v, 63);
        fac[wave * 128 + 2 * lane] = d0 * __expf(alast - (ex + a0)); fac[wave * 128 + 2 * lane + 1] = d1 * __expf(alast - v);
        DT[(t0 + 2 * lane) * 16 + head] = d0; DT[(t0 + 2 * lane + 1) * 16 + head] = d1;
        ACS[(t0 + 2 * lane) * 16 + head] = ex + a0; ACS[(t0 + 2 * lane + 1) * 16 + head] = v;
    }
    float wk[4][8], bs[8];
#pragma unroll
    for (int k = 0; k < 4; ++k) { const f32x4 w0 = *(const f32x4*)(a.in[6] + k * 2048 + xch), w1 = *(const f32x4*)(a.in[6] + k * 2048 + xch + 4);
#pragma unroll
        for (int j = 0; j < 4; ++j) { wk[k][j] = w0[j]; wk[k][4 + j] = w1[j]; } }
    { const f32x4 b0 = *(const f32x4*)(a.in[7] + xch), b1 = *(const f32x4*)(a.in[7] + xch + 4);
#pragma unroll
      for (int j = 0; j < 4; ++j) { bs[j] = b0[j]; bs[4 + j] = b1[j]; } }
    __syncthreads();
    {
        bf16_t* gdst = kind == 0 ? XC + (t0 + tb) * 1024 + g * 256 + c8 * 8 : (kind == 1 ? BC + (t0 + tb) * 512 + g * 128 + (c8 - 32) * 8 : CC + (t0 + tb) * 512 + g * 128 + (c8 - 48) * 8);
        const size_t gld = kind == 0 ? 1024 : 512;
        float u0[8], u1[8], u2[8], u3[8];
        unpack8(raw[0], u0); unpack8(raw[1], u1); unpack8(raw[2], u2);
#pragma unroll
        for (int i = 0; i < 16; ++i) {
            unpack8(raw[i + 3], u3);
            float o[8];
#pragma unroll
            for (int j = 0; j < 8; ++j) o[j] = fast_silu(bs[j] + wk[0][j] * u0[j] + wk[1][j] * u1[j] + wk[2][j] * u2[j] + wk[3][j] * u3[j]);
            *(u32x4*)(gdst + (size_t)i * gld) = pack8(o);
            if (kind == 0) { const float f = fac[(c8 >> 3) * 128 + tb + i];
#pragma unroll
                for (int j = 0; j < 8; ++j) o[j] *= f;
                *(LAS u32x4*)(xsd + (tb + i) * 264 + c8 * 8) = pack8(o); }
            else if (kind == 1) *(LAS u32x4*)(Bs + (tb + i) * 136 + (c8 - 32) * 8) = pack8(o);
#pragma unroll
            for (int j = 0; j < 8; ++j) { u0[j] = u1[j]; u1[j] = u2[j]; u2[j] = u3[j]; }
        }
    }
    __syncthreads();
    {
        const int fr = lane & 15, fq = lane >> 4, r = wave >> 1;
        bf16_t* ss = SS + (((size_t)b * 32 + c) * 16 + g * 4 + r) * 8192;
#pragma unroll
        for (int pi = 0; pi < 2; ++pi) { const int pt = (wave & 1) * 2 + pi;
            bf16x8 y[4];
#pragma unroll
            for (int kk = 0; kk < 4; ++kk) y[kk] = ldfrag_tr(xsd, 264, kk * 32, r * 64 + pt * 16, lane);
#pragma unroll
            for (int nt = 0; nt < 8; ++nt) { f32x4 acc = {0.f, 0.f, 0.f, 0.f};
#pragma unroll
                for (int kk = 0; kk < 4; ++kk) acc = MFMA16(ldfrag_tr(Bs, 136, kk * 32, nt * 16, lane), y[kk], acc);
                *(u32x2*)(ss + (pt * 16 + fr) * 128 + nt * 16 + 4 * fq) = pack4(acc); } }
    }
    __syncthreads();
}

__device__ __forceinline__ void ssd_p4_item(const MkArgs& a, LAS unsigned char* lds, int item, int tid, int wave, int lane) {
    unsigned char* ws = a.ws;
    const int g = item & 3, c = (item >> 2) & 31, b = item >> 7;
    const size_t t0 = (size_t)b * SEQ + c * 128;
    const bf16_t* proj = (const bf16_t*)(ws + WS_PROJ);
    const bf16_t* XC = (const bf16_t*)(ws + WS_XC); const bf16_t* BC = (const bf16_t*)(ws + WS_BC); const bf16_t* CC = (const bf16_t*)(ws + WS_CC); const bf16_t* SS = (const bf16_t*)(ws + WS_SS);
    const float* DT = (const float*)(ws + WS_DT); const float* ACS = (const float*)(ws + WS_ACS);
    bf16_t* mix = (bf16_t*)(ws + WS_HA);
    LAS bf16_t* Cs = (LAS bf16_t*)(lds);
    LAS bf16_t* Bs = (LAS bf16_t*)(lds + 34816);
    LAS bf16_t* xs = (LAS bf16_t*)(lds + 69632);
    LAS bf16_t* Ss = (LAS bf16_t*)(lds + 104448);
    LAS float* acs = (LAS float*)(lds + 139264);
    const int fr = lane & 15, fq = lane >> 4, w = wave;
    acs[tid] = ACS[(t0 + (tid & 127)) * 16 + g * 4 + (tid >> 7)];
    for (int u = tid; u < 2048; u += NTHREADS) { const int r = u >> 4, cq = u & 15;
        *(LAS u32x4*)(Cs + r * 136 + cq * 8) = *(const u32x4*)(CC + (t0 + r) * 512 + g * 128 + cq * 8);
        *(LAS u32x4*)(Bs + r * 136 + cq * 8) = *(const u32x4*)(BC + (t0 + r) * 512 + g * 128 + cq * 8); }
    u32x4 xr[4], sr[4]; float dtr[4];
#define SSD4_LOAD(hp) do { _Pragma("unroll") for (int i = 0; i < 4; ++i) { const int u = tid + i * NTHREADS, t = u >> 4, cq = u & 15; \
        xr[i] = *(const u32x4*)(XC + (t0 + t) * 1024 + g * 256 + (hp) * 128 + cq * 8); dtr[i] = DT[(t0 + t) * 16 + g * 4 + (hp) * 2 + (cq >> 3)]; \
        sr[i] = *(const u32x4*)(SS + (((size_t)b * 32 + c) * 16 + g * 4 + (hp) * 2) * 8192 + (size_t)t * 128 + cq * 8); } } while (0)
#define SSD4_STORE() do { _Pragma("unroll") for (int i = 0; i < 4; ++i) { const int u = tid + i * NTHREADS, t = u >> 4, cq = u & 15; float f[8]; unpack8(xr[i], f); \
        _Pragma("unroll") for (int j = 0; j < 8; ++j) f[j] *= dtr[i]; *(LAS u32x4*)(xs + t * 136 + cq * 8) = pack8(f); *(LAS u32x4*)(Ss + t * 136 + cq * 8) = sr[i]; } } while (0)
    SSD4_LOAD(0);
    __syncthreads();
    bf16x8 cf[4];
#pragma unroll
    for (int kk = 0; kk < 4; ++kk) cf[kk] = ldfrag(Cs, 136, w * 16, kk * 32, fr, fq);
    f32x4 cb[8];
#pragma unroll
    for (int st = 0; st < 8; ++st) { cb[st] = (f32x4){0.f, 0.f, 0.f, 0.f};
        if (st <= w) {
#pragma unroll
            for (int kk = 0; kk < 4; ++kk) cb[st] = MFMA16(ldfrag(Bs, 136, st * 16, kk * 32, fr, fq), cf[kk], cb[st]); } }
    SSD4_STORE();
    __syncthreads();
    const int l = w * 16 + fr;
    float ssq = 0.f;
    bf16_t* mrow = mix + (t0 + l) * DM + 1024 + g * 256 + 4 * fq;
    u32x2 yk[4][4];
#pragma unroll 1
    for (int hp = 0; hp < 2; ++hp) {
        if (hp == 0) SSD4_LOAD(1);
#pragma unroll 1
        for (int r2 = 0; r2 < 2; ++r2) {
            const int r = hp * 2 + r2;
            const float al = acs[r * 128 + l];
#pragma unroll
            for (int st = 0; st < 8; ++st) if (st <= (w | 1)) { f32x4 mv;
#pragma unroll
                for (int j = 0; j < 4; ++j) { const int s = st * 16 + 4 * fq + j; mv[j] = (s <= l) ? cb[st][j] * __expf(al - acs[r * 128 + s]) : 0.f; }
                *(LAS u32x2*)(Bs + l * 136 + st * 16 + 4 * fq) = pack4(mv); }
            LDS_WAIT();
            const float eal = __expf(al), dsk = a.in[10][g * 4 + r];
            const bf16_t* xcp = XC + (t0 + l) * 1024 + g * 256 + r * 64 + 4 * fq; const bf16_t* zp = proj + (t0 + l) * PJ + PZ + g * 256 + r * 64 + 4 * fq;
            u32x2 xv[4], zv[4];
#pragma unroll
            for (int pt = 0; pt < 4; ++pt) { xv[pt] = *(const u32x2*)(xcp + pt * 16); zv[pt] = *(const u32x2*)(zp + pt * 16); }
#pragma unroll
            for (int pt = 0; pt < 4; ++pt) {
                f32x4 ad = {0.f, 0.f, 0.f, 0.f}, ao = {0.f, 0.f, 0.f, 0.f};
#pragma unroll
                for (int kk = 0; kk < 4; ++kk) if (kk <= (w >> 1)) ad = MFMA16(ldfrag_tr(xs, 136, kk * 32, r2 * 64 + pt * 16, lane), ldfrag(Bs, 136, w * 16, kk * 32, fr, fq), ad);
#pragma unroll
                for (int kk = 0; kk < 4; ++kk) ao = MFMA16(ldfrag(Ss, 136, r2 * 64 + pt * 16, kk * 32, fr, fq), cf[kk], ao);
                f32x4 y = ad + ao * eal;
                y[0] = (y[0] + dsk * bflo(xv[pt].x)) * fast_silu(bflo(zv[pt].x)); y[1] = (y[1] + dsk * bfhi(xv[pt].x)) * fast_silu(bfhi(zv[pt].x));
                y[2] = (y[2] + dsk * bflo(xv[pt].y)) * fast_silu(bflo(zv[pt].y)); y[3] = (y[3] + dsk * bfhi(xv[pt].y)) * fast_silu(bfhi(zv[pt].y));
                ssq += (y[0] * y[0] + y[1] * y[1]) + (y[2] * y[2] + y[3] * y[3]);
                { const u32x2 yp = pack4(y); if (r == 0) yk[0][pt] = yp; else if (r == 1) yk[1][pt] = yp; else if (r == 2) yk[2][pt] = yp; else yk[3][pt] = yp; }
            }
            LDS_WAIT();
        }
        if (hp == 0) { __syncthreads(); SSD4_STORE(); __syncthreads(); }
    }
#undef SSD4_LOAD
#undef SSD4_STORE
    ssq += __shfl_xor(ssq, 16); ssq += __shfl_xor(ssq, 32);
    const float rs = rsqrtf(ssq * (1.f / 256.f) + EPS);
#pragma unroll
    for (int q = 0; q < 16; ++q) { const f32x4 wn = *(const f32x4*)(a.in[11] + g * 256 + q * 16 + 4 * fq);
        const u32x2 v = yk[q >> 2][q & 3]; *(u32x2*)(mrow + q * 16) = pack4((f32x4){bflo(v.x), bfhi(v.x), bflo(v.y), bfhi(v.y)} * rs * wn); }
    __syncthreads();
}

__device__ __forceinline__ void phase2(const MkArgs& a, LAS unsigned char* lds, int tid, int wave, int lane) {
    if (a.flags & 64) for (int it = blockIdx.x; it < 512; it += gridDim.x) ssd_p2_item(a, lds, it, tid, wave, lane);
    if (a.flags & 2) for (int it = blockIdx.x; it < 512; it += gridDim.x) ssd_p2_item(a, lds, it, tid, wave, lane);
    if (a.flags & 1) gla_p2_loop(a, lds, blockIdx.x, 1024, gridDim.x, tid, wave, lane);
}
__device__ __forceinline__ void phase4(const MkArgs& a, LAS unsigned char* lds, int tid, int wave, int lane) {
#ifndef NO_SSD4
    if (a.flags & 128) for (int it = blockIdx.x; it < 512; it += gridDim.x) ssd_p4_item(a, lds, it, tid, wave, lane);
    if (a.flags & 2) for (int it = blockIdx.x; it < 512; it += gridDim.x) ssd_p4_item(a, lds, it, tid, wave, lane);
#endif
#ifndef NO_GLA4
    if (a.flags & 1) gla_p4_loop(a, lds, blockIdx.x, 1024, gridDim.x, tid, wave, lane);
#endif
}
__global__ void __launch_bounds__(NTHREADS, 2) mk_fwd(MkArgs a) {
    extern __shared__ __attribute__((aligned(16))) unsigned char lds_raw[];
    LAS unsigned char* lds = (LAS unsigned char*)lds_raw;
    const int tid = threadIdx.x, lane = tid & 63, wave = __builtin_amdgcn_readfirstlane(tid >> 6);
    const int lo = a.ph_lo, hi = a.ph_hi;
    volatile LAS unsigned* bst = (volatile LAS unsigned*)(lds + LDS_BYTES - 64);
    if (tid < 16) bst[tid] = 0u;
    __syncthreads();
    XcdBarrier bar = xcd_barrier_post((unsigned*)(a.ws + WS_BAR) + a.li * XCD_BAR_WORDS, bst);
#ifndef ONLY_PHASE
#define ONLY_PHASE -1
#endif
#define IN(k) ((ONLY_PHASE < 0 || ONLY_PHASE == (k)) && lo <= (k) && (k) < hi)
#ifndef TSCALE
#define TSCALE (0.01f / 4.f)
#endif
    unsigned long long tprev = 0, tsel0 = 0, tsel1 = 0;
    if (TSEL >= 0) tprev = __builtin_amdgcn_s_memrealtime();
    if (TSEL == 0) tsel0 = tprev;
#define SEAM(k) do { if (IN(k) && IN((k) + 1)) { xcd_barrier(bar); if (TSEL >= 0) { const unsigned long long tn = __builtin_amdgcn_s_memrealtime(); if (TSEL == (k) || (TSEL == 10 && (k) == 6) || (TSEL == 78 && (k) == 8)) tsel1 = tn; if (TSEL == 78 && (k) == 6) tsel0 = tn; if (TSEL == (k) + 1 || (TSEL == 11 && (k) == 5)) tsel0 = tn; } } } while (0)
    if (a.flags & 65536) { for (int i = 0; i < 10; ++i) xcd_barrier(bar); }
    if (IN(0)) { phase0(a, lds, wave, lane); if (a.flags & 8) phase0(a, lds, wave, lane); }
    SEAM(0);
    if (IN(1)) { phase1(a, lds, wave, lane); if (a.flags & 32768) phase1(a, lds, wave, lane); }
    SEAM(1);
    if (IN(2)) { phase2(a, lds, tid, wave, lane); if (a.flags & 16) phase2(a, lds, tid, wave, lane); }
    SEAM(2);
    if (IN(3)) { scan_phase(a, a.flags); }
    SEAM(3);
    if (IN(4)) { phase4(a, lds, tid, wave, lane); if (a.flags & 32) phase4(a, lds, tid, wave, lane); }
    SEAM(4);
    if (IN(5)) { phase5(a, lds, a.out); if (a.flags & 16384) phase5(a, lds, a.out); }
    SEAM(5);
    if (IN(6)) { phase6(a, lds, a.out, wave, lane);
#ifdef P6SPLIT
        xcd_barrier(bar); if (TSEL == 10) tsel0 = __builtin_amdgcn_s_memrealtime(); if (TSEL == 11) tsel1 = __builtin_amdgcn_s_memrealtime();
#endif
        phase6b(a, lds, wave, lane); }
    SEAM(6);
    if (IN(7)) { if (MOE_MERGED) phase78(a, lds, []() {}); else phase78(a, lds, [&]() { wdt_queue(a, lds, wave, lane); xcd_barrier(bar); }); }
    SEAM(8);
    if (IN(9)) { phase9(a, wave, lane); }
    if (TSEL >= 0) { if (TSEL == 9) tsel1 = __builtin_amdgcn_s_memrealtime(); __syncthreads(); VM_WAIT(); if (TSEL >= 100 && blockIdx.x == 0 && tid == 0) { const unsigned long long* st = (const unsigned long long*)(a.ws + WS_CTL + 24576); tsel0 = st[TSEL - 100]; tsel1 = st[TSEL - 99]; }
        if (blockIdx.x == 0 && tid == 0) a.out[0] += (float)(tsel1 - tsel0) * TSCALE; }
#undef IN
#undef SEAM
}

typedef short s16x4 __attribute__((ext_vector_type(4)));
__global__ void n_trtest(unsigned* flag) {
    __shared__ unsigned short T[32 * 72];
    for (int i = threadIdx.x; i < 32 * 72; i += 64) { const int r = i / 72, c = i % 72; T[i] = (unsigned short)(r * 16 + (c & 15) + 1000 * (c >> 4)); }
    __syncthreads();
    const int lane = threadIdx.x, idx = lane & 15, q = idx >> 2, p = idx & 3, fq = lane >> 4;
    const s16x4 v = __builtin_amdgcn_ds_read_tr16_b64_v4i16((__attribute__((address_space(3))) s16x4*)(T + (8 * fq + q) * 72 + 4 * p));
    bool bad = false;
    for (int j = 0; j < 4; ++j) if ((unsigned short)v[j] != (unsigned short)((8 * fq + j) * 16 + idx)) bad = true;
    if (bad) atomicOr(flag, 1u);
}
__global__ void n_poison(float* out, const unsigned* flag) { if (threadIdx.x == 0 && flag[0] != 0u) out[0] += 1000.f; }
#ifndef PROBE_FLAGS
#define PROBE_FLAGS 0
#endif
static int g_grid = 0;
static void launch_mk(MkArgs a, int lo, int hi, int li, hipStream_t stream) {
    if (g_grid == 0) {
        int dev = 0, cus = 0, per_cu = 0;
        hipGetDevice(&dev);
        hipDeviceGetAttribute(&cus, hipDeviceAttributeMultiprocessorCount, dev);
        hipFuncSetAttribute((const void*)mk_fwd, hipFuncAttributeMaxDynamicSharedMemorySize, LDS_BYTES);
        hipOccupancyMaxActiveBlocksPerMultiprocessor(&per_cu, (const void*)mk_fwd, NTHREADS, LDS_BYTES);
        if (per_cu < 1) { fprintf(stderr, "kernel_launch: occupancy query says %d blocks/CU\n", per_cu); per_cu = 1; }
        g_grid = cus * per_cu;
        fprintf(stderr, "kernel_launch: grid %d (%d CUs x %d)\n", g_grid, cus, per_cu);
    }
    a.ph_lo = lo; a.ph_hi = hi; a.li = li;
    void* args[] = {&a};
    hipError_t e = hipLaunchCooperativeKernel((const void*)mk_fwd, dim3(g_grid), dim3(NTHREADS), args, LDS_BYTES, stream);
    if (e != hipSuccess) fprintf(stderr, "cooperative launch failed: %s (grid %d)\n", hipGetErrorString(e), g_grid);
}

extern "C" void kernel_launch(void* const* d_in, const int* in_sizes, int n_in, void* d_out, int out_size, void* d_ws, size_t ws_size, hipStream_t stream) {
    if (n_in != 22 || out_size != T_TOK * DM || ws_size < WS_END) { fprintf(stderr, "kernel_launch: unexpected shapes (n_in %d, out %d, ws %zu < %zu); nothing launched\n", n_in, out_size, ws_size, (size_t)WS_END); return; }
    MkArgs a{};
    for (int i = 0; i < 22; ++i) a.in[i] = (const float*)d_in[i];
    a.out = (float*)d_out; a.ws = (unsigned char*)d_ws;
    (void)hipMemsetAsync((char*)d_ws + WS_CTL, 0, 262144, stream);
    a.flags = 3 | PROBE_FLAGS;
    launch_mk(a, 0, 10, 0, stream);
#ifdef TRTEST
    n_trtest<<<1, 64, 0, stream>>>((unsigned*)((char*)d_ws + WS_CTL + 20480));
    n_poison<<<1, 64, 0, stream>>>((float*)d_out, (const unsigned*)((char*)d_ws + WS_CTL + 20480));
#endif
}
```

```cpp
#include <hip/hip_runtime.h>
#include <cstdio>
#include <cstdint>

typedef unsigned short bf16_t;

constexpr int T_TOK = 16384, SEQ = 4096, NB = 4, DM = 2048;
constexpr int IN_DIM = 6176;
constexpr int PJ = 6144;
constexpr int PQ = 0, PK = 512, PV = 1024, PG = 2048, PZ = 3072, PX = 4096, PB = 5120, PC = 5632;
constexpr int WI_GK = 3072, WI_Z = 3088, WI_XBC = 4112, WI_DT = 6160;
constexpr int NEXP = 32, DEXP = 512;
constexpr float EPS = 1e-6f;

__device__ __forceinline__ float bf2f(bf16_t b) { return __uint_as_float(((unsigned)b) << 16); }
__device__ __forceinline__ bf16_t f2bf(float f) { unsigned u = __float_as_uint(f); u += 0x7FFFu + ((u >> 16) & 1u); return (bf16_t)(u >> 16); }
__device__ __forceinline__ float siluf(float v) { return v / (1.f + __expf(-v)); }
__device__ __forceinline__ float softplusf(float v) { return v > 20.f ? v : log1pf(__expf(v)); }
__device__ __forceinline__ float logsigmoidf(float v) { return fminf(v, 0.f) - log1pf(__expf(-fabsf(v))); }
__device__ __forceinline__ int win_col(int j) { return j < 3072 ? j : (j < 4096 ? j - 3072 + WI_Z : j - 4096 + WI_XBC); }
__device__ __forceinline__ int win_col_small(int j) { return j < 16 ? WI_GK + j : WI_DT + (j - 16); }

constexpr size_t MiB = 1024 * 1024;
constexpr size_t WS_CTL = 0;
constexpr size_t WS_BAR = 65536;
constexpr size_t WS_SMALL = 1 * MiB;
constexpr size_t WS_TOKE = WS_SMALL + 2 * MiB;
constexpr size_t WS_TOKW = WS_TOKE + MiB / 8;
constexpr size_t WS_LIST = WS_TOKW + MiB / 8;
constexpr size_t WS_RSTD = 6 * MiB;
constexpr size_t WS_WRT = 7 * MiB;
constexpr size_t WS_HA = 8 * MiB;
constexpr size_t WS_PROJ = WS_HA + 64 * MiB;
constexpr size_t WS_SCR = WS_PROJ + 192 * MiB;
constexpr size_t WS_Y = WS_SCR;
constexpr size_t WS_A8S = WS_SCR;
#ifndef MOE_MERGED
#define MOE_MERGED 0
#endif
#if MOE_MERGED
constexpr size_t WS_H8 = WS_PROJ + 64 * MiB;
#else
constexpr size_t WS_H8 = WS_SCR + 80 * MiB;
#endif
constexpr size_t WS_HMID = WS_SCR + 128 * MiB;
constexpr size_t WS_QT = WS_SCR;
constexpr size_t WS_KT = WS_QT + 16 * MiB;
constexpr size_t WS_GS = WS_KT + 16 * MiB;
constexpr size_t WS_GDEC = WS_GS + 64 * MiB;
constexpr size_t WS_XC = WS_GDEC + 1 * MiB;
constexpr size_t WS_BC = WS_XC + 32 * MiB;
constexpr size_t WS_CC = WS_BC + 16 * MiB;
constexpr size_t WS_SS = WS_CC + 16 * MiB;
constexpr size_t WS_DT = WS_SS + 32 * MiB;
constexpr size_t WS_ACS = WS_DT + 1 * MiB;
static_assert(WS_ACS + 1 * MiB <= WS_SCR + 200 * MiB, "mixer scratch");
constexpr size_t WS_WINT = WS_SCR + 200 * MiB;
constexpr size_t WS_WST = WS_WINT + 24 * MiB;
constexpr size_t WS_WOUTT = WS_WST + 1 * MiB;
#ifndef CONV_IN_P1
#define CONV_IN_P1 0
#endif
constexpr size_t WS_OWN64 = WS_WOUTT + 8 * MiB;
constexpr size_t WS_END = WS_OWN64 + 64 * MiB;
#if CONV_IN_P1
constexpr size_t WS_WGUT = WS_OWN64;
constexpr size_t WS_H2U = WS_PROJ;
#else
constexpr size_t WS_H2U = WS_OWN64;
constexpr size_t WS_WGUT = WS_PROJ;
#endif
constexpr size_t WS_WDT = WS_PROJ + 128 * MiB;

#include <hip/hip_cooperative_groups.h>
namespace cg = cooperative_groups;
#define LAS __attribute__((address_space(3)))
#define GAS __attribute__((address_space(1)))
typedef short bf16x8 __attribute__((ext_vector_type(8)));
typedef float f32x4 __attribute__((ext_vector_type(4)));
typedef float f32x2 __attribute__((ext_vector_type(2)));
typedef unsigned u32x4 __attribute__((ext_vector_type(4)));
typedef unsigned u32x2 __attribute__((ext_vector_type(2)));
#define LDS_WAIT() asm volatile("s_waitcnt lgkmcnt(0)" ::: "memory")
#define VM_WAIT() asm volatile("s_waitcnt vmcnt(0)" ::: "memory")
typedef __bf16 bf16x2_t __attribute__((ext_vector_type(2)));
__device__ __forceinline__ unsigned cvt_pk_bf16(float lo, float hi) { f32x2 f = {lo, hi}; bf16x2_t v = __builtin_convertvector(f, bf16x2_t); return __builtin_bit_cast(unsigned, v); }

__device__ __forceinline__ float bflo(unsigned u) { return __uint_as_float(u << 16); }
__device__ __forceinline__ float bfhi(unsigned u) { return __uint_as_float(u & 0xffff0000u); }

__device__ __forceinline__ void unpack8(u32x4 r, float (&f)[8]) { f[0] = bflo(r.x); f[1] = bfhi(r.x); f[2] = bflo(r.y); f[3] = bfhi(r.y); f[4] = bflo(r.z); f[5] = bfhi(r.z); f[6] = bflo(r.w); f[7] = bfhi(r.w); }

typedef int i32x4 __attribute__((ext_vector_type(4)));
typedef int i32x8 __attribute__((ext_vector_type(8)));
#ifndef MX8_PLAIN
#define MX8_PLAIN 0
#endif
__device__ __forceinline__ long pick64(i32x8 v, int q) { return (long)(((unsigned long long)(unsigned)v[2 * q + 1] << 32) | (unsigned)v[2 * q]); }
__device__ __forceinline__ i32x8 cat8(bf16x8 lo, bf16x8 hi) { return __builtin_shufflevector(__builtin_bit_cast(i32x4, lo), __builtin_bit_cast(i32x4, hi), 0, 1, 2, 3, 4, 5, 6, 7); }
__device__ __forceinline__ unsigned pk_fp8x4(float a, float b, float c, float d) {
    a = __builtin_amdgcn_fmed3f(a, -448.f, 448.f); b = __builtin_amdgcn_fmed3f(b, -448.f, 448.f); c = __builtin_amdgcn_fmed3f(c, -448.f, 448.f); d = __builtin_amdgcn_fmed3f(d, -448.f, 448.f);
    int w = __builtin_amdgcn_cvt_pk_fp8_f32(a, b, 0, false); w = __builtin_amdgcn_cvt_pk_fp8_f32(c, d, w, true); return (unsigned)w; }

#ifdef KLOOP_PROBE
#ifndef KUI
#define KUI 1
#endif
__device__ unsigned long long g_dbg[8];
#endif
#ifndef NCONT
#define NCONT 0
#endif
namespace pg8 {
constexpr int BM = 256, BK = 64, HALF = 128, HTB = HALF * BK * 2, STAGE_BYTES = 8 * HTB, NXCD = 8, WGM = 8;
__host__ __device__ __forceinline__ int lds_byte(int r, int c) { const int st = (r >> 4) * 2 + (c >> 5), rr = r & 15, cc = c & 31, ob = rr * 64 + cc * 2; return st * 1024 + (ob ^ (((ob >> 9) & 1) << 5)); }
__host__ __device__ __forceinline__ void stage_rc(int b, int& R, int& C) { const int st = b / 1024, sb = b % 1024, swz = sb ^ (((sb >> 9) & 1) << 5); R = (st >> 1) * 16 + swz / 64; C = (st & 1) * 32 + (swz % 64) / 2; }
__host__ __device__ __forceinline__ int perm32(int rho) { const int n = rho >> 4, i = rho & 15; return 8 * (i >> 2) + 4 * n + (i & 3); }

struct Unit { int pm, pn, e, row0, ne; };

struct StaticOrder {
    static constexpr bool GATHER = false; static constexpr int A_AUX = 0;
    const char* A; const char* Bt; size_t tstep;
    int nM, nN, nwg, G, c; int i0 = 0, imax = 1 << 30;
    __device__ void init(const bf16_t* A_, const bf16_t* Bt_, int M, int N, int K, int G_, int c_) { A = (const char*)A_; Bt = (const char*)Bt_; tstep = (size_t)BM * K * 2; nM = M / BM; nN = N / BM; nwg = nM * nN; G = G_; c = c_; }
    __device__ bool next(int i, Unit& u) const {
        if (i >= imax) return false;
        const long L = (long)(i + i0) * G + c; if (L >= nwg) return false;
        int wgid = (int)L; { const int q = nwg / NXCD, r = nwg % NXCD, xcd = wgid % NXCD, off = wgid / NXCD; wgid = (xcd < r ? xcd * (q + 1) : r * (q + 1) + (xcd - r) * q) + off; }
        const int nig = WGM * nN, gid = wgid / nig, fm = gid * WGM, gsz = (nM - fm) < WGM ? (nM - fm) : WGM;
        u.pm = fm + ((wgid % nig) % gsz); u.pn = (wgid % nig) / gsz; u.e = 0; u.row0 = 0; u.ne = 0; return true;
    }
    __device__ __forceinline__ const char* a_ptr(const Unit& u) const { return A + (size_t)u.pm * tstep; }
    __device__ __forceinline__ const char* b_ptr(const Unit& u) const { return Bt + (size_t)u.pn * tstep; }
    static constexpr bool META = false;
    __device__ __forceinline__ void meta(const Unit&, int, LAS unsigned char*, int, int) const {}
    __device__ __forceinline__ int a_row_lds(const Unit&, int, const LAS unsigned char*, int) const { return 0; }
    __device__ __forceinline__ int a_row(const Unit&, int) const { return 0; }
    __device__ __forceinline__ void a_ready(const Unit&) const {}
    __device__ __forceinline__ void done(const Unit&, int) const {}
};

__device__ __forceinline__ int lane_now() { unsigned m = ~0u; asm volatile("" : "+s"(m)); return (int)__builtin_amdgcn_mbcnt_hi(m, __builtin_amdgcn_mbcnt_lo(m, 0u)); }
constexpr int GN_OFF = 133120;
template <class Epi, class Sched, bool ALIGN_EPI = true, bool SP2 = true, bool MX8 = false, unsigned SC_W = 0x7F7F7F7Fu, unsigned SC_X = 0x7F7F7F7Fu>
__device__ __forceinline__ void gemm_phase(LAS unsigned char* lds, const int K, const Sched& S, Epi& E, const int wid_in) {
    int tid_ = wid_in * 64 + lane_now(); asm volatile("" : "+v"(tid_));
    const int tid = tid_, wid = __builtin_amdgcn_readfirstlane(tid >> 6), lane = tid & 63, wr = wid >> 2, wc = wid & 3, fr = lane & 15, fq = lane >> 4;
    const int nt = K / BK;
    unsigned voffA[2], voffB[2]; int RA[2];
#pragma unroll
    for (int i = 0; i < 2; ++i) { int R, C; stage_rc(tid * 16 + i * 8192, R, C); const int Rb = Epi::PERM ? ((NCONT ? (R >> 5) * 64 : (R & ~31)) + perm32(R & 31)) : R;
        voffA[i] = Sched::GATHER ? (unsigned)(C * 2) : (unsigned)(R * K + C) * 2u; voffB[i] = (unsigned)(Rb * K + C) * 2u; RA[i] = R; }
    const size_t kstep = (size_t)(BK * 2);
    const size_t hstep = (size_t)HALF * K * 2;
    const size_t hstepA = Sched::GATHER ? 0 : hstep;
    const size_t hstepB = (Epi::PERM && NCONT) ? (size_t)32 * K * 2 : hstep;
    const unsigned ldsw = (unsigned)wid * 1024u;
    const int aoff = lds_byte(wr * 64 + fr, fq * 8), boff = lds_byte(wc * 32 + fr, fq * 8);
#define PG8_SA(b, h) (((b) * 2 + (h)) * HTB)
#define PG8_SB(b, h) ((4 + (b) * 2 + (h)) * HTB)
#define PG8_STAGE_X(bufoff, gbase, voff, AUX) do { _Pragma("unroll") for (int _i = 0; _i < 2; ++_i) { unsigned _vo = (voff)[_i]; asm volatile("" : "+v"(_vo));     \
        __builtin_amdgcn_global_load_lds((const unsigned*)((const char*)(gbase) + _vo), (LAS unsigned*)(lds + (bufoff) + ldsw + _i * 8192), 16, 0, AUX); } } while (0)
#define PG8_STAGE(bufoff, gbase, voff) PG8_STAGE_X(bufoff, gbase, voff, 0)
#define PG8_STAGEA(bufoff, gbase, voff) PG8_STAGE_X(bufoff, gbase, voff, Sched::A_AUX)
#define PG8_LDA(dst, b, h) do { _Pragma("unroll") for (int m = 0; m < 4; ++m) { if constexpr (MX8) dst##8[m] = cat8(*(const LAS bf16x8*)(lds + PG8_SA(b, h) + aoff + m * 2048), *(const LAS bf16x8*)(lds + PG8_SA(b, h) + aoff + m * 2048 + 1024)); \
        else { _Pragma("unroll") for (int k = 0; k < 2; ++k) dst[m][k] = *(const LAS bf16x8*)(lds + PG8_SA(b, h) + aoff + m * 2048 + k * 1024); } } } while (0)
#define PG8_LDB(dst, b, h) do { _Pragma("unroll") for (int n = 0; n < 2; ++n) { if constexpr (MX8) dst##8[n] = cat8(*(const LAS bf16x8*)(lds + PG8_SB(b, h) + boff + n * 2048), *(const LAS bf16x8*)(lds + PG8_SB(b, h) + boff + n * 2048 + 1024)); \
        else { _Pragma("unroll") for (int k = 0; k < 2; ++k) dst[n][k] = *(const LAS bf16x8*)(lds + PG8_SB(b, h) + boff + n * 2048 + k * 1024); } } } while (0)
#define PG8_MMA(ai, bj, At, Bt) do { __builtin_amdgcn_s_setprio(1); _Pragma("unroll") for (int m = 0; m < 4; ++m) _Pragma("unroll") for (int n = 0; n < 2; ++n) { \
        if constexpr (MX8) { if (MX8_PLAIN) { _Pragma("unroll") for (int q_ = 0; q_ < 4; ++q_) acc[ai][bj][m][n] = __builtin_amdgcn_mfma_f32_16x16x32_fp8_fp8(pick64(Bt##8[n], q_), pick64(At##8[m], q_), acc[ai][bj][m][n], 0, 0, 0); } \
            else acc[ai][bj][m][n] = __builtin_amdgcn_mfma_scale_f32_16x16x128_f8f6f4(Bt##8[n], At##8[m], acc[ai][bj][m][n], 0, 0, 0, (int)SC_W, 0, (int)SC_X); } \
        else { _Pragma("unroll") for (int k = 0; k < 2; ++k) acc[ai][bj][m][n] = __builtin_amdgcn_mfma_f32_16x16x32_bf16(Bt[n][k], At[m][k], acc[ai][bj][m][n], 0, 0, 0); } } \
        __builtin_amdgcn_s_setprio(0); } while (0)
#define PG8_WAIT_V(n) asm volatile("s_waitcnt vmcnt(" #n ")" ::: "memory")
#define PG8_WAIT_L(n) asm volatile("s_waitcnt lgkmcnt(" #n ")" ::: "memory")
#define PG8_BAR __builtin_amdgcn_s_barrier()
#define PG8_SCHED __builtin_amdgcn_sched_barrier(0)
    Unit cur, nxt; int ui = 0;
    if (!S.next(0, cur)) return;
    f32x4 acc[2][2][4][2];
#pragma unroll
    for (int a = 0; a < 2; ++a)
#pragma unroll
        for (int b = 0; b < 2; ++b)
#pragma unroll
            for (int m = 0; m < 4; ++m)
#pragma unroll
                for (int n = 0; n < 2; ++n) acc[a][b][m][n] = (f32x4){0.f, 0.f, 0.f, 0.f};
    bf16x8 At[4][2], B0[2][2], B1[2][2]; i32x8 At8[4], B08[2], B18[2];
    const char* cA = S.a_ptr(cur); const char* cB = S.b_ptr(cur);
    S.a_ready(cur);
    int pc = 0;
    if constexpr (Sched::META) S.meta(cur, 0, lds, wid_in, lane_now());
    E.par = 0;
    { int t_p = wid_in * 64 + lane_now(); E.pre(cur, wr, t_p & 15); }
    unsigned gC0[2], gC1[2];
#pragma unroll
    for (int i = 0; i < 2; ++i) {
        if constexpr (Sched::GATHER) { int R, C; stage_rc(tid * 16 + i * 8192, R, C); gC0[i] = (unsigned)(C * 2) + (unsigned)S.a_row(cur, R) * (unsigned)(K * 2); gC1[i] = (unsigned)(C * 2) + (unsigned)S.a_row(cur, HALF + R) * (unsigned)(K * 2); }
        else { gC0[i] = voffA[i]; gC1[i] = voffA[i]; }
    }
    if constexpr (SP2) {
        PG8_STAGE(PG8_SB(0, 0), cB, voffB); PG8_STAGE(PG8_SB(0, 1), cB + hstepB, voffB); PG8_STAGEA(PG8_SA(0, 0), cA, gC0); PG8_STAGEA(PG8_SA(0, 1), cA + hstepA, gC1);
        if (wr == 1) PG8_BAR;
        PG8_WAIT_V(2); PG8_BAR;
        PG8_STAGE(PG8_SB(1, 0), cB + kstep, voffB); PG8_STAGEA(PG8_SA(1, 0), cA + kstep, gC0); PG8_STAGE(PG8_SB(1, 1), cB + hstepB + kstep, voffB);
        PG8_WAIT_V(6); PG8_BAR;
    } else {
        PG8_STAGE(PG8_SB(0, 0), cB, voffB); PG8_STAGEA(PG8_SA(0, 0), cA, gC0); PG8_STAGE(PG8_SB(0, 1), cB + hstepB, voffB); PG8_STAGEA(PG8_SA(0, 1), cA + hstepA, gC1);
        if (wr == 1) PG8_BAR;
        PG8_WAIT_V(4); PG8_BAR;
        PG8_STAGE(PG8_SB(1, 0), cB + kstep, voffB); PG8_STAGEA(PG8_SA(1, 0), cA + kstep, gC0); PG8_STAGE(PG8_SB(1, 1), cB + hstepB + kstep, voffB);
        PG8_WAIT_V(6); PG8_BAR;
    }
    for (;;) {
        const bool has_next = S.next(ui + 1, nxt);
        const char* nA = has_next ? S.a_ptr(nxt) : cA; const char* nB = has_next ? S.b_ptr(nxt) : cB;
        const int pn = pc == 2 ? 0 : pc + 1;
        if constexpr (Sched::META) { if (has_next) S.meta(nxt, pn, lds, wid_in, lane_now()); }
#ifdef KLOOP_PROBE
        constexpr bool PRB = KLOOP_WHICH == 7 ? (Sched::GATHER && MX8) : KLOOP_WHICH == 8 ? (!Sched::GATHER && MX8 && Sched::META) : (!Sched::META && sizeof(Epi) > 40);
        unsigned long long kp0 = 0, kc0 = 0; if (PRB) { kc0 = __builtin_amdgcn_s_memtime(); kp0 = __builtin_amdgcn_s_memrealtime(); if (blockIdx.x == 0 && wid_in == 0 && lane_now() == 0) { if (KLOOP_WHICH == 5) { if (ui == 0) g_dbg[2] = kp0 - g_dbg[3]; } else { if (ui == 2) g_dbg[2] = kp0 - g_dbg[3]; if (ui == 1) g_dbg[3] = kp0; } } }
#endif
#pragma unroll 1
        for (int t = 0; t < nt; t += 2) {
            const bool last = (t == nt - 2);
            const char* a1 = cA + (size_t)(t + 1) * kstep;
            const char* a2 = last ? nA : cA + (size_t)(t + 2) * kstep; const char* b2 = last ? nB : cB + (size_t)(t + 2) * kstep;
            const char* a3 = a2 + kstep; const char* b3 = b2 + kstep;
            if (last && has_next) S.a_ready(nxt);
            unsigned s0[2], s1[2];
#pragma unroll
            for (int i = 0; i < 2; ++i) { s0[i] = gC0[i]; s1[i] = gC1[i]; }
            if constexpr (SP2) {
            PG8_LDB(B0, 0, 0); PG8_LDB(B1, 0, 1); PG8_SCHED; PG8_LDA(At, 0, 0); PG8_STAGEA(PG8_SA(1, 1), a1 + hstepA, gC1);
            if constexpr (Sched::GATHER) { if (last && has_next) { const int t_g = wid_in * 64 + lane_now();
                _Pragma("unroll") for (int i = 0; i < 2; ++i) { int R, C; stage_rc(t_g * 16 + i * 8192, R, C); s0[i] = (unsigned)(C * 2) + (unsigned)S.a_row_lds(nxt, pn, lds, R) * (unsigned)(K * 2); s1[i] = (unsigned)(C * 2) + (unsigned)S.a_row_lds(nxt, pn, lds, HALF + R) * (unsigned)(K * 2); } } }
            PG8_WAIT_V(8); PG8_WAIT_L(0); PG8_BAR; PG8_MMA(0, 0, At, B0); PG8_MMA(0, 1, At, B1); PG8_BAR; PG8_SCHED;
            PG8_LDA(At, 0, 1); PG8_STAGE(PG8_SB(0, 0), b2, voffB); PG8_STAGE(PG8_SB(0, 1), b2 + hstepB, voffB); PG8_STAGEA(PG8_SA(0, 0), a2, s0);
            PG8_WAIT_V(8); PG8_WAIT_L(0); PG8_BAR; PG8_MMA(1, 0, At, B0); PG8_MMA(1, 1, At, B1); PG8_BAR; PG8_SCHED;
            PG8_LDB(B0, 1, 0); PG8_LDB(B1, 1, 1); PG8_SCHED; PG8_LDA(At, 1, 0); PG8_STAGEA(PG8_SA(0, 1), a2 + hstepA, s1);
            PG8_WAIT_V(8); PG8_WAIT_L(0); PG8_BAR; PG8_MMA(0, 0, At, B0); PG8_MMA(0, 1, At, B1); PG8_BAR; PG8_SCHED;
            PG8_LDA(At, 1, 1); PG8_STAGE(PG8_SB(1, 0), b3, voffB); PG8_STAGE(PG8_SB(1, 1), b3 + hstepB, voffB); PG8_STAGEA(PG8_SA(1, 0), a3, s0);
            PG8_WAIT_V(8); PG8_WAIT_L(0); PG8_BAR; PG8_MMA(1, 0, At, B0); PG8_MMA(1, 1, At, B1); PG8_BAR; PG8_SCHED;
            } else {
            PG8_LDB(B0, 0, 0); PG8_SCHED; PG8_LDA(At, 0, 0); PG8_STAGEA(PG8_SA(1, 1), a1 + hstepA, gC1);
            if constexpr (Sched::GATHER) { if (last && has_next) { const int t_g = wid_in * 64 + lane_now();
                _Pragma("unroll") for (int i = 0; i < 2; ++i) { int R, C; stage_rc(t_g * 16 + i * 8192, R, C); s0[i] = (unsigned)(C * 2) + (unsigned)S.a_row_lds(nxt, pn, lds, R) * (unsigned)(K * 2); s1[i] = (unsigned)(C * 2) + (unsigned)S.a_row_lds(nxt, pn, lds, HALF + R) * (unsigned)(K * 2); } } }
            PG8_WAIT_L(8); PG8_BAR; PG8_WAIT_L(0); PG8_MMA(0, 0, At, B0); PG8_BAR; PG8_SCHED;
            PG8_LDB(B1, 0, 1); PG8_STAGE(PG8_SB(0, 0), b2, voffB);
            PG8_BAR; PG8_WAIT_L(0); PG8_MMA(0, 1, At, B1); PG8_BAR;
            PG8_LDA(At, 0, 1); PG8_STAGEA(PG8_SA(0, 0), a2, s0);
            PG8_BAR; PG8_WAIT_L(0); PG8_MMA(1, 0, At, B0); PG8_BAR; PG8_SCHED;
            PG8_STAGE(PG8_SB(0, 1), b2 + hstepB, voffB);
            PG8_WAIT_V(6); PG8_BAR; PG8_MMA(1, 1, At, B1); PG8_BAR;
            PG8_LDB(B0, 1, 0); PG8_SCHED; PG8_LDA(At, 1, 0); PG8_STAGEA(PG8_SA(0, 1), a2 + hstepA, s1);
            PG8_WAIT_L(8); PG8_BAR; PG8_WAIT_L(0); PG8_MMA(0, 0, At, B0); PG8_BAR; PG8_SCHED;
            PG8_LDB(B1, 1, 1); PG8_STAGE(PG8_SB(1, 0), b3, voffB);
            PG8_BAR; PG8_WAIT_L(0); PG8_MMA(0, 1, At, B1); PG8_BAR;
            PG8_LDA(At, 1, 1); PG8_STAGEA(PG8_SA(1, 0), a3, s0);
            PG8_BAR; PG8_WAIT_L(0); PG8_MMA(1, 0, At, B0); PG8_BAR; PG8_SCHED;
            PG8_STAGE(PG8_SB(1, 1), b3 + hstepB, voffB);
            PG8_WAIT_V(6); PG8_BAR; PG8_MMA(1, 1, At, B1); PG8_BAR;
            }
        }
#ifdef KLOOP_PROBE
        if (PRB && ui == KUI && blockIdx.x == 0 && wid_in == 0 && lane_now() == 0) { g_dbg[6] = __builtin_amdgcn_s_memrealtime(); g_dbg[0] = __builtin_amdgcn_s_memrealtime() - kp0; g_dbg[4] = (__builtin_amdgcn_s_memtime() - kc0) / 20; }
#endif
        if constexpr (ALIGN_EPI) { if (wr == 0) PG8_BAR; }
        { int t_e = wid_in * 64 + lane_now(); const int fr_e = t_e & 15, fq_e = (t_e >> 4) & 3;
          E.par = pc; E(acc, cur, wr, wc, fr_e, fq_e); } S.done(cur, lane);
#ifdef KLOOP_PROBE
        if (PRB && ui == KUI && blockIdx.x == 0 && wid_in == 0 && lane_now() == 0) { asm volatile("s_waitcnt vmcnt(0)" ::: "memory"); g_dbg[5] = __builtin_amdgcn_s_memrealtime() - g_dbg[6]; }
#endif
        if (!has_next) break;
#pragma unroll
        for (int a = 0; a < 2; ++a)
#pragma unroll
            for (int b = 0; b < 2; ++b)
#pragma unroll
                for (int m = 0; m < 4; ++m)
#pragma unroll
                    for (int n = 0; n < 2; ++n) acc[a][b][m][n] = (f32x4){0.f, 0.f, 0.f, 0.f};
        cur = nxt; cA = nA; cB = nB; ++ui; pc = pn;
        { int t_p = wid_in * 64 + lane_now(); E.pre(cur, wr, t_p & 15); }
        if constexpr (Sched::GATHER) { const int t_g = wid_in * 64 + lane_now();
#pragma unroll
            for (int i = 0; i < 2; ++i) { int R, C; stage_rc(t_g * 16 + i * 8192, R, C); gC0[i] = (unsigned)(C * 2) + (unsigned)S.a_row_lds(cur, pc, lds, R) * (unsigned)(K * 2); gC1[i] = (unsigned)(C * 2) + (unsigned)S.a_row_lds(cur, pc, lds, HALF + R) * (unsigned)(K * 2); } }
        if constexpr (ALIGN_EPI) { if (wr == 1) PG8_BAR; }
    }
    PG8_WAIT_V(0);
    if constexpr (!ALIGN_EPI) { if (wr == 0) PG8_BAR; }
    PG8_BAR;
#undef PG8_SA
#undef PG8_SB
#undef PG8_STAGE
#undef PG8_STAGEA
#undef PG8_STAGE_X
#undef PG8_LDA
#undef PG8_LDB
#undef PG8_MMA
#undef PG8_WAIT_V
#undef PG8_WAIT_L
#undef PG8_BAR
#undef PG8_SCHED
}

struct EpiBf16 {
    static constexpr bool PERM = true;
    __device__ __forceinline__ void pre(const Unit&, int, int) const {}
    bf16_t* O; int ldc; int par = 0;
    __device__ __forceinline__ void operator()(const f32x4 (&acc)[2][2][4][2], const Unit& u, int wr, int wc, int fr, int fq) const {
        const int row0 = u.pm * BM + wr * 64 + fr, col0 = u.pn * BM + wc * (NCONT ? 64 : 32) + 8 * fq; constexpr int BJ = NCONT ? 32 : HALF;
#pragma unroll
        for (int ai = 0; ai < 2; ++ai)
#pragma unroll
            for (int m = 0; m < 4; ++m) { bf16_t* rowp = O + (size_t)(row0 + ai * HALF + m * 16) * ldc + col0;
#pragma unroll
                for (int bj = 0; bj < 2; ++bj) { const f32x4 v0 = acc[ai][bj][m][0], v1 = acc[ai][bj][m][1];
                    u32x4 w; w.x = cvt_pk_bf16(v0[0], v0[1]); w.y = cvt_pk_bf16(v0[2], v0[3]); w.z = cvt_pk_bf16(v1[0], v1[1]); w.w = cvt_pk_bf16(v1[2], v1[3]);
                    *(u32x4*)(rowp + bj * BJ) = w; } }
    }
};
struct EpiResF32 {
    static constexpr bool PERM = true;
    __device__ __forceinline__ void pre(const Unit&, int, int) const {}
    const float* base; float* C; int ldc; bf16_t* H; unsigned char* H8; int par = 0;
    __device__ __forceinline__ void operator()(const f32x4 (&acc)[2][2][4][2], const Unit& u, int wr, int wc, int fr, int fq) const {
        const int row0 = u.pm * BM + wr * 64 + fr, col0 = u.pn * BM + wc * (NCONT ? 64 : 32) + 8 * fq; constexpr int BJ = NCONT ? 32 : HALF;
#pragma unroll
        for (int ai = 0; ai < 2; ++ai) {
            f32x4 xv[4][2][2];
#pragma unroll
            for (int m = 0; m < 4; ++m) { const size_t off = (size_t)(row0 + ai * HALF + m * 16) * ldc + col0;
#pragma unroll
                for (int bj = 0; bj < 2; ++bj) { xv[m][bj][0] = __builtin_nontemporal_load((const f32x4*)(base + off + bj * BJ)); xv[m][bj][1] = __builtin_nontemporal_load((const f32x4*)(base + off + bj * BJ + 4)); } }
            __builtin_amdgcn_sched_barrier(0);
#pragma unroll
            for (int m = 0; m < 4; ++m) { const size_t off = (size_t)(row0 + ai * HALF + m * 16) * ldc + col0;
#pragma unroll
                for (int bj = 0; bj < 2; ++bj) {
                    const f32x4 v0 = xv[m][bj][0] + acc[ai][bj][m][0], v1 = xv[m][bj][1] + acc[ai][bj][m][1];
                    if (C) { *(f32x4*)(C + off + bj * BJ) = v0; *(f32x4*)(C + off + bj * BJ + 4) = v1; }
                    u32x4 h; h.x = cvt_pk_bf16(v0[0], v0[1]); h.y = cvt_pk_bf16(v0[2], v0[3]); h.z = cvt_pk_bf16(v1[0], v1[1]); h.w = cvt_pk_bf16(v1[2], v1[3]);
                    if (H) *(u32x4*)(H + off + bj * BJ) = h;
                    if (H8) { u32x2 q; q.x = pk_fp8x4(v0[0], v0[1], v0[2], v0[3]); q.y = pk_fp8x4(v1[0], v1[1], v1[2], v1[3]); *(u32x2*)(H8 + off + bj * BJ) = q; } } }
            __builtin_amdgcn_sched_barrier(0);
        }
    }
};
}
#define RLX_AGENT __ATOMIC_RELAXED, __HIP_MEMORY_SCOPE_AGENT
#define XB_TMO      128
#define XB_XCNT(j)  (256  + 64 * (j))
#define XB_XSUB(j)  (1280 + 64 * (j))
#define XB_XGEN(j)  (2304 + 64 * (j))
#define XB_TOP      3328
#define XB_TOPGEN   3392
#define XCD_BAR_WORDS 3456
#define XB_SPIN_CAP (1u << 18)

__device__ __forceinline__ unsigned xb_ld(unsigned* p)              { return __hip_atomic_load(p, __ATOMIC_RELAXED, __HIP_MEMORY_SCOPE_AGENT); }
__device__ __forceinline__ unsigned xb_add(unsigned* p, unsigned v) { return __hip_atomic_fetch_add(p, v, __ATOMIC_RELAXED, __HIP_MEMORY_SCOPE_AGENT); }
__device__ __forceinline__ unsigned xb_xcc_id() { return (unsigned)__builtin_amdgcn_s_getreg((3 << 11) | 20) & 0xFu; }
#define XB_SPIN(cond, bar) do { unsigned _sp = 0; while (cond) { __builtin_amdgcn_s_sleep(1); \
    if ((++_sp & 255u) == 0u) { if (xb_ld(&(bar)[XB_TMO])) break; if (_sp > XB_SPIN_CAP) { atomicAdd(&(bar)[XB_TMO], 1u); break; } } } } while (0)

struct XcdBarrier {
    unsigned* bar; unsigned x;
    volatile LAS unsigned* st;
};

__device__ __forceinline__ XcdBarrier xcd_barrier_post(unsigned* bar, volatile LAS unsigned* st) {
    XcdBarrier b; b.bar = bar; b.x = xb_xcc_id(); b.st = st;
    if (threadIdx.x == 0) (void)xb_add(&bar[XB_XCNT(b.x)], 1u);
    return b;
}
__device__ __forceinline__ void xcd_barrier_complete(unsigned* bar, unsigned x, unsigned& nloc, unsigned& nx) {
    const unsigned G = gridDim.x * gridDim.y * gridDim.z;
    unsigned sum, cnt, mine, sp = 0u;
    for (;;) {
        sum = 0u; cnt = 0u; mine = 0u;
#pragma unroll
        for (unsigned j = 0; j < 16; ++j) { const unsigned c = xb_ld(&bar[XB_XCNT(j)]); sum += c; cnt += (c > 0u) ? 1u : 0u; mine = (j == x) ? c : mine; }
        if (sum == G) break;
        __builtin_amdgcn_s_sleep(1);
        if ((++sp & 255u) == 0u) { if (xb_ld(&bar[XB_TMO])) break; if (sp > XB_SPIN_CAP) { atomicAdd(&bar[XB_TMO], 1u); break; } }
    }
    nloc = mine > 0u ? mine : 1u; nx = cnt > 0u ? cnt : 1u;
}

__device__ __forceinline__ void xcd_barrier(const XcdBarrier& b) {
    asm volatile("s_waitcnt vmcnt(0)" ::: "memory");
    __syncthreads();
    if (threadIdx.x == 0) {
        unsigned* bar = b.bar;
        __builtin_amdgcn_s_waitcnt(0);
        unsigned nloc = b.st[0], nx = b.st[1];
        if (nloc == 0u) { xcd_barrier_complete(bar, b.x, nloc, nx); b.st[0] = nloc; b.st[1] = nx; }
        const unsigned old = xb_add(&bar[XB_XSUB(b.x)], 1u);
        const unsigned gen = old / nloc;
        if (old + 1u == (gen + 1u) * nloc) {
            __builtin_amdgcn_fence(__ATOMIC_RELEASE, "agent");
            asm volatile("s_waitcnt vmcnt(0)" ::: "memory");
            const unsigned og = xb_add(&bar[XB_TOP], 1u);
            const unsigned tg = og / nx;
            if (og + 1u == (tg + 1u) * nx) xb_add(&bar[XB_TOPGEN], 1u);
            else XB_SPIN(xb_ld(&bar[XB_TOPGEN]) == tg, bar);
            __builtin_amdgcn_fence(__ATOMIC_ACQUIRE, "agent");
            xb_add(&bar[XB_XGEN(b.x)], 1u);
            asm volatile("s_waitcnt vmcnt(0)" ::: "memory");
        } else {
            XB_SPIN(xb_ld(&bar[XB_XGEN(b.x)]) == gen, bar);
            __builtin_amdgcn_fence(__ATOMIC_ACQUIRE, "agent");
            asm volatile("s_waitcnt vmcnt(0)" ::: "memory");
        }
    }
    __syncthreads();
}

constexpr int NWAVES = 8, NTHREADS = 512;
constexpr int LDS_BYTES = 147456;
constexpr int NPHASES = 10;

constexpr int LDS_TAB = 131072;

#define STAMP(i) do { if (TSEL >= 100 && blockIdx.x == 0 && pg8::lane_now() == 0) ((unsigned long long*)(a.ws + WS_CTL + 24576))[i] = __builtin_amdgcn_s_memrealtime(); } while (0)
#ifndef TSEL
#define TSEL -1
#endif
#ifndef MOE_FP8
#define MOE_FP8 1
#endif
#ifndef P1_FP8
#define P1_FP8 0
#endif
#ifndef P8_FP8
#define P8_FP8 1
#endif
#ifndef P5_FP8
#define P5_FP8 0
#endif
static_assert(!CONV_IN_P1 || MOE_FP8, "CONV_IN_P1 places the gate/up copy in a 64 MiB region: e4m3 only");
#ifndef MOE_FP8_DIRECT
#define MOE_FP8_DIRECT 1
#endif
#ifndef X1_BF16
#define X1_BF16 1
#endif
#ifndef GU_DEEP
#define GU_DEEP false
#endif
#ifndef P5_STAGGER
#define P5_STAGGER 1
#endif
#ifndef H2U_IN_ROUTER
#define H2U_IN_ROUTER 0
#endif
#ifndef P1_ALIGN
#define P1_ALIGN true
#endif
#ifndef P1_SP2
#define P1_SP2 true
#endif
#ifndef P7_SP2
#define P7_SP2 true
#endif
#ifndef P7_ALIGN
#define P7_ALIGN true
#endif
#ifndef P5_ALIGN
#define P5_ALIGN true
#endif
#ifndef P8_ALIGN
#define P8_ALIGN true
#endif
#ifndef P8_SP2
#define P8_SP2 true
#endif
#ifndef H8_IN_ROUTER
#define H8_IN_ROUTER 0
#endif
#ifndef ROUTER_DEEP
#define ROUTER_DEEP 0
#endif
#ifndef ROUTER_ROT
#define ROUTER_ROT 0
#endif
#ifndef TR_NT
#define TR_NT 1
#endif
#ifndef GU_SPLIT
#define GU_SPLIT 32768
#endif
#ifndef WD_STATIC
#ifndef MOE_MERGED
#define MOE_MERGED 0
#endif
#ifndef WD_STATIC
#define WD_STATIC (MOE_MERGED ? 16384 : 0)
#endif
#endif
struct MkArgs {
    const float* in[22]; float* out; unsigned char* ws; int ph_lo, ph_hi, flags, li;
};

__device__ __forceinline__ float wave_sum(float v) {
#pragma unroll
    for (int o = 1; o < 64; o <<= 1) v += __shfl_xor(v, o);
    return v;
}

struct TrItem { const float* W; int ldw, k0, colA, colB; bf16_t* WT; int Kdst, drow0; const float* kscale; float f8scale; };
__device__ __forceinline__ void tr_load(const TrItem& t, int lane, f32x4 (&v)[8]) {
    const int n4 = (lane & 7) * 4, kr = lane >> 3; const int sc = n4 < 16 ? t.colA + n4 : t.colB + n4 - 16;
#pragma unroll
    for (int i = 0; i < 8; ++i) v[i] = TR_NT ? __builtin_nontemporal_load((const f32x4*)(t.W + (size_t)(t.k0 + i * 8 + kr) * t.ldw + sc)) : *(const f32x4*)(t.W + (size_t)(t.k0 + i * 8 + kr) * t.ldw + sc);
}
__device__ __forceinline__ void tr_to_lds(LAS float* scr, int lane, const f32x4 (&v)[8]) {
    const int n4 = (lane & 7) * 4, kr = lane >> 3;
#pragma unroll
    for (int i = 0; i < 8; ++i) { LAS float* s = scr + (i * 8 + kr) * 33 + n4; s[0] = v[i][0]; s[1] = v[i][1]; s[2] = v[i][2]; s[3] = v[i][3]; }
}
struct TrKs { float ks[16]; int k0; };
__device__ __forceinline__ void tr_ks(const TrItem& t, int lane, TrKs& K) {
    if (t.f8scale == 0.f || t.k0 == K.k0) return;
    const int c = lane & 3; K.k0 = t.k0;
#pragma unroll
    for (int i = 0; i < 16; ++i) K.ks[i] = (t.kscale ? t.kscale[t.k0 + 16 * c + i] : 1.f) * t.f8scale;
}
__device__ __forceinline__ void tr_store(const TrItem& t, const LAS float* scr, int lane, const TrKs& K) {
    if (t.f8scale != 0.f) {
        const int c = lane & 3; unsigned char* W8 = (unsigned char*)t.WT;
        const float (&ks)[16] = K.ks;
#pragma unroll
        for (int jj = 0; jj < 2; ++jj) { const int n = (lane >> 2) + 16 * jj; const LAS float* s = scr + (16 * c) * 33 + n;
            u32x4 o; o.x = pk_fp8x4(s[0 * 33] * ks[0], s[1 * 33] * ks[1], s[2 * 33] * ks[2], s[3 * 33] * ks[3]); o.y = pk_fp8x4(s[4 * 33] * ks[4], s[5 * 33] * ks[5], s[6 * 33] * ks[6], s[7 * 33] * ks[7]);
            o.z = pk_fp8x4(s[8 * 33] * ks[8], s[9 * 33] * ks[9], s[10 * 33] * ks[10], s[11 * 33] * ks[11]); o.w = pk_fp8x4(s[12 * 33] * ks[12], s[13 * 33] * ks[13], s[14 * 33] * ks[14], s[15 * 33] * ks[15]);
            *(u32x4*)(W8 + (size_t)(t.drow0 + n) * t.Kdst + t.k0 + 16 * c) = o; }
        return; }
    const int c = lane & 7;
    f32x4 k0v = {1.f, 1.f, 1.f, 1.f}, k1v = {1.f, 1.f, 1.f, 1.f};
    if (t.kscale) { k0v = *(const f32x4*)(t.kscale + t.k0 + 8 * c); k1v = *(const f32x4*)(t.kscale + t.k0 + 8 * c + 4); }
#pragma unroll
    for (int jj = 0; jj < 4; ++jj) { const int n = (lane >> 3) + 8 * jj; const LAS float* s = scr + (8 * c) * 33 + n;
        u32x4 o; o.x = cvt_pk_bf16(s[0 * 33] * k0v[0], s[1 * 33] * k0v[1]); o.y = cvt_pk_bf16(s[2 * 33] * k0v[2], s[3 * 33] * k0v[3]); o.z = cvt_pk_bf16(s[4 * 33] * k1v[0], s[5 * 33] * k1v[1]); o.w = cvt_pk_bf16(s[6 * 33] * k1v[2], s[7 * 33] * k1v[3]);
        *(u32x4*)(t.WT + (size_t)(t.drow0 + n) * t.Kdst + t.k0 + 8 * c) = o; }
}
template <bool DEEP, class F>
__device__ __forceinline__ void tr_run(F item_of, int first, int end, int step, LAS float* scr, int lane) {
    if (first >= end) return;
    if constexpr (DEEP) {
        TrItem c0 = item_of(first), c1 = c0; f32x4 v0[8], v1[8]; TrKs K; K.k0 = -1;
        tr_ks(c0, lane, K);
        tr_load(c0, lane, v0);
        if (first + step < end) { c1 = item_of(first + step); tr_load(c1, lane, v1); }
        for (int it = first; it < end; it += 2 * step) {
            tr_to_lds(scr, lane, v0);
            LDS_WAIT();
            tr_ks(c0, lane, K);
            TrItem n0 = c0; if (it + 2 * step < end) { n0 = item_of(it + 2 * step); tr_load(n0, lane, v0); }
            tr_store(c0, scr, lane, K);
            LDS_WAIT();
            c0 = n0;
            if (it + step < end) {
                tr_to_lds(scr, lane, v1);
                LDS_WAIT();
                tr_ks(c1, lane, K);
                TrItem n1 = c1; if (it + 3 * step < end) { n1 = item_of(it + 3 * step); tr_load(n1, lane, v1); }
                tr_store(c1, scr, lane, K);
                LDS_WAIT();
                c1 = n1;
            }
        }
    } else {
        TrItem cur = item_of(first); f32x4 v[8]; TrKs K; K.k0 = -1;
        tr_ks(cur, lane, K);
        tr_load(cur, lane, v);
        for (int it = first; it < end; it += step) {
            tr_to_lds(scr, lane, v);
            LDS_WAIT();
            const int nx = it + step; TrItem nxt = cur;
            tr_ks(cur, lane, K);
            if (nx < end) { nxt = item_of(nx); tr_load(nxt, lane, v); }
            tr_store(cur, scr, lane, K);
            LDS_WAIT();
            cur = nxt;
        }
    }
}
__device__ __forceinline__ TrItem tr_item_p0(const MkArgs& a, int r) {
    unsigned char* ws = a.ws;
    constexpr int I_IN = 32 * 192, I_S = 32;
    if (r < I_IN) { const int kb = r / 192, nb = r % 192, n0 = nb * 32; const int sc = win_col(n0); return TrItem{a.in[2], IN_DIM, kb * 64, sc, sc + 16, (bf16_t*)(ws + WS_WINT), DM, n0, nullptr, P1_FP8 ? 64.f : 0.f}; } r -= I_IN;
    if (r < I_S) return TrItem{a.in[2], IN_DIM, r * 64, WI_GK, WI_DT, (bf16_t*)(ws + WS_WST), DM, 0, nullptr, 0.f}; r -= I_S;
    const int kb = r / 64, nb = r % 64; return TrItem{a.in[12], DM, kb * 64, nb * 32, nb * 32 + 16, (bf16_t*)(ws + WS_WOUTT), DM, nb * 32, nullptr, P5_FP8 ? 64.f : 0.f};
}
__device__ __forceinline__ TrItem tr_item_gu(const MkArgs& a, int r) {
    constexpr int I_G = 32 * 32 * 16;
    const int up = r >= I_G; if (up) r -= I_G; const int e = r / 512, q = r % 512, kb = q / 16, nb = q % 16, n0 = nb * 32;
    return TrItem{(up ? a.in[19] : a.in[18]) + (size_t)e * DM * DEXP, DEXP, kb * 64, n0, n0 + 16, (bf16_t*)(a.ws + WS_WGUT), DM, e * 1024 + (n0 >> 7) * 256 + (NCONT ? ((n0 & 127) >> 5) * 64 + up * 32 : up * 128 + (n0 & 127)), a.in[13], MOE_FP8 ? 64.f : 0.f};
}
__device__ __forceinline__ TrItem tr_item_d(const MkArgs& a, int r) {
    const int e = r / 512, q = r % 512, kb = q / 64, nb = q % 64, n0 = nb * 32;
    return TrItem{a.in[20] + (size_t)e * DEXP * DM, DM, kb * 64, n0, n0 + 16, (bf16_t*)(a.ws + WS_WDT), DEXP, e * DM + n0, nullptr, P8_FP8 ? 64.f : 0.f};
}

__device__ __forceinline__ void rms_row_to_bf16(const float* __restrict__ xrow, const float* __restrict__ w, bf16_t* __restrict__ orow, int lane) {
    const f32x4* xr = (const f32x4*)xrow + lane; const f32x4* wr = (const f32x4*)w + lane;
    f32x4 v[8]; float s = 0.f;
#pragma unroll
    for (int j = 0; j < 8; ++j) { v[j] = xr[64 * j]; s += (v[j].x * v[j].x + v[j].y * v[j].y) + (v[j].z * v[j].z + v[j].w * v[j].w); }
    const float r = rsqrtf(wave_sum(s) * (1.f / DM) + EPS);
    u32x2* o8 = (u32x2*)orow + lane;
#pragma unroll
    for (int j = 0; j < 8; ++j) { const f32x4 ww = wr[64 * j]; u32x2 o; o.x = cvt_pk_bf16(v[j].x * r * ww.x, v[j].y * r * ww.y); o.y = cvt_pk_bf16(v[j].z * r * ww.z, v[j].w * r * ww.w); o8[64 * j] = o; }
}

__device__ __forceinline__ void phase0(const MkArgs& a, LAS unsigned char* lds, int wave, int lane) {
    unsigned char* ws = a.ws;
    LAS float* scr = (LAS float*)(lds + wave * 16384);
    const int gw = blockIdx.x * NWAVES + wave, NGW = gridDim.x * NWAVES;
    constexpr int NITEMS = 32 * 192 + 32 + 32 * 64;
    tr_run<true>([&](int r) { return tr_item_p0(a, r); }, gw, NITEMS, NGW, scr, lane);
    {
        bf16_t* WrT = (bf16_t*)(ws + WS_WRT);
        for (int idx = gw * 64 + lane; idx < 48 * DM; idx += NGW * 64) { const int n = idx / DM, k = idx % DM;
            const float v = a.in[13][k] * (n < 4 ? a.in[14][k * 4 + n] : (n < 36 ? a.in[16][k * 32 + n - 4] : 0.f));
            const bf16_t hi = f2bf(v); WrT[idx] = hi; WrT[48 * DM + idx] = f2bf(v - bf2f(hi)); }
    }
    bf16_t* hA = (bf16_t*)(ws + WS_HA);
    {
        const f32x4* wr = (const f32x4*)a.in[1] + lane;
        f32x4 v[8], nv[8], wv[8];
#pragma unroll
        for (int j = 0; j < 8; ++j) wv[j] = wr[64 * j];
        if (gw < T_TOK) { const f32x4* xr = (const f32x4*)(a.in[0] + (size_t)gw * DM) + lane;
#pragma unroll
            for (int j = 0; j < 8; ++j) v[j] = __builtin_nontemporal_load(xr + 64 * j); }
        for (int m = gw; m < T_TOK; m += NGW) {
            const int mn = m + NGW;
            if (mn < T_TOK) { const f32x4* xr = (const f32x4*)(a.in[0] + (size_t)mn * DM) + lane;
#pragma unroll
                for (int j = 0; j < 8; ++j) nv[j] = __builtin_nontemporal_load(xr + 64 * j); }
            float s = 0.f;
#pragma unroll
            for (int j = 0; j < 8; ++j) s += (v[j].x * v[j].x + v[j].y * v[j].y) + (v[j].z * v[j].z + v[j].w * v[j].w);
            const float r = rsqrtf(wave_sum(s) * (1.f / DM) + EPS);
            u32x2* o8 = (u32x2*)(hA + (size_t)m * DM) + lane;
#pragma unroll
            for (int j = 0; j < 8; ++j) { const f32x4 ww = wv[j]; const float h0 = v[j].x * r * ww.x, h1 = v[j].y * r * ww.y, h2 = v[j].z * r * ww.z, h3 = v[j].w * r * ww.w;
                u32x2 o; o.x = cvt_pk_bf16(h0, h1); o.y = cvt_pk_bf16(h2, h3); o8[64 * j] = o;
                if (P1_FP8) ((unsigned*)(ws + WS_H8 + (size_t)m * DM))[lane + 64 * j] = pk_fp8x4(h0 * 16.f, h1 * 16.f, h2 * 16.f, h3 * 16.f); }
#pragma unroll
            for (int j = 0; j < 8; ++j) v[j] = nv[j];
        }
    }
}

__device__ __forceinline__ void skinny32_phase(const bf16_t* __restrict__ A, const bf16_t* __restrict__ BsT, float* __restrict__ out, LAS unsigned char* lds, int wave, int lane) {
    const int fr = lane & 15, fq = lane >> 4, tid = threadIdx.x;
    LAS f32x4* red = (LAS f32x4*)lds;
    for (int mt = blockIdx.x; mt < T_TOK / 64; mt += gridDim.x) {
        const bf16_t* ap = A + (size_t)(mt * 64 + fr) * DM + wave * 256 + fq * 8;
        const bf16_t* bp = BsT + (size_t)fr * DM + wave * 256 + fq * 8;
        f32x4 acc[4][2];
#pragma unroll
        for (int m = 0; m < 4; ++m) { acc[m][0] = (f32x4){0.f, 0.f, 0.f, 0.f}; acc[m][1] = (f32x4){0.f, 0.f, 0.f, 0.f}; }
        bf16x8 av[8][4], bv[8][2];
#pragma unroll
        for (int ks = 0; ks < 8; ++ks) {
#pragma unroll
            for (int m = 0; m < 4; ++m) av[ks][m] = *(const bf16x8*)(ap + (size_t)m * 16 * DM + ks * 32);
            bv[ks][0] = *(const bf16x8*)(bp + ks * 32); bv[ks][1] = *(const bf16x8*)(bp + (size_t)16 * DM + ks * 32); }
#pragma unroll
        for (int ks = 0; ks < 8; ++ks)
#pragma unroll
            for (int m = 0; m < 4; ++m) { acc[m][0] = __builtin_amdgcn_mfma_f32_16x16x32_bf16(av[ks][m], bv[ks][0], acc[m][0], 0, 0, 0); acc[m][1] = __builtin_amdgcn_mfma_f32_16x16x32_bf16(av[ks][m], bv[ks][1], acc[m][1], 0, 0, 0); }
#pragma unroll
        for (int m = 0; m < 4; ++m) { red[(wave * 8 + m * 2 + 0) * 64 + lane] = acc[m][0]; red[(wave * 8 + m * 2 + 1) * 64 + lane] = acc[m][1]; }
        __syncthreads();
        {
            const int slot = tid >> 6, ln = tid & 63, m = slot >> 1, n = slot & 1;
            f32x4 v = red[slot * 64 + ln];
#pragma unroll
            for (int w = 1; w < 8; ++w) v += red[(w * 8 + slot) * 64 + ln];
#pragma unroll
            for (int j = 0; j < 4; ++j) out[(size_t)(mt * 64 + m * 16 + 4 * (ln >> 4) + j) * 32 + n * 16 + (ln & 15)] = v[j];
        }
        __syncthreads();
    }
}

__device__ __forceinline__ void phase1(const MkArgs& a, LAS unsigned char* lds, int wave, int lane) {
    unsigned char* ws = a.ws;
    const bf16_t* hA = (const bf16_t*)(ws + WS_HA);
    STAMP(30);
    skinny32_phase(hA, (const bf16_t*)(ws + WS_WST), (float*)(ws + WS_SMALL), lds, wave, lane);
    STAMP(31);
    constexpr int K1 = P1_FP8 ? DM / 2 : DM;
    pg8::StaticOrder S; S.init(P1_FP8 ? (const bf16_t*)(ws + WS_H8) : hA, (const bf16_t*)(ws + WS_WINT), T_TOK, PJ, K1, gridDim.x, blockIdx.x);
    pg8::EpiBf16 E{(bf16_t*)(ws + WS_PROJ), PJ};
    pg8::gemm_phase<pg8::EpiBf16, pg8::StaticOrder, P1_ALIGN, P1_SP2, P1_FP8 != 0, 0x79797979u, 0x7B7B7B7Bu>(lds, K1, S, E, wave);
}

__device__ __forceinline__ void phase5(const MkArgs& a, LAS unsigned char* lds, float* x1, int wave, int i0 = 0, int imax = 1 << 30) {
    unsigned char* ws = a.ws;
    constexpr int K5 = P5_FP8 ? DM / 2 : DM;
#ifdef KLOOP_PROBE
    if (blockIdx.x == 0 && wave == 0 && pg8::lane_now() == 0) g_dbg[3] = __builtin_amdgcn_s_memrealtime();
#endif
    pg8::StaticOrder S; S.init((const bf16_t*)(ws + WS_HA), (const bf16_t*)(ws + WS_WOUTT), T_TOK, DM, K5, gridDim.x, blockIdx.x); S.i0 = i0; S.imax = imax;
    pg8::EpiResF32 E{a.in[0], X1_BF16 ? nullptr : x1, DM, H2U_IN_ROUTER ? nullptr : (bf16_t*)(ws + WS_H2U), (MOE_FP8 && !H8_IN_ROUTER) ? (unsigned char*)(ws + WS_H8) : nullptr};
    pg8::gemm_phase<pg8::EpiResF32, pg8::StaticOrder, P5_ALIGN, true, P5_FP8 != 0, 0x79797979u, 0x7B7B7B7Bu>(lds, K5, S, E, wave);
}


__device__ __forceinline__ void phase6(const MkArgs& a, LAS unsigned char* lds, const float* x1, int wave, int lane) {
    unsigned char* ws = a.ws;
    const int fr = lane & 15, fq = lane >> 4, tid = threadIdx.x;
    const bf16_t* WrT = (const bf16_t*)(ws + WS_WRT);
    float* rstd2 = (float*)(ws + WS_RSTD);
    int* cnt = (int*)(ws + WS_CTL); int* list = (int*)(ws + WS_LIST); float* rsl = (float*)(ws + WS_SMALL);
    int* tok_e = (int*)(ws + WS_TOKE); float* tok_w = (float*)(ws + WS_TOKW);
    LAS f32x4* red = (LAS f32x4*)lds;
    LAS float* redss = (LAS float*)(lds + 98304);
    LAS float* lg = (LAS float*)(lds + 100352);
    LAS float* ssum = (LAS float*)(lds + 112896);
    for (int mt = blockIdx.x; mt < T_TOK / 64; mt += gridDim.x) {
        const float* xp = x1 + (size_t)(mt * 64 + fr) * DM + wave * 256 + fq * 8;
        const bf16_t* bp = WrT + (size_t)fr * DM + wave * 256 + fq * 8;
        bf16_t* hp = (bf16_t*)(ws + WS_H2U) + (size_t)(mt * 64 + fr) * DM + wave * 256 + fq * 8;
        f32x4 acc[4][3];
#pragma unroll
        for (int m = 0; m < 4; ++m)
#pragma unroll
            for (int n = 0; n < 3; ++n) acc[m][n] = (f32x4){0.f, 0.f, 0.f, 0.f};
        float ss[4] = {0.f, 0.f, 0.f, 0.f};
#if X1_BF16
        const bf16_t* hx = (const bf16_t*)(ws + WS_H2U) + (size_t)(mt * 64 + fr) * DM + wave * 256 + fq * 8;
        const int rot = ROUTER_ROT ? ((blockIdx.x >> 3) & 7) : 0;
        unsigned char* h8p = ws + WS_H8 + (size_t)(mt * 64 + fr) * DM + wave * 256 + fq * 8;
        bf16x8 XA[4], XB[4]; bf16x8 BA[3][2], BB[3][2];
#if ROUTER_DEEP
        bf16x8 XC[4];
#endif
#define R_LOAD(ks_, X, B) do { const int kr_ = ((ks_) + rot) & 7;        \
            _Pragma("unroll") for (int m_ = 0; m_ < 4; ++m_) X[m_] = *(const bf16x8*)(hx + (size_t)m_ * 16 * DM + kr_ * 32); \
            _Pragma("unroll") for (int n_ = 0; n_ < 3; ++n_) { B[n_][0] = *(const bf16x8*)(bp + (size_t)n_ * 16 * DM + kr_ * 32); B[n_][1] = *(const bf16x8*)(bp + (size_t)(48 + n_ * 16) * DM + kr_ * 32); } } while (0)
#define R_COMP(KS_, X, B) do { _Pragma("unroll") for (int m_ = 0; m_ < 4; ++m_) { float f_[8]; unpack8(__builtin_bit_cast(u32x4, X[m_]), f_); \
            if (MOE_FP8 && H8_IN_ROUTER) { u32x2 q_; q_.x = pk_fp8x4(f_[0], f_[1], f_[2], f_[3]); q_.y = pk_fp8x4(f_[4], f_[5], f_[6], f_[7]); *(u32x2*)(h8p + (size_t)m_ * 16 * DM + (KS_) * 32) = q_; } \
            ss[m_] += (f_[0] * f_[0] + f_[1] * f_[1]) + (f_[2] * f_[2] + f_[3] * f_[3]) + (f_[4] * f_[4] + f_[5] * f_[5]) + (f_[6] * f_[6] + f_[7] * f_[7]); \
            _Pragma("unroll") for (int n_ = 0; n_ < 3; ++n_) { \
                acc[m_][n_] = __builtin_amdgcn_mfma_f32_16x16x32_bf16(X[m_], B[n_][0], acc[m_][n_], 0, 0, 0); \
                acc[m_][n_] = __builtin_amdgcn_mfma_f32_16x16x32_bf16(X[m_], B[n_][1], acc[m_][n_], 0, 0, 0); } } } while (0)
        (void)xp;
#else
        f32x4 XA[4][2], XB[4][2]; bf16x8 BA[3][2], BB[3][2];
#define R_LOAD(ks_, X, B) do { _Pragma("unroll") for (int m_ = 0; m_ < 4; ++m_) { \
            X[m_][0] = __builtin_nontemporal_load((const f32x4*)(xp + (size_t)m_ * 16 * DM + (ks_) * 32)); X[m_][1] = __builtin_nontemporal_load((const f32x4*)(xp + (size_t)m_ * 16 * DM + (ks_) * 32 + 4)); } \
            _Pragma("unroll") for (int n_ = 0; n_ < 3; ++n_) { B[n_][0] = *(const bf16x8*)(bp + (size_t)n_ * 16 * DM + (ks_) * 32); B[n_][1] = *(const bf16x8*)(bp + (size_t)(48 + n_ * 16) * DM + (ks_) * 32); } } while (0)
#define R_COMP(KS_, X, B) do { _Pragma("unroll") for (int m_ = 0; m_ < 4; ++m_) { const f32x4 xa = X[m_][0], xb = X[m_][1]; \
            ss[m_] += (xa.x * xa.x + xa.y * xa.y) + (xa.z * xa.z + xa.w * xa.w) + (xb.x * xb.x + xb.y * xb.y) + (xb.z * xb.z + xb.w * xb.w); \
            u32x4 hi; hi.x = cvt_pk_bf16(xa.x, xa.y); hi.y = cvt_pk_bf16(xa.z, xa.w); hi.z = cvt_pk_bf16(xb.x, xb.y); hi.w = cvt_pk_bf16(xb.z, xb.w); \
            if (H2U_IN_ROUTER) *(u32x4*)(hp + (size_t)m_ * 16 * DM + (KS_) * 32) = hi; \
            u32x4 lo; \
            lo.x = cvt_pk_bf16(xa.x - bflo(hi.x), xa.y - bfhi(hi.x)); lo.y = cvt_pk_bf16(xa.z - bflo(hi.y), xa.w - bfhi(hi.y)); \
            lo.z = cvt_pk_bf16(xb.x - bflo(hi.z), xb.y - bfhi(hi.z)); lo.w = cvt_pk_bf16(xb.z - bflo(hi.w), xb.w - bfhi(hi.w)); \
            const bf16x8 ah = __builtin_bit_cast(bf16x8, hi), al = __builtin_bit_cast(bf16x8, lo); \
            _Pragma("unroll") for (int n_ = 0; n_ < 3; ++n_) { \
                acc[m_][n_] = __builtin_amdgcn_mfma_f32_16x16x32_bf16(ah, B[n_][0], acc[m_][n_], 0, 0, 0); \
                acc[m_][n_] = __builtin_amdgcn_mfma_f32_16x16x32_bf16(al, B[n_][0], acc[m_][n_], 0, 0, 0); \
                acc[m_][n_] = __builtin_amdgcn_mfma_f32_16x16x32_bf16(ah, B[n_][1], acc[m_][n_], 0, 0, 0); } } } while (0)
#endif
        STAMP(0);
#if ROUTER_DEEP && X1_BF16
        const bf16x8* xq0 = (const bf16x8*)hx; const bf16x8* xq1 = (const bf16x8*)(hx + (size_t)16 * DM); const bf16x8* xq2 = (const bf16x8*)(hx + (size_t)32 * DM); const bf16x8* xq3 = (const bf16x8*)(hx + (size_t)48 * DM);
        const bf16x8* bq0 = (const bf16x8*)bp; const bf16x8* bq1 = (const bf16x8*)(bp + (size_t)48 * DM);
        asm volatile("" : "+v"(xq0), "+v"(xq1), "+v"(xq2), "+v"(xq3), "+v"(bq0), "+v"(bq1));
#define R_LX(ks_, X) do { X[0] = xq0[(ks_) * 4]; X[1] = xq1[(ks_) * 4]; X[2] = xq2[(ks_) * 4]; X[3] = xq3[(ks_) * 4]; } while (0)
#define R_LB(ks_, B) do { _Pragma("unroll") for (int n_ = 0; n_ < 3; ++n_) { B[n_][0] = bq0[(size_t)n_ * 2 * DM + (ks_) * 4]; B[n_][1] = bq1[(size_t)n_ * 2 * DM + (ks_) * 4]; } } while (0)
#define R_SB __builtin_amdgcn_sched_barrier(0)
        R_LX(0, XA); R_LB(0, BA); R_LX(1, XB); R_LB(1, BB); R_LX(2, XC); R_SB;
        R_COMP(0, XA, BA); R_LX(3, XA); R_LB(2, BA); R_SB;
        R_COMP(1, XB, BB); R_LX(4, XB); R_LB(3, BB); R_SB;
        R_COMP(2, XC, BA); R_LX(5, XC); R_LB(4, BA); R_SB;
        R_COMP(3, XA, BB); R_LX(6, XA); R_LB(5, BB); R_SB;
        R_COMP(4, XB, BA); R_LX(7, XB); R_LB(6, BA); R_SB;
        R_COMP(5, XC, BB); R_LB(7, BB); R_SB;
        R_COMP(6, XA, BA); R_COMP(7, XB, BB);
#undef R_LX
#undef R_LB
#undef R_SB
#else
        R_LOAD(0, XA, BA);
#pragma unroll 1
        for (int ks = 0; ks < 8; ks += 2) {
            R_LOAD(ks + 1, XB, BB);
            R_COMP(ks, XA, BA);
            if (ks + 2 < 8) R_LOAD(ks + 2, XA, BA);
            R_COMP(ks + 1, XB, BB);
        }
#endif
#undef R_LOAD
#undef R_COMP
        STAMP(1);
        const int lane_p = pg8::lane_now(), fr_p = lane_p & 15, fq_p = lane_p >> 4, tid_p = wave * 64 + lane_p;
#pragma unroll
        for (int m = 0; m < 4; ++m) { float s = ss[m]; s += __shfl_xor(s, 16); s += __shfl_xor(s, 32); if (fq_p == 0) redss[wave * 64 + m * 16 + fr_p] = s;
#pragma unroll
            for (int n = 0; n < 3; ++n) red[(wave * 12 + m * 3 + n) * 64 + lane_p] = acc[m][n]; }
        __syncthreads();
        for (int s = tid_p; s < 768; s += NTHREADS) { const int slot = s >> 6, ln = s & 63, m = slot / 3, n = slot % 3;
            f32x4 v = red[slot * 64 + ln];
#pragma unroll
            for (int w = 1; w < 8; ++w) v += red[(w * 12 + slot) * 64 + ln];
#pragma unroll
            for (int j = 0; j < 4; ++j) lg[(m * 16 + 4 * (ln >> 4) + j) * 49 + n * 16 + (ln & 15)] = v[j]; }
        if (tid_p < 64) { float s = 0.f;
#pragma unroll
            for (int w = 0; w < 8; ++w) s += redss[w * 64 + tid_p];
            ssum[tid_p] = s; }
        __syncthreads();
        STAMP(2);
        if (wave == 0) {
            const int t = mt * 64 + lane_p;
            const float r = rsqrtf(ssum[lane_p] * (1.f / DM) + EPS);
            rstd2[t] = r;
            const LAS float* l = lg + lane_p * 49;
            float gm = -1e30f; int gi = 0; float gl[4];
#pragma unroll
            for (int j = 0; j < 4; ++j) { gl[j] = l[j] * r + a.in[15][j]; if (gl[j] > gm) { gm = gl[j]; gi = j; } }
            float gs = 0.f;
#pragma unroll
            for (int j = 0; j < 4; ++j) gs += __expf(gl[j] - gm);
            const float gw_ = 1.f / gs;
            float m0 = -1e30f, m1 = -1e30f; int i0 = 0, i1 = 0;
            for (int j = 0; j < 8; ++j) { const float v = l[4 + gi * 8 + j] * r + a.in[17][gi * 8 + j];
                if (v > m0) { m1 = m0; i1 = i0; m0 = v; i0 = j; } else if (v > m1) { m1 = v; i1 = j; } }
            const float e1 = __expf(m1 - m0);
            const float w0 = gw_ / (1.f + e1), w1 = gw_ * e1 / (1.f + e1);
            const int ex0 = gi * 8 + i0, ex1 = gi * 8 + i1;
            tok_e[t * 2] = ex0; tok_e[t * 2 + 1] = ex1; tok_w[t * 2] = w0; tok_w[t * 2 + 1] = w1;
            LAS int* hist = (LAS int*)(lds + 113152);
            if (lane_p < 32) hist[lane_p] = 0;
            LDS_WAIT();
            const int p0 = atomicAdd((int*)(hist + ex0), 1);
            const int p1 = atomicAdd((int*)(hist + ex1), 1);
            LDS_WAIT();
            if (lane_p < 32) { const int hc = hist[lane_p]; if (hc > 0) hist[32 + lane_p] = atomicAdd(&cnt[lane_p * 64], hc); }
            LDS_WAIT();
            list[ex0 * T_TOK + hist[32 + ex0] + p0] = t * 2;
            list[ex1 * T_TOK + hist[32 + ex1] + p1] = t * 2 + 1;
            rsl[ex0 * T_TOK + hist[32 + ex0] + p0] = r; rsl[ex1 * T_TOK + hist[32 + ex1] + p1] = r;
        }
        STAMP(3);
        __syncthreads();
        STAMP(4);
    }
}
__device__ __forceinline__ void phase6b(const MkArgs& a, LAS unsigned char* lds, int wave, int lane, int lo = 0, int hi = 2 * 32 * 32 * 16, bool wd = true) {
    LAS float* scr = (LAS float*)(lds + 32768 + wave * 8704);
    const int gw = blockIdx.x * NWAVES + wave, NGW = gridDim.x * NWAVES;
    tr_run<GU_DEEP>([&](int r) { return tr_item_gu(a, r); }, lo + gw, hi, NGW, scr, lane);
    if (wd) tr_run<false>([&](int r) { return tr_item_d(a, r); }, gw, WD_STATIC, NGW, scr, lane);
#ifdef WARM_H2U
    {
        const u32x4* p = (const u32x4*)(a.ws + WS_H2U); u32x4 acc = {0u, 0u, 0u, 0u};
        for (size_t i = (size_t)gw * 64 + lane; i < (size_t)T_TOK * DM * 2 / 16; i += (size_t)NGW * 64 * 4) {
            const u32x4 v0 = p[i], v1 = (i + (size_t)NGW * 64 < (size_t)T_TOK * DM / 8) ? p[i + (size_t)NGW * 64] : acc, v2 = (i + (size_t)NGW * 128 < (size_t)T_TOK * DM / 8) ? p[i + (size_t)NGW * 128] : acc, v3 = (i + (size_t)NGW * 192 < (size_t)T_TOK * DM / 8) ? p[i + (size_t)NGW * 192] : acc;
            acc ^= v0 ^ v1 ^ v2 ^ v3; }
        asm volatile("" :: "v"(acc));
    }
#endif
}
__device__ __forceinline__ void wdt_queue(const MkArgs& a, LAS unsigned char* lds, int wave, int lane) {
    unsigned char* ws = a.ws;
    unsigned* wq = (unsigned*)(ws + WS_CTL + 16384);
    LAS float* scr = (LAS float*)(lds + wave * 8704);
    LAS unsigned* slot = (LAS unsigned*)(lds + 8 * 8704);
    constexpr int I_D = 32 * 8 * 64;
    for (;;) {
        if (threadIdx.x == 0) slot[0] = WD_STATIC + atomicAdd(wq, 64u);
        __syncthreads();
        const unsigned base = slot[0];
        __syncthreads();
        if (base >= (unsigned)I_D) break;
        tr_run<false>([&](int r) { return tr_item_d(a, r); }, (int)base + wave * 8, (int)base + wave * 8 + 8, 1, scr, lane);
    }
}

template <bool GATHER_T>
struct MoeOrderT {
    static constexpr bool GATHER = GATHER_T; static constexpr int A_AUX = (GATHER_T || !MOE_MERGED) ? 0 : 16;
    const char* A; const char* Bt; const int* list; const LAS int* tab; int NT, K, G, c, nwg; size_t bstride; const float* rsl;
    static constexpr bool META = true;
    __device__ __forceinline__ void meta(const pg8::Unit& u, int par, LAS unsigned char* lds, int wid, int lane) const {
        const int part = wid & 3; const size_t off = (size_t)u.e * T_TOK + u.row0 + part * 64 + lane;
        __builtin_amdgcn_global_load_lds((const unsigned*)(list + off), (LAS unsigned*)(lds + pg8::GN_OFF + par * 2048 + part * 256), 4, 0, 0);
        __builtin_amdgcn_global_load_lds((const unsigned*)(rsl + off), (LAS unsigned*)(lds + pg8::GN_OFF + par * 2048 + 1024 + part * 256), 4, 0, 0);
    }
    __device__ __forceinline__ int a_row_lds(const pg8::Unit& u, int par, const LAS unsigned char* lds, int r) const { const int ent = *(const LAS int*)(lds + pg8::GN_OFF + par * 2048 + r * 4); return u.row0 + r < u.ne ? (ent >> 1) : 0; }
    __device__ bool next(int i, pg8::Unit& u) const {
        int L;
        if (GATHER || i < dmin) L = i * G + c;
        else { if (c < n3) return false; L = dmin * G + (i - dmin) * (G - n3) + (c - n3); }
        if (L >= nwg) return false;
        int wgid = (int)L; { const int q = nwg / 8, r = nwg % 8, xcd = wgid % 8, off = wgid / 8; wgid = (xcd < r ? xcd * (q + 1) : r * (q + 1) + (xcd - r) * q) + off; }
        int e = 0;
#pragma unroll
        for (int step = 16; step >= 1; step >>= 1) { const int mid = e + step; if (__builtin_amdgcn_readfirstlane(tab[32 + mid]) * NT <= wgid) e = mid; }
        const int te = __builtin_amdgcn_readfirstlane(tab[33 + e] - tab[32 + e]), tp = __builtin_amdgcn_readfirstlane(tab[32 + e]);
        wgid -= tp * NT;
        const int pn = wgid / te, mt = wgid % te;
        u.pm = tp + mt; u.pn = pn; u.e = e; u.row0 = mt * 256; u.ne = __builtin_amdgcn_readfirstlane(tab[e]); return true;
    }
    __device__ __forceinline__ const char* a_ptr(const pg8::Unit& u) const { return GATHER ? A : A + (size_t)u.pm * 256 * K * 2; }
    __device__ __forceinline__ const char* b_ptr(const pg8::Unit& u) const { return Bt + (size_t)u.e * bstride + (size_t)u.pn * 256 * K * 2; }
    __device__ __forceinline__ int a_row(const pg8::Unit& u, int r) const { const int rr = u.row0 + r; return rr < u.ne ? (list[(size_t)u.e * T_TOK + rr] >> 1) : 0; }
    unsigned* ready; int n3, dmin;
    __device__ __forceinline__ void done(const pg8::Unit& u, int lane) const {
        if (GATHER && MOE_MERGED) { asm volatile("s_waitcnt vmcnt(0)" ::: "memory");
#ifdef HANDOFF_STRICT
            __builtin_amdgcn_fence(__ATOMIC_RELEASE, "agent"); asm volatile("s_waitcnt vmcnt(0)" ::: "memory");
#endif
            if (lane == 0) __hip_atomic_fetch_add(ready + 64 * u.pm, 1u, __ATOMIC_RELAXED, __HIP_MEMORY_SCOPE_AGENT); }
    }
    __device__ __forceinline__ void a_ready(const pg8::Unit& u) const {
        if (!GATHER && MOE_MERGED) {
            if (threadIdx.x < 64) {
                const unsigned long long t0 = __builtin_amdgcn_s_memrealtime();
                while ((unsigned)__builtin_amdgcn_readfirstlane(__hip_atomic_load(ready + 64 * u.pm, __ATOMIC_RELAXED, __HIP_MEMORY_SCOPE_AGENT)) < 32u) {
                    if (__builtin_amdgcn_s_memrealtime() - t0 > 2000000ull) break;
                    __builtin_amdgcn_s_sleep(2); }
            }
            asm volatile("" ::: "memory"); __builtin_amdgcn_s_barrier(); asm volatile("" ::: "memory");
#ifdef HANDOFF_STRICT
            __builtin_amdgcn_fence(__ATOMIC_ACQUIRE, "agent"); asm volatile("s_waitcnt vmcnt(0)" ::: "memory");
#endif
        }
    }
};
__device__ __forceinline__ int moe_tables(const int* cnt, LAS int* tab) {
    if (threadIdx.x < 32) tab[threadIdx.x] = __hip_atomic_load(cnt + threadIdx.x * 64, __ATOMIC_RELAXED, __HIP_MEMORY_SCOPE_AGENT);
    __syncthreads();
    if (threadIdx.x == 0) { int p = 0; for (int e = 0; e < 32; ++e) { tab[32 + e] = p; p += (tab[e] + 255) >> 8; } tab[64] = p; }
    __syncthreads();
    return __builtin_amdgcn_readfirstlane(tab[64]);
}
struct EpiSwiGLU {
    static constexpr bool PERM = true;
    __device__ __forceinline__ void pre(const pg8::Unit&, int, int) const {}
    bf16_t* H; const LAS unsigned char* lds; int par = 0;
    __device__ __forceinline__ void operator()(const f32x4 (&acc)[2][2][4][2], const pg8::Unit& u, int wr, int wc, int fr, int fq) const {
#pragma unroll
        for (int ai = 0; ai < 2; ++ai)
#pragma unroll
            for (int m = 0; m < 4; ++m) { const int rt = ai * 128 + wr * 64 + m * 16 + fr; const int rr = u.row0 + rt;
                const float rs = rr < u.ne ? *(const LAS float*)(lds + pg8::GN_OFF + par * 2048 + 1024 + rt * 4) * (MOE_FP8 ? (1.f / 64.f) : 1.f) : 0.f;
                const f32x4 g0 = acc[ai][0][m][0] * rs, g1 = acc[ai][0][m][1] * rs, u0 = acc[ai][1][m][0] * rs, u1 = acc[ai][1][m][1] * rs;
                float h[8];
#pragma unroll
                for (int j = 0; j < 4; ++j) { h[j] = g0[j] * __builtin_amdgcn_rcpf(1.f + __builtin_amdgcn_exp2f(g0[j] * -1.44269504f)) * u0[j]; h[4 + j] = g1[j] * __builtin_amdgcn_rcpf(1.f + __builtin_amdgcn_exp2f(g1[j] * -1.44269504f)) * u1[j]; }
                u32x4 w; w.x = cvt_pk_bf16(h[0], h[1]); w.y = cvt_pk_bf16(h[2], h[3]); w.z = cvt_pk_bf16(h[4], h[5]); w.w = cvt_pk_bf16(h[6], h[7]);
                if (P8_FP8) { u32x2 w8; w8.x = pk_fp8x4(h[0] * 8.f, h[1] * 8.f, h[2] * 8.f, h[3] * 8.f); w8.y = pk_fp8x4(h[4] * 8.f, h[5] * 8.f, h[6] * 8.f, h[7] * 8.f);
                    unsigned long long* h8p = (unsigned long long*)((unsigned char*)H + (size_t)(u.pm * 256 + rt) * DEXP + u.pn * 128 + wc * 32 + 8 * fq);
                    if (MOE_MERGED) __hip_atomic_store(h8p, ((unsigned long long)w8.y << 32) | w8.x, __ATOMIC_RELAXED, __HIP_MEMORY_SCOPE_AGENT);
                    else *(u32x2*)h8p = w8; } else {
                unsigned long long* hp = (unsigned long long*)(H + (size_t)(u.pm * 256 + rt) * DEXP + u.pn * 128 + wc * 32 + 8 * fq);
                if (MOE_MERGED) {
                    __hip_atomic_store(hp, ((unsigned long long)w.y << 32) | w.x, __ATOMIC_RELAXED, __HIP_MEMORY_SCOPE_AGENT);
                    __hip_atomic_store(hp + 1, ((unsigned long long)w.w << 32) | w.z, __ATOMIC_RELAXED, __HIP_MEMORY_SCOPE_AGENT);
                } else *(u32x4*)hp = w; } }
    }
};
struct EpiDown {
    static constexpr bool PERM = true;
    bf16_t* Y; const LAS unsigned char* lds; int par = 0;
    __device__ __forceinline__ void pre(const pg8::Unit&, int, int) const {}
    __device__ __forceinline__ void operator()(const f32x4 (&acc)[2][2][4][2], const pg8::Unit& u, int wr, int wc, int fr, int fq) const {
#pragma unroll
        for (int ai = 0; ai < 2; ++ai)
#pragma unroll
            for (int m = 0; m < 4; ++m) { const int rt = ai * 128 + wr * 64 + m * 16 + fr; const int slot = *(const LAS int*)(lds + pg8::GN_OFF + par * 2048 + rt * 4);
                if (u.row0 + rt < u.ne) { bf16_t* rowp = Y + (size_t)slot * DM + u.pn * 256 + wc * (NCONT ? 64 : 32) + 8 * fq;
#pragma unroll
                    for (int bj = 0; bj < 2; ++bj) { const f32x4 v0 = acc[ai][bj][m][0], v1 = acc[ai][bj][m][1];
                        u32x4 w; w.x = cvt_pk_bf16(v0[0], v0[1]); w.y = cvt_pk_bf16(v0[2], v0[3]); w.z = cvt_pk_bf16(v1[0], v1[1]); w.w = cvt_pk_bf16(v1[2], v1[3]);
                        *(u32x4*)(rowp + bj * (NCONT ? 32 : 128)) = w; } } }
    }
};
__device__ __forceinline__ void moe_gather_fp8(const MkArgs& a, const LAS int* tab, int tiles, int wave, int lane) {
    const unsigned char* H8 = (const unsigned char*)(a.ws + WS_H8); unsigned char* A8s = (unsigned char*)(a.ws + WS_A8S);
    const int* list = (const int*)(a.ws + WS_LIST);
    const int gw = blockIdx.x * NWAVES + wave, NGW = gridDim.x * NWAVES, nrows = tiles * 256;
    for (int r0 = gw; r0 < nrows; r0 += 4 * NGW) {
        u32x4 v[4][2]; int ok[4];
#pragma unroll
        for (int q = 0; q < 4; ++q) { const int r = r0 + q * NGW; ok[q] = 0; v[q][0] = (u32x4){0u, 0u, 0u, 0u}; v[q][1] = (u32x4){0u, 0u, 0u, 0u};
            if (r < nrows) { const int t8 = r >> 8; int e = 0;
                for (; e < 31; ++e) if (t8 < __builtin_amdgcn_readfirstlane(tab[33 + e])) break;
                const int p = r - __builtin_amdgcn_readfirstlane(tab[32 + e]) * 256; ok[q] = 1;
                if (p < __builtin_amdgcn_readfirstlane(tab[e])) { const int tok = list[(size_t)e * T_TOK + p] >> 1; const u32x4* s = (const u32x4*)(H8 + (size_t)tok * DM) + lane; v[q][0] = s[0]; v[q][1] = s[64]; } } }
#pragma unroll
        for (int q = 0; q < 4; ++q) if (ok[q]) { u32x4* d = (u32x4*)(A8s + (size_t)(r0 + q * NGW) * DM) + lane; d[0] = v[q][0]; d[64] = v[q][1]; }
    }
}
template <class BAR, class BAR0>
__device__ __forceinline__ void phase78(const MkArgs& a, LAS unsigned char* lds, BAR midbar, BAR0 prebar, int wave, int lane) {
    unsigned char* ws = a.ws;
    LAS int* tab = (LAS int*)(lds + LDS_TAB);
    STAMP(60);
    const int tiles = moe_tables((const int*)(ws + WS_CTL), tab);
    unsigned* ready = (unsigned*)(ws + WS_CTL + 131072);
    const int G = gridDim.x, c = blockIdx.x, U = tiles * 4, Dn = tiles * 8;
    if (MOE_FP8 && !MOE_FP8_DIRECT) { moe_gather_fp8(a, tab, tiles, wave, lane); prebar(); }
    {
        constexpr int KU = MOE_FP8 ? DM / 2 : DM;
        constexpr bool UPG = MOE_FP8 == 0 || MOE_FP8_DIRECT != 0;
        MoeOrderT<UPG> S; S.A = MOE_FP8 ? (const char*)(ws + (MOE_FP8_DIRECT ? WS_H8 : WS_A8S)) : (const char*)(ws + WS_H2U); S.Bt = (const char*)(ws + WS_WGUT); S.list = (const int*)(ws + WS_LIST); S.tab = tab; S.NT = 4; S.K = KU; S.G = G; S.c = c; S.nwg = U; S.bstride = (size_t)1024 * KU * 2;
        S.ready = ready; S.n3 = 0; S.dmin = 0; S.rsl = (const float*)(ws + WS_SMALL);
        if (!MOE_MERGED) {
            const int rounds = (U + G - 1) / G, gup = rounds > 0 ? (U + rounds - 1) / rounds : G;
            S.G = gup; if (c >= gup) S.nwg = 0; }
        EpiSwiGLU E{(bf16_t*)(ws + WS_HMID), lds};
        pg8::gemm_phase<EpiSwiGLU, MoeOrderT<UPG>, P7_ALIGN, P7_SP2, MOE_FP8 != 0>(lds, KU, S, E, wave);
    }
    STAMP(61);
    midbar();
    STAMP(62);
    {
        constexpr int KD = P8_FP8 ? DEXP / 2 : DEXP;
        int n3 = U % G; int x = (Dn + 2 * n3) / G; int dmin = x - 2; if (dmin < 0) dmin = 0;
        if (!MOE_MERGED) { n3 = 0; dmin = 1 << 20; }
        MoeOrderT<false> S; S.A = (const char*)(ws + WS_HMID); S.Bt = (const char*)(ws + WS_WDT); S.list = (const int*)(ws + WS_LIST); S.tab = tab; S.NT = 8; S.K = KD; S.G = G; S.c = c; S.nwg = Dn; S.bstride = (size_t)DM * KD * 2;
        S.ready = ready; S.n3 = n3; S.dmin = dmin; S.rsl = (const float*)(ws + WS_SMALL);
        EpiDown E{(bf16_t*)(ws + WS_Y), lds};
        pg8::gemm_phase<EpiDown, MoeOrderT<false>, P8_ALIGN, P8_SP2, P8_FP8 != 0, 0x79797979u, 0x7C7C7C7Cu>(lds, KD, S, E, wave);
    }
}
__device__ __forceinline__ void phase9(const MkArgs& a, int wave, int lane) {
    unsigned char* ws = a.ws;
    const bf16_t* Y = (const bf16_t*)(ws + WS_Y); const float* tok_w = (const float*)(ws + WS_TOKW);
    const int gw = blockIdx.x * NWAVES + wave, NGW = gridDim.x * NWAVES;
    const f32x4* wf = (const f32x4*)a.in[21] + lane;
    f32x4 v[8], nv[8]; u32x2 p[8], q[8], np[8], nq[8]; float w0 = 0.f, w1 = 0.f, nw0 = 0.f, nw1 = 0.f;
#define P9_LOAD(T, V, P, Q, W0, W1) do { W0 = tok_w[(T) * 2]; W1 = tok_w[(T) * 2 + 1]; const f32x4* xr_ = (const f32x4*)(a.out + (size_t)(T) * DM) + lane; const u32x2* hx_ = (const u32x2*)((const bf16_t*)(ws + WS_H2U) + (size_t)(T) * DM) + lane; \
        const u32x2* y0_ = (const u32x2*)(Y + (size_t)((T) * 2) * DM) + lane; const u32x2* y1_ = (const u32x2*)(Y + (size_t)((T) * 2 + 1) * DM) + lane; \
        _Pragma("unroll") for (int j = 0; j < 8; ++j) { V[j] = X1_BF16 ? (f32x4){bflo(hx_[64 * j].x), bfhi(hx_[64 * j].x), bflo(hx_[64 * j].y), bfhi(hx_[64 * j].y)} : xr_[64 * j]; P[j] = __builtin_nontemporal_load(y0_ + 64 * j); Q[j] = __builtin_nontemporal_load(y1_ + 64 * j); } } while (0)
    f32x4 wfr[8];
#pragma unroll
    for (int j = 0; j < 8; ++j) wfr[j] = wf[64 * j];
    if (gw < T_TOK) P9_LOAD(gw, v, p, q, w0, w1);
    for (int t = gw; t < T_TOK; t += NGW) {
        const int tn = t + NGW;
        if (tn < T_TOK) P9_LOAD(tn, nv, np, nq, nw0, nw1);
        float s = 0.f;
#pragma unroll
        for (int j = 0; j < 8; ++j) {
            v[j].x += w0 * bflo(p[j].x) + w1 * bflo(q[j].x); v[j].y += w0 * bfhi(p[j].x) + w1 * bfhi(q[j].x);
            v[j].z += w0 * bflo(p[j].y) + w1 * bflo(q[j].y); v[j].w += w0 * bfhi(p[j].y) + w1 * bfhi(q[j].y);
            s += (v[j].x * v[j].x + v[j].y * v[j].y) + (v[j].z * v[j].z + v[j].w * v[j].w); }
        const float r = rsqrtf(wave_sum(s) * (1.f / DM) + EPS);
        f32x4* xo = (f32x4*)(a.out + (size_t)t * DM) + lane;
#pragma unroll
        for (int j = 0; j < 8; ++j) { const f32x4 ww = wfr[j]; xo[64 * j] = (f32x4){v[j].x * r * ww.x, v[j].y * r * ww.y, v[j].z * r * ww.z, v[j].w * r * ww.w}; }
#pragma unroll
        for (int j = 0; j < 8; ++j) { v[j] = nv[j]; p[j] = np[j]; q[j] = nq[j]; }
        w0 = nw0; w1 = nw1;
    }
#undef P9_LOAD
}

__device__ __forceinline__ bf16x8 ldfrag(const LAS bf16_t* base, int stride, int r0, int k0, int fr, int fq) {
    return *(const LAS bf16x8*)(base + (r0 + fr) * stride + k0 + fq * 8);
}
#define MFMA16(X, Y, C) __builtin_amdgcn_mfma_f32_16x16x32_bf16((X), (Y), (C), 0, 0, 0)
__device__ __forceinline__ u32x2 pack4(f32x4 v) { u32x2 o; o.x = cvt_pk_bf16(v[0], v[1]); o.y = cvt_pk_bf16(v[2], v[3]); return o; }

template <class SC>
__device__ __forceinline__ void load_transposed(const bf16_t* __restrict__ src, size_t ld, int ntp, int ncol8, LAS unsigned* dst32, int dstride32, int tid, SC scale) {
    for (int u = tid; u < ntp * ncol8; u += NTHREADS) {
        const int tp = u % ntp, cg = u / ntp;
        const bf16_t* p = src + (size_t)(2 * tp) * ld + cg * 8;
        const u32x4 r0 = *(const u32x4*)p, r1 = *(const u32x4*)(p + ld);
        const float s0 = scale(2 * tp, cg), s1 = scale(2 * tp + 1, cg);
#pragma unroll
        for (int i = 0; i < 4; ++i) {
            dst32[(cg * 8 + 2 * i) * dstride32 + tp] = cvt_pk_bf16(bflo(r0[i]) * s0, bflo(r1[i]) * s1);
            dst32[(cg * 8 + 2 * i + 1) * dstride32 + tp] = cvt_pk_bf16(bfhi(r0[i]) * s0, bfhi(r1[i]) * s1);
        }
    }
}
struct NoScale { __device__ __forceinline__ float operator()(int, int) const { return 1.f; } };


typedef short s16x4 __attribute__((ext_vector_type(4)));
__device__ __forceinline__ bf16x8 ldfrag_tr(const LAS bf16_t* T, int stride, int k0, int c0, int lane) {
    const int idx = lane & 15, q = idx >> 2, p = idx & 3, fq = lane >> 4;
    const LAS bf16_t* ptr = T + (k0 + 8 * fq + q) * stride + c0 + 4 * p;
    const s16x4 lo = __builtin_amdgcn_ds_read_tr16_b64_v4i16((LAS s16x4*)ptr), hi = __builtin_amdgcn_ds_read_tr16_b64_v4i16((LAS s16x4*)(ptr + 4 * stride));
    return (bf16x8){lo[0], lo[1], lo[2], lo[3], hi[0], hi[1], hi[2], hi[3]};
}
__device__ __forceinline__ float fast_logsigmoid(float g) { return fminf(g, 0.f) - __logf(1.f + __expf(-fabsf(g))); }
__device__ __forceinline__ float fast_silu(float v) { return v * __builtin_amdgcn_rcpf(1.f + __expf(-v)); }
__device__ __forceinline__ u32x4 pack8(const float (&f)[8]) { u32x4 w; w.x = cvt_pk_bf16(f[0], f[1]); w.y = cvt_pk_bf16(f[2], f[3]); w.z = cvt_pk_bf16(f[4], f[5]); w.w = cvt_pk_bf16(f[6], f[7]); return w; }

#define GLA2_TILES(IT, GK, VV, QV, KV) do { const int c_ = (IT) & 63, bh_ = (IT) >> 6, h_ = bh_ & 3, b_ = bh_ >> 2; const size_t t0_ = (size_t)b_ * SEQ + c_ * 64; \
        _Pragma("unroll") for (int i = 0; i < 2; ++i) { const int u = tid + i * NTHREADS; GK[i] = small[(t0_ + (u >> 4)) * 32 + (u & 15)]; } \
        _Pragma("unroll") for (int i = 0; i < 4; ++i) { const int u = tid + i * NTHREADS, t = u >> 5, c8 = u & 31; VV[i] = *(const u32x4*)(proj + (t0_ + t) * PJ + PV + h_ * 256 + c8 * 8); } \
        _Pragma("unroll") for (int i = 0; i < 2; ++i) { const int u = tid + i * NTHREADS, t = u >> 4, d8 = u & 15; \
            QV[i] = *(const u32x4*)(proj + (t0_ + t) * PJ + PQ + h_ * 128 + d8 * 8); KV[i] = *(const u32x4*)(proj + (t0_ + t) * PJ + PK + h_ * 128 + d8 * 8); } } while (0)
__device__ __forceinline__ void gla_p2_loop(const MkArgs& a, LAS unsigned char* lds, int first, int end, int step, int tid, int wave, int lane) {
    unsigned char* ws = a.ws;
    const bf16_t* proj = (const bf16_t*)(ws + WS_PROJ); const float* small = (const float*)(ws + WS_SMALL);
    float gkv[2], ngk[2]; u32x4 vv[4], qv[2], kv[2], nvv[4], nqv[2], nkv[2];
    if (first < end) GLA2_TILES(first, gkv, vv, qv, kv);
    const int fr = lane & 15, fq = lane >> 4;
    bf16x8 wb1, wb2; float gbias; int hcur = -1;
    for (int item = first; item < end; item += step) {
    const int c = item & 63, bh = item >> 6, h = bh & 3, b = bh >> 2;
    const size_t t0 = (size_t)b * SEQ + c * 64;
    if (h != hcur) { hcur = h; float w8[8], hi8[8], lo8[8];
#pragma unroll
        for (int jx = 0; jx < 8; ++jx) { w8[jx] = a.in[3][(8 * (fq & 1) + jx) * 512 + h * 128 + wave * 16 + fr]; hi8[jx] = bf2f(f2bf(w8[jx])); lo8[jx] = fq < 2 ? w8[jx] - hi8[jx] : 0.f; }
        wb1 = __builtin_bit_cast(bf16x8, pack8(hi8)); wb2 = __builtin_bit_cast(bf16x8, pack8(lo8)); gbias = a.in[4][h * 128 + wave * 16 + fr]; }
    bf16_t* QT = (bf16_t*)(ws + WS_QT); bf16_t* KT = (bf16_t*)(ws + WS_KT); bf16_t* GS = (bf16_t*)(ws + WS_GS); float* GDEC = (float*)(ws + WS_GDEC);
    LAS bf16_t* vS = (LAS bf16_t*)(lds);
    LAS bf16_t* kd = (LAS bf16_t*)(lds + 33792);
    LAS float* Gs = (LAS float*)(lds + 51200);
    LAS float* gk = (LAS float*)(lds + 84992);
    LAS float* part = (LAS float*)(lds + 89088);
    LAS float* tot = (LAS float*)(lds + 91136);
#pragma unroll
    for (int i = 0; i < 2; ++i) gk[tid + i * NTHREADS] = gkv[i];
#pragma unroll
    for (int i = 0; i < 4; ++i) { const int u = tid + i * NTHREADS, t = u >> 5, c8 = u & 31; *(LAS u32x4*)(vS + t * 264 + c8 * 8) = vv[i]; }
    __syncthreads();
    if (item + step < end) GLA2_TILES(item + step, ngk, nvv, nqv, nkv);
    {
        float la[4][4];
#pragma unroll
        for (int tt = 0; tt < 4; ++tt) {
            const f32x4 x0 = *(const LAS f32x4*)(gk + (tt * 16 + fr) * 16 + 8 * (fq & 1)), x1 = *(const LAS f32x4*)(gk + (tt * 16 + fr) * 16 + 8 * (fq & 1) + 4);
            float xv[8] = {x0[0], x0[1], x0[2], x0[3], x1[0], x1[1], x1[2], x1[3]}, av[8];
#pragma unroll
            for (int jx = 0; jx < 8; ++jx) { const float hi = bf2f(f2bf(xv[jx])); av[jx] = fq < 2 ? hi : xv[jx] - hi; }
            const bf16x8 af = __builtin_bit_cast(bf16x8, pack8(av));
            f32x4 acc = {gbias, gbias, gbias, gbias};
            acc = MFMA16(af, wb1, acc); acc = MFMA16(af, wb2, acc);
#pragma unroll
            for (int jx = 0; jx < 4; ++jx) la[tt][jx] = fast_logsigmoid(acc[jx]) * (1.f / 16.f);
        }
        float base = 0.f;
#pragma unroll
        for (int tt = 0; tt < 4; ++tt) {
            const float c0 = la[tt][0], c1 = c0 + la[tt][1], c2 = c1 + la[tt][2], c3 = c2 + la[tt][3];
            float x = c3; float y = __shfl_up(x, 16); if (fq >= 1) x += y; y = __shfl_up(x, 32); if (fq >= 2) x += y;
            const float ex = base + x - c3;
            LAS float* gp = Gs + (tt * 16 + 4 * fq) * 132 + wave * 16 + fr;
            gp[0] = ex + c0; gp[132] = ex + c1; gp[264] = ex + c2; gp[396] = ex + c3;
            base += __shfl(x, 48 + fr);
        }
        if (fq == 0) { tot[wave * 16 + fr] = base; ((float*)(ws + WS_GDEC))[item * 128 + wave * 16 + fr] = __expf(base); }
    }
    __syncthreads();
    const float scale = 0.08838834764831845f;
#pragma unroll
    for (int i = 0; i < 2; ++i) { const int u = tid + i * NTHREADS, t = u >> 4, d8 = u & 15;
        const f32x4 g0 = *(const LAS f32x4*)(Gs + t * 132 + d8 * 8), g1 = *(const LAS f32x4*)(Gs + t * 132 + d8 * 8 + 4);
        const f32x4 z0 = *(const LAS f32x4*)(tot + d8 * 8), z1 = *(const LAS f32x4*)(tot + d8 * 8 + 4);
        float q[8], k[8], qo[8], ko[8], kdo[8]; unpack8(qv[i], q); unpack8(kv[i], k);
#pragma unroll
        for (int j = 0; j < 8; ++j) { const float Gj = j < 4 ? g0[j] : g1[j - 4], Tj = j < 4 ? z0[j] : z1[j - 4];
            qo[j] = q[j] * scale * __expf(Gj); ko[j] = k[j] * __expf(-Gj); kdo[j] = k[j] * __expf(Tj - Gj); }
        *(u32x4*)(QT + (t0 + t) * 512 + h * 128 + d8 * 8) = pack8(qo);
        *(u32x4*)(KT + (t0 + t) * 512 + h * 128 + d8 * 8) = pack8(ko);
        *(LAS u32x4*)(kd + t * 136 + d8 * 8) = pack8(kdo); }
    __syncthreads();
    bf16_t* gs = GS + (size_t)item * 32768;
#pragma unroll
    for (int et = 0; et < 2; ++et) {
        const int e0 = wave * 32 + et * 16;
        const bf16x8 y0 = ldfrag_tr(vS, 264, 0, e0, lane), y1 = ldfrag_tr(vS, 264, 32, e0, lane);
#pragma unroll
        for (int dt_ = 0; dt_ < 8; ++dt_) {
            f32x4 acc = {0.f, 0.f, 0.f, 0.f};
            acc = MFMA16(ldfrag_tr(kd, 136, 0, dt_ * 16, lane), y0, acc);
            acc = MFMA16(ldfrag_tr(kd, 136, 32, dt_ * 16, lane), y1, acc);
            *(u32x2*)(gs + (e0 + fr) * 128 + dt_ * 16 + 4 * fq) = pack4(acc);
        }
    }
    __syncthreads();
#pragma unroll
    for (int i = 0; i < 2; ++i) { gkv[i] = ngk[i]; qv[i] = nqv[i]; kv[i] = nkv[i]; }
#pragma unroll
    for (int i = 0; i < 4; ++i) vv[i] = nvv[i];
    }
}
#undef GLA2_TILES
__device__ __forceinline__ void scan_phase(const MkArgs& a, int flags) {
    unsigned char* ws = a.ws;
    const int u = blockIdx.x * NTHREADS + threadIdx.x, NU = gridDim.x * NTHREADS;
    if (flags & 1) {
        bf16_t* GS = (bf16_t*)(ws + WS_GS); const float* GDEC = (const float*)(ws + WS_GDEC);
        for (int v = u; v < 16 * 8192; v += NU) {
            const int bh = v >> 13, rem = v & 8191, e = rem >> 5, d0 = (rem & 31) * 4;
            bf16_t* gp = GS + (size_t)bh * 64 * 32768 + e * 128 + d0; const float* dp = GDEC + bh * 64 * 128 + d0;
            f32x4 S = {0.f, 0.f, 0.f, 0.f};
            u32x2 locA[8], locB[8]; f32x4 decA[8], decB[8];
#define SC_LOAD(c0, L, D) do { _Pragma("unroll") for (int i = 0; i < 8; ++i) { L[i] = *(const u32x2*)(gp + (size_t)((c0) + i) * 32768); D[i] = *(const f32x4*)(dp + ((c0) + i) * 128); } } while (0)
#define SC_STEP(c0, L, D) do { _Pragma("unroll") for (int i = 0; i < 8; ++i) { *(u32x2*)(gp + (size_t)((c0) + i) * 32768) = pack4(S); \
                S = S * D[i] + (f32x4){bflo(L[i].x), bfhi(L[i].x), bflo(L[i].y), bfhi(L[i].y)}; } } while (0)
            SC_LOAD(0, locA, decA);
#pragma unroll 1
            for (int c0 = 0; c0 < 64; c0 += 16) {
                SC_LOAD(c0 + 8, locB, decB);
                SC_STEP(c0, locA, decA);
                if (c0 + 16 < 64) SC_LOAD(c0 + 16, locA, decA);
                SC_STEP(c0 + 8, locB, decB);
            }
#undef SC_LOAD
#undef SC_STEP
        }
    }
    if (flags & 2) {
        bf16_t* SS = (bf16_t*)(ws + WS_SS); const float* ACS = (const float*)(ws + WS_ACS);
        for (int v = u; v < 64 * 2048; v += NU) {
            const int bhd = v >> 11, rem = v & 2047, b = bhd >> 4, head = bhd & 15;
            bf16_t* sp = SS + ((size_t)b * 32 * 16 + head) * 8192 + rem * 4; const float* ap = ACS + ((size_t)b * SEQ + 127) * 16 + head;
            f32x4 S = {0.f, 0.f, 0.f, 0.f};
            u32x2 locA[8], locB[8]; float decA[8], decB[8];
#define SC_LOAD(c0, L, D) do { _Pragma("unroll") for (int i = 0; i < 8; ++i) { L[i] = *(const u32x2*)(sp + (size_t)((c0) + i) * 16 * 8192); D[i] = ap[(size_t)((c0) + i) * 128 * 16]; } } while (0)
#define SC_STEP(c0, L, D) do { _Pragma("unroll") for (int i = 0; i < 8; ++i) { *(u32x2*)(sp + (size_t)((c0) + i) * 16 * 8192) = pack4(S); \
                S = S * __expf(D[i]) + (f32x4){bflo(L[i].x), bfhi(L[i].x), bflo(L[i].y), bfhi(L[i].y)}; } } while (0)
            SC_LOAD(0, locA, decA);
#pragma unroll 1
            for (int c0 = 0; c0 < 32; c0 += 16) {
                SC_LOAD(c0 + 8, locB, decB);
                SC_STEP(c0, locA, decA);
                if (c0 + 16 < 32) SC_LOAD(c0 + 16, locA, decA);
                SC_STEP(c0 + 8, locB, decB);
            }
#undef SC_LOAD
#undef SC_STEP
        }
    }
}

#define GLA4_TILES(IT) do { const int c_ = (IT) & 63, bh_ = (IT) >> 6, h_ = bh_ & 3, b_ = bh_ >> 2; const size_t t0_ = (size_t)b_ * SEQ + c_ * 64; \
        _Pragma("unroll") for (int i = 0; i < 4; ++i) { const int u = tid + i * NTHREADS, t = u >> 5, c8 = u & 31; vv[i] = *(const u32x4*)(proj + (t0_ + t) * PJ + PV + h_ * 256 + c8 * 8); } \
        _Pragma("unroll") for (int i = 0; i < 2; ++i) { const int u = tid + i * NTHREADS, t = u >> 4, d8 = u & 15; \
            qv[i] = *(const u32x4*)(QT + (t0_ + t) * 512 + h_ * 128 + d8 * 8); kv[i] = *(const u32x4*)(KT + (t0_ + t) * 512 + h_ * 128 + d8 * 8); } } while (0)
__device__ __forceinline__ void gla_p4_loop(const MkArgs& a, LAS unsigned char* lds, int first, int end, int step, int tid, int wave, int lane) {
    unsigned char* ws = a.ws;
    const bf16_t* proj = (const bf16_t*)(ws + WS_PROJ);
    const bf16_t* QT = (const bf16_t*)(ws + WS_QT); const bf16_t* KT = (const bf16_t*)(ws + WS_KT);
    u32x4 vv[4], qv[2], kv[2];
    if (first < end) GLA4_TILES(first);
    for (int item = first; item < end; item += step) {
    const int c = item & 63, bh = item >> 6, h = bh & 3, b = bh >> 2;
    const size_t t0 = (size_t)b * SEQ + c * 64;
    const bf16_t* gs = (const bf16_t*)(ws + WS_GS) + (size_t)item * 32768;
    bf16_t* mix = (bf16_t*)(ws + WS_HA);
    LAS bf16_t* qs = (LAS bf16_t*)(lds);
    LAS bf16_t* ks = (LAS bf16_t*)(lds + 17408);
    LAS bf16_t* vS = (LAS bf16_t*)(lds + 34816);
    LAS bf16_t* P = (LAS bf16_t*)(lds + 68608);
    LAS float* red = (LAS float*)(lds + 77824);
    const int fr = lane & 15, fq = lane >> 4;
    bf16x8 sx[2][4];
#pragma unroll
    for (int et = 0; et < 2; ++et)
#pragma unroll
        for (int kk = 0; kk < 4; ++kk) sx[et][kk] = *(const bf16x8*)(gs + (wave * 32 + et * 16 + fr) * 128 + kk * 32 + fq * 8);
    u32x2 gg[4][2];
#pragma unroll
    for (int mt = 0; mt < 4; ++mt)
#pragma unroll
        for (int et = 0; et < 2; ++et) gg[mt][et] = *(const u32x2*)(proj + (t0 + mt * 16 + fr) * PJ + PG + h * 256 + wave * 32 + et * 16 + 4 * fq);
#pragma unroll
    for (int i = 0; i < 4; ++i) { const int u = tid + i * NTHREADS, t = u >> 5, c8 = u & 31; *(LAS u32x4*)(vS + t * 264 + c8 * 8) = vv[i]; }
#pragma unroll
    for (int i = 0; i < 2; ++i) { const int u = tid + i * NTHREADS, t = u >> 4, d8 = u & 15; *(LAS u32x4*)(qs + t * 136 + d8 * 8) = qv[i]; *(LAS u32x4*)(ks + t * 136 + d8 * 8) = kv[i]; }
    __syncthreads();
    if (item + step < end) GLA4_TILES(item + step);
    {
        const int it = wave >> 1;
#pragma unroll
        for (int jj_ = 0; jj_ < 2; ++jj_) { const int jt = (wave & 1) * 2 + jj_;
            f32x4 acc = {0.f, 0.f, 0.f, 0.f};
            if (jt <= it) {
#pragma unroll
                for (int kk = 0; kk < 4; ++kk) acc = MFMA16(ldfrag(ks, 136, jt * 16, kk * 32, fr, fq), ldfrag(qs, 136, it * 16, kk * 32, fr, fq), acc);
                if (jt == it) {
#pragma unroll
                    for (int j = 0; j < 4; ++j) if (4 * fq + j > fr) acc[j] = 0.f;
                }
            }
            *(LAS u32x2*)(P + (it * 16 + fr) * 72 + jt * 16 + 4 * fq) = pack4(acc); }
    }
    __syncthreads();
    f32x4 o[4][2];
#pragma unroll
    for (int mt = 0; mt < 4; ++mt)
#pragma unroll
        for (int et = 0; et < 2; ++et) o[mt][et] = (f32x4){0.f, 0.f, 0.f, 0.f};
#pragma unroll
    for (int et = 0; et < 2; ++et) { const int e0 = wave * 32 + et * 16;
#pragma unroll
        for (int kk = 0; kk < 2; ++kk) { const bf16x8 x = ldfrag_tr(vS, 264, kk * 32, e0, lane);
#pragma unroll
            for (int mt = 0; mt < 4; ++mt) if (mt * 16 + 15 >= kk * 32) o[mt][et] = MFMA16(x, ldfrag(P, 72, mt * 16, kk * 32, fr, fq), o[mt][et]); }
#pragma unroll
        for (int kk = 0; kk < 4; ++kk) {
#pragma unroll
            for (int mt = 0; mt < 4; ++mt) o[mt][et] = MFMA16(sx[et][kk], ldfrag(qs, 136, mt * 16, kk * 32, fr, fq), o[mt][et]); }
    }
#pragma unroll
    for (int mt = 0; mt < 4; ++mt) { float s = 0.f;
#pragma unroll
        for (int et = 0; et < 2; ++et)
#pragma unroll
            for (int j = 0; j < 4; ++j) s += o[mt][et][j] * o[mt][et][j];
        s += __shfl_xor(s, 16); s += __shfl_xor(s, 32);
        if (fq == 0) red[wave * 64 + mt * 16 + fr] = s; }
    __syncthreads();
#pragma unroll
    for (int mt = 0; mt < 4; ++mt) { const int i = mt * 16 + fr; float s = 0.f;
#pragma unroll
        for (int w = 0; w < 8; ++w) s += red[w * 64 + i];
        const float r = rsqrtf(s * (1.f / 256.f) + EPS);
#pragma unroll
        for (int et = 0; et < 2; ++et) { const int e = wave * 32 + et * 16 + 4 * fq;
            const u32x2 g = gg[mt][et]; const f32x4 wn = *(const f32x4*)(a.in[5] + e);
            f32x4 v = o[mt][et] * r * wn; v[0] *= fast_silu(bflo(g.x)); v[1] *= fast_silu(bfhi(g.x)); v[2] *= fast_silu(bflo(g.y)); v[3] *= fast_silu(bfhi(g.y));
            if (P5_FP8) *(unsigned*)((unsigned char*)mix + (t0 + i) * DM + h * 256 + e) = pk_fp8x4(v[0] * 16.f, v[1] * 16.f, v[2] * 16.f, v[3] * 16.f);
            else *(u32x2*)(mix + (t0 + i) * DM + h * 256 + e) = pack4(v); } }
    __syncthreads();
    }
}
#undef GLA4_TILES

#define SSD2_RAW(IT) do { const int g_ = (IT) & 3, c_ = ((IT) >> 2) & 31, b_ = (IT) >> 7; const size_t t0_ = (size_t)b_ * SEQ + c_ * 128; \
        const int xch_ = kind == 0 ? g_ * 256 + c8 * 8 : (kind == 1 ? 1024 + g_ * 128 + (c8 - 32) * 8 : 1536 + g_ * 128 + (c8 - 48) * 8); \
        const bf16_t* src_ = proj + (t0_ + tb) * PJ + PX + xch_; \
        _Pragma("unroll") for (int i = 0; i < 19; ++i) { raw[i] = (u32x4){0u, 0u, 0u, 0u}; if (i >= 3 || tb > 0 || c_ > 0) raw[i] = *(const u32x4*)(src_ + ((long)i - 3) * PJ); } } while (0)
__device__ __forceinline__ void ssd_p2_loop(const MkArgs& a, LAS unsigned char* lds, int first, int end, int step, int tid, int wave, int lane) {
    unsigned char* ws = a.ws;
    const bf16_t* proj = (const bf16_t*)(ws + WS_PROJ); const float* small = (const float*)(ws + WS_SMALL);
    const int c8 = lane, kind = c8 < 32 ? 0 : (c8 < 48 ? 1 : 2);
    const int tb = wave * 16;
    u32x4 raw[19];
    if (first < end) SSD2_RAW(first);
    for (int item = first; item < end; item += step) {
    const int g = item & 3, c = (item >> 2) & 31, b = item >> 7;
    const size_t t0 = (size_t)b * SEQ + c * 128;
    bf16_t* XC = (bf16_t*)(ws + WS_XC); bf16_t* BC = (bf16_t*)(ws + WS_BC); bf16_t* CC = (bf16_t*)(ws + WS_CC); bf16_t* SS = (bf16_t*)(ws + WS_SS);
    float* DT = (float*)(ws + WS_DT); float* ACS = (float*)(ws + WS_ACS);
    LAS bf16_t* xsd = (LAS bf16_t*)(lds);
    LAS bf16_t* Bs = (LAS bf16_t*)(lds + 67584);
    LAS float* fac = (LAS float*)(lds + 102400);
    const int xch = kind == 0 ? g * 256 + c8 * 8 : (kind == 1 ? 1024 + g * 128 + (c8 - 32) * 8 : 1536 + g * 128 + (c8 - 48) * 8);
    if (wave < 4) {
        const int head = g * 4 + wave; const float av = -__expf(a.in[9][head]), dtb = a.in[8][head];
        const float d0 = softplusf(small[(t0 + 2 * lane) * 32 + 16 + head] + dtb), d1 = softplusf(small[(t0 + 2 * lane + 1) * 32 + 16 + head] + dtb);
        const float a0 = d0 * av, a1 = d1 * av;
        float v = a0 + a1;
#pragma unroll
        for (int o = 1; o < 64; o <<= 1) { const float u = __shfl_up(v, o); if (lane >= o) v += u; }
        const float ex = v - (a0 + a1), alast = __shfl(v, 63);
        fac[wave * 128 + 2 * lane] = d0 * __expf(alast - (ex + a0)); fac[wave * 128 + 2 * lane + 1] = d1 * __expf(alast - v);
        DT[(t0 + 2 * lane) * 16 + head] = d0; DT[(t0 + 2 * lane + 1) * 16 + head] = d1;
        ACS[(t0 + 2 * lane) * 16 + head] = ex + a0; ACS[(t0 + 2 * lane + 1) * 16 + head] = v;
    }
    float wk[4][8], bs[8];
#pragma unroll
    for (int k = 0; k < 4; ++k) { const f32x4 w0 = *(const f32x4*)(a.in[6] + k * 2048 + xch), w1 = *(const f32x4*)(a.in[6] + k * 2048 + xch + 4);
#pragma unroll
        for (int j = 0; j < 4; ++j) { wk[k][j] = w0[j]; wk[k][4 + j] = w1[j]; } }
    { const f32x4 b0 = *(const f32x4*)(a.in[7] + xch), b1 = *(const f32x4*)(a.in[7] + xch + 4);
#pragma unroll
      for (int j = 0; j < 4; ++j) { bs[j] = b0[j]; bs[4 + j] = b1[j]; } }
    __syncthreads();
    {
        bf16_t* gdst = kind == 0 ? XC + (t0 + tb) * 1024 + g * 256 + c8 * 8 : (kind == 1 ? BC + (t0 + tb) * 512 + g * 128 + (c8 - 32) * 8 : CC + (t0 + tb) * 512 + g * 128 + (c8 - 48) * 8);
        const size_t gld = kind == 0 ? 1024 : 512;
        float u0[8], u1[8], u2[8], u3[8];
        unpack8(raw[0], u0); unpack8(raw[1], u1); unpack8(raw[2], u2);
#pragma unroll
        for (int i = 0; i < 16; ++i) {
            unpack8(raw[i + 3], u3);
            float o[8];
#pragma unroll
            for (int j = 0; j < 8; ++j) o[j] = fast_silu(bs[j] + wk[0][j] * u0[j] + wk[1][j] * u1[j] + wk[2][j] * u2[j] + wk[3][j] * u3[j]);
            *(u32x4*)(gdst + (size_t)i * gld) = pack8(o);
            if (kind == 0) { const float f = fac[(c8 >> 3) * 128 + tb + i];
#pragma unroll
                for (int j = 0; j < 8; ++j) o[j] *= f;
                *(LAS u32x4*)(xsd + (tb + i) * 264 + c8 * 8) = pack8(o); }
            else if (kind == 1) *(LAS u32x4*)(Bs + (tb + i) * 136 + (c8 - 32) * 8) = pack8(o);
#pragma unroll
            for (int j = 0; j < 8; ++j) { u0[j] = u1[j]; u1[j] = u2[j]; u2[j] = u3[j]; }
        }
    }
    __syncthreads();
    { const int nit = item + step < end ? item + step : item; SSD2_RAW(nit); }
    {
        const int fr = lane & 15, fq = lane >> 4, r = wave >> 1;
        bf16_t* ss = SS + (((size_t)b * 32 + c) * 16 + g * 4 + r) * 8192;
#pragma unroll
        for (int pi = 0; pi < 2; ++pi) { const int pt = (wave & 1) * 2 + pi;
            bf16x8 y[4];
#pragma unroll
            for (int kk = 0; kk < 4; ++kk) y[kk] = ldfrag_tr(xsd, 264, kk * 32, r * 64 + pt * 16, lane);
#pragma unroll
            for (int nt = 0; nt < 8; ++nt) { f32x4 acc = {0.f, 0.f, 0.f, 0.f};
#pragma unroll
                for (int kk = 0; kk < 4; ++kk) acc = MFMA16(ldfrag_tr(Bs, 136, kk * 32, nt * 16, lane), y[kk], acc);
                *(u32x2*)(ss + (pt * 16 + fr) * 128 + nt * 16 + 4 * fq) = pack4(acc); } }
    }
    __syncthreads();
    }
}
#undef SSD2_RAW

#define SSD4_CB(IT) do { const int g_ = (IT) & 3, c_ = ((IT) >> 2) & 31, b_ = (IT) >> 7; const size_t t0_ = (size_t)b_ * SEQ + c_ * 128; \
        acr = ACS[(t0_ + (tid & 127)) * 16 + g_ * 4 + (tid >> 7)]; \
        _Pragma("unroll") for (int i = 0; i < 4; ++i) { const int u = tid + i * NTHREADS, r = u >> 4, cq = u & 15; \
            ct[i] = *(const u32x4*)(CC + (t0_ + r) * 512 + g_ * 128 + cq * 8); bt[i] = *(const u32x4*)(BC + (t0_ + r) * 512 + g_ * 128 + cq * 8); } } while (0)
__device__ __forceinline__ void ssd_p4_loop(const MkArgs& a, LAS unsigned char* lds, int first, int end, int step, int tid, int wave, int lane) {
    unsigned char* ws = a.ws;
    const bf16_t* proj = (const bf16_t*)(ws + WS_PROJ);
    const bf16_t* XC = (const bf16_t*)(ws + WS_XC); const bf16_t* BC = (const bf16_t*)(ws + WS_BC); const bf16_t* CC = (const bf16_t*)(ws + WS_CC); const bf16_t* SS = (const bf16_t*)(ws + WS_SS);
    const float* DT = (const float*)(ws + WS_DT); const float* ACS = (const float*)(ws + WS_ACS);
    u32x4 ct[4], bt[4]; float acr = 0.f;
    if (tid < 256) ((LAS f32x4*)(lds + 141312))[tid] = ((const f32x4*)a.in[11])[tid];
    if (first < end) SSD4_CB(first);
    for (int item = first; item < end; item += step) {
    const int g = item & 3, c = (item >> 2) & 31, b = item >> 7;
    const size_t t0 = (size_t)b * SEQ + c * 128;
    bf16_t* mix = (bf16_t*)(ws + WS_HA);
    LAS bf16_t* Cs = (LAS bf16_t*)(lds);
    LAS bf16_t* Bs = (LAS bf16_t*)(lds + 34816);
    LAS bf16_t* xs = (LAS bf16_t*)(lds + 69632);
    LAS bf16_t* Ss = (LAS bf16_t*)(lds + 104448);
    LAS float* acs = (LAS float*)(lds + 139264);
    const int fr = lane & 15, fq = lane >> 4, w = wave;
    acs[tid] = acr;
#pragma unroll
    for (int i = 0; i < 4; ++i) { const int u = tid + i * NTHREADS, r = u >> 4, cq = u & 15; *(LAS u32x4*)(Cs + r * 136 + cq * 8) = ct[i]; *(LAS u32x4*)(Bs + r * 136 + cq * 8) = bt[i]; }
    u32x4 xr[4], sr[4]; float dtr[4];
#define SSD4_LOAD(hp) do { _Pragma("unroll") for (int i = 0; i < 4; ++i) { const int u = tid + i * NTHREADS, t = u >> 4, cq = u & 15; \
        xr[i] = *(const u32x4*)(XC + (t0 + t) * 1024 + g * 256 + (hp) * 128 + cq * 8); dtr[i] = DT[(t0 + t) * 16 + g * 4 + (hp) * 2 + (cq >> 3)]; \
        sr[i] = *(const u32x4*)(SS + (((size_t)b * 32 + c) * 16 + g * 4 + (hp) * 2) * 8192 + (size_t)t * 128 + cq * 8); } } while (0)
#define SSD4_STORE() do { _Pragma("unroll") for (int i = 0; i < 4; ++i) { const int u = tid + i * NTHREADS, t = u >> 4, cq = u & 15; float f[8]; unpack8(xr[i], f); \
        _Pragma("unroll") for (int j = 0; j < 8; ++j) f[j] *= dtr[i]; *(LAS u32x4*)(xs + t * 136 + cq * 8) = pack8(f); *(LAS u32x4*)(Ss + t * 136 + cq * 8) = sr[i]; } } while (0)
    SSD4_LOAD(0);
    __syncthreads();
    bf16x8 cf[4];
#pragma unroll
    for (int kk = 0; kk < 4; ++kk) cf[kk] = ldfrag(Cs, 136, w * 16, kk * 32, fr, fq);
    f32x4 cb[8];
#pragma unroll
    for (int st = 0; st < 8; ++st) { cb[st] = (f32x4){0.f, 0.f, 0.f, 0.f};
        if (st <= w) {
#pragma unroll
            for (int kk = 0; kk < 4; ++kk) cb[st] = MFMA16(ldfrag(Bs, 136, st * 16, kk * 32, fr, fq), cf[kk], cb[st]); } }
    SSD4_STORE();
    __syncthreads();
    const int l = w * 16 + fr;
    float ssq = 0.f;
    bf16_t* mrow = mix + (t0 + l) * DM + 1024 + g * 256 + 4 * fq;
    u32x2 yk[4][4];
#pragma unroll 1
    for (int hp = 0; hp < 2; ++hp) {
        if (hp == 0) SSD4_LOAD(1);
#pragma unroll 1
        for (int r2 = 0; r2 < 2; ++r2) {
            const int r = hp * 2 + r2;
            const float al = acs[r * 128 + l];
#pragma unroll
            for (int st = 0; st < 8; ++st) if (st <= (w | 1)) { f32x4 mv;
#pragma unroll
                for (int j = 0; j < 4; ++j) { const int s = st * 16 + 4 * fq + j; mv[j] = (s <= l) ? cb[st][j] * __expf(al - acs[r * 128 + s]) : 0.f; }
                *(LAS u32x2*)(Bs + l * 136 + st * 16 + 4 * fq) = pack4(mv); }
            LDS_WAIT();
            const float eal = __expf(al), dsk = a.in[10][g * 4 + r];
            const bf16_t* xcp = XC + (t0 + l) * 1024 + g * 256 + r * 64 + 4 * fq; const bf16_t* zp = proj + (t0 + l) * PJ + PZ + g * 256 + r * 64 + 4 * fq;
            u32x2 xv[4], zv[4];
#pragma unroll
            for (int pt = 0; pt < 4; ++pt) { xv[pt] = *(const u32x2*)(xcp + pt * 16); zv[pt] = *(const u32x2*)(zp + pt * 16); }
#pragma unroll
            for (int pt = 0; pt < 4; ++pt) {
                f32x4 ad = {0.f, 0.f, 0.f, 0.f}, ao = {0.f, 0.f, 0.f, 0.f};
#pragma unroll
                for (int kk = 0; kk < 4; ++kk) if (kk <= (w >> 1)) ad = MFMA16(ldfrag_tr(xs, 136, kk * 32, r2 * 64 + pt * 16, lane), ldfrag(Bs, 136, w * 16, kk * 32, fr, fq), ad);
#pragma unroll
                for (int kk = 0; kk < 4; ++kk) ao = MFMA16(ldfrag(Ss, 136, r2 * 64 + pt * 16, kk * 32, fr, fq), cf[kk], ao);
                f32x4 y = ad + ao * eal;
                y[0] = (y[0] + dsk * bflo(xv[pt].x)) * fast_silu(bflo(zv[pt].x)); y[1] = (y[1] + dsk * bfhi(xv[pt].x)) * fast_silu(bfhi(zv[pt].x));
                y[2] = (y[2] + dsk * bflo(xv[pt].y)) * fast_silu(bflo(zv[pt].y)); y[3] = (y[3] + dsk * bfhi(xv[pt].y)) * fast_silu(bfhi(zv[pt].y));
                ssq += (y[0] * y[0] + y[1] * y[1]) + (y[2] * y[2] + y[3] * y[3]);
                { const u32x2 yp = pack4(y); if (r == 0) yk[0][pt] = yp; else if (r == 1) yk[1][pt] = yp; else if (r == 2) yk[2][pt] = yp; else yk[3][pt] = yp; }
            }
            LDS_WAIT();
        }
        if (hp == 0) { __syncthreads(); SSD4_STORE(); __syncthreads(); }
    }
#undef SSD4_LOAD
#undef SSD4_STORE
    { const int nit = item + step < end ? item + step : item; SSD4_CB(nit); }
    ssq += __shfl_xor(ssq, 16); ssq += __shfl_xor(ssq, 32);
    const float rs = rsqrtf(ssq * (1.f / 256.f) + EPS);
#pragma unroll
    for (int q = 0; q < 16; ++q) { const f32x4 wn = *(const LAS f32x4*)(lds + 141312 + (g * 256 + q * 16 + 4 * fq) * 4);
        const u32x2 v = yk[q >> 2][q & 3]; const f32x4 mv = (f32x4){bflo(v.x), bfhi(v.x), bflo(v.y), bfhi(v.y)} * rs * wn;
        if (P5_FP8) *(unsigned*)((unsigned char*)mix + (t0 + l) * DM + 1024 + g * 256 + 4 * fq + q * 16) = pk_fp8x4(mv[0] * 16.f, mv[1] * 16.f, mv[2] * 16.f, mv[3] * 16.f);
        else *(u32x2*)(mrow + q * 16) = pack4(mv);
        if ((q & 3) == 3) __builtin_amdgcn_sched_barrier(0); }
    __syncthreads();
    }
}
#undef SSD4_CB

__device__ __forceinline__ void phase2(const MkArgs& a, LAS unsigned char* lds, int tid, int wave, int lane) {
    STAMP(44);
    if (a.flags & 2) ssd_p2_loop(a, lds, blockIdx.x, 512, gridDim.x, tid, wave, lane);
    STAMP(45);
    if (a.flags & 1) gla_p2_loop(a, lds, blockIdx.x, 1024, gridDim.x, tid, wave, lane);
    STAMP(46);
}
__device__ __forceinline__ void phase4(const MkArgs& a, LAS unsigned char* lds, int tid, int wave, int lane) {
    STAMP(40);
#ifndef NO_SSD4
    if (a.flags & 2) ssd_p4_loop(a, lds, blockIdx.x, 512, gridDim.x, tid, wave, lane);
#endif
    STAMP(41);
#ifndef NO_GLA4
    if (a.flags & 1) gla_p4_loop(a, lds, blockIdx.x, 1024, gridDim.x, tid, wave, lane);
#endif
    STAMP(42);
}
__global__ void __launch_bounds__(NTHREADS, 2) mk_fwd(MkArgs a) {
    extern __shared__ __attribute__((aligned(16))) unsigned char lds_raw[];
    LAS unsigned char* lds = (LAS unsigned char*)lds_raw;
    const int tid = threadIdx.x, wave = __builtin_amdgcn_readfirstlane(tid >> 6);
    const int lo = a.ph_lo, hi = a.ph_hi;
    volatile LAS unsigned* bst = (volatile LAS unsigned*)(lds + LDS_BYTES - 64);
    if (tid < 16) bst[tid] = 0u;
    __syncthreads();
    XcdBarrier bar = xcd_barrier_post((unsigned*)(a.ws + WS_BAR) + a.li * XCD_BAR_WORDS, bst);
#ifndef ONLY_PHASE
#define ONLY_PHASE -1
#endif
#ifndef STAG_MASK
#define STAG_MASK 8
#endif
#define STAMPB(i) do { if (TSEL >= 100 && blockIdx.x == 8 && pg8::lane_now() == 0) ((unsigned long long*)(a.ws + WS_CTL + 24576))[i] = __builtin_amdgcn_s_memrealtime(); } while (0)
#define IN(k) ((ONLY_PHASE < 0 || ONLY_PHASE == (k)) && lo <= (k) && (k) < hi)
#ifndef TSCALE
#define TSCALE (0.01f / 4.f)
#endif
    unsigned long long tprev = 0, tsel0 = 0, tsel1 = 0;
    if (TSEL >= 0) tprev = __builtin_amdgcn_s_memrealtime();
    if (TSEL == 0) tsel0 = tprev;
#define SEAM(k) do { if (IN(k) && IN((k) + 1)) { xcd_barrier(bar); if (TSEL >= 0) { const unsigned long long tn = __builtin_amdgcn_s_memrealtime(); if (TSEL == (k) || (TSEL == 10 && (k) == 6) || (TSEL == 78 && (k) == 8)) tsel1 = tn; if (TSEL == 78 && (k) == 6) tsel0 = tn; if (TSEL == (k) + 1 || (TSEL == 11 && (k) == 5)) tsel0 = tn; } } } while (0)
    if (a.flags & 65536) { for (int i = 0; i < 10; ++i) xcd_barrier(bar); }
    if (IN(0)) { phase0(a, lds, wave, pg8::lane_now()); if (a.flags & 8) phase0(a, lds, wave, pg8::lane_now()); }
    SEAM(0);
#if CONV_IN_P1
    if (IN(1)) { if (blockIdx.x & 8) { phase6b(a, lds, wave, pg8::lane_now()); __syncthreads(); phase1(a, lds, wave, pg8::lane_now()); } else { phase1(a, lds, wave, pg8::lane_now()); __syncthreads(); phase6b(a, lds, wave, pg8::lane_now()); } }
#else
    if (IN(1)) { phase1(a, lds, wave, pg8::lane_now()); if (a.flags & 32768) phase1(a, lds, wave, pg8::lane_now()); }
#endif
    SEAM(1);
    if (IN(2)) { phase2(a, lds, wave * 64 + pg8::lane_now(), wave, pg8::lane_now()); if (a.flags & 16) phase2(a, lds, wave * 64 + pg8::lane_now(), wave, pg8::lane_now()); }
    SEAM(2);
    if (IN(3)) { scan_phase(a, a.flags); }
    SEAM(3);
    if (IN(4)) { phase4(a, lds, wave * 64 + pg8::lane_now(), wave, pg8::lane_now()); if (a.flags & 32) phase4(a, lds, wave * 64 + pg8::lane_now(), wave, pg8::lane_now()); }
    SEAM(4);
#if CONV_IN_P1
    if (IN(5)) { phase5(a, lds, a.out, wave); }
#elif P5_STAGGER == 3
    if (IN(5)) { const int grp = (blockIdx.x >> 3) % 3;
        if (grp == 0) { phase6b(a, lds, wave, pg8::lane_now()); __syncthreads(); phase5(a, lds, a.out, wave); }
        else if (grp == 1) { phase5(a, lds, a.out, wave, 0, 1); __syncthreads(); phase6b(a, lds, wave, pg8::lane_now()); __syncthreads(); phase5(a, lds, a.out, wave, 1, 1); }
        else { phase5(a, lds, a.out, wave); __syncthreads(); phase6b(a, lds, wave, pg8::lane_now()); } }
#elif P5_STAGGER
    if (IN(5)) { if (blockIdx.x & STAG_MASK) { STAMPB(24); phase6b(a, lds, wave, pg8::lane_now(), 0, GU_SPLIT); __syncthreads(); STAMPB(25); phase5(a, lds, a.out, wave); STAMPB(26); } else { STAMP(20); phase5(a, lds, a.out, wave); STAMP(21); phase6b(a, lds, wave, pg8::lane_now(), 0, GU_SPLIT); STAMP(22); } }
#else
    if (IN(5)) { phase5(a, lds, a.out, wave); }
#endif
    SEAM(5);
#if P5_STAGGER || CONV_IN_P1
    if (IN(6)) { phase6(a, lds, a.out, wave, pg8::lane_now()); if (GU_SPLIT < 32768) { __syncthreads(); phase6b(a, lds, wave, pg8::lane_now(), GU_SPLIT, 32768, false); } }
#else
    if (IN(6)) { phase6(a, lds, a.out, wave, pg8::lane_now()); phase6b(a, lds, wave, pg8::lane_now()); }
#endif
    SEAM(6);
    if (IN(7)) { if (MOE_MERGED) phase78(a, lds, []() {}, [&]() { xcd_barrier(bar); }, wave, pg8::lane_now()); else phase78(a, lds, [&]() { wdt_queue(a, lds, wave, pg8::lane_now()); xcd_barrier(bar); }, [&]() { xcd_barrier(bar); }, wave, pg8::lane_now()); }
    SEAM(8);
    if (IN(9)) { phase9(a, wave, pg8::lane_now()); }
    if (TSEL >= 0) { if (TSEL == 9) tsel1 = __builtin_amdgcn_s_memrealtime(); __syncthreads(); VM_WAIT(); if (TSEL >= 100) { const unsigned long long* st = (const unsigned long long*)(a.ws + WS_CTL + 24576); tsel0 = st[TSEL - 100]; tsel1 = st[TSEL - 99]; }
        if (blockIdx.x == 0 && wave == 0 && pg8::lane_now() == 0) a.out[0] += (float)(tsel1 - tsel0) * TSCALE; }
#ifdef KLOOP_PROBE
    __syncthreads(); if (blockIdx.x == 0 && wave == 0 && pg8::lane_now() == 0) a.out[0] += (float)g_dbg[KLOOP_PROBE] * 0.01f;
#endif
#undef IN
#undef SEAM
}

typedef short s16x4 __attribute__((ext_vector_type(4)));
__global__ void n_trtest(unsigned* flag) {
    __shared__ unsigned short T[32 * 72];
    for (int i = threadIdx.x; i < 32 * 72; i += 64) { const int r = i / 72, c = i % 72; T[i] = (unsigned short)(r * 16 + (c & 15) + 1000 * (c >> 4)); }
    __syncthreads();
    const int lane = threadIdx.x, idx = lane & 15, q = idx >> 2, p = idx & 3, fq = lane >> 4;
    const s16x4 v = __builtin_amdgcn_ds_read_tr16_b64_v4i16((__attribute__((address_space(3))) s16x4*)(T + (8 * fq + q) * 72 + 4 * p));
    bool bad = false;
    for (int j = 0; j < 4; ++j) if ((unsigned short)v[j] != (unsigned short)((8 * fq + j) * 16 + idx)) bad = true;
    if (bad) atomicOr(flag, 1u);
}
__global__ void n_poison(float* out, const unsigned* flag) { if (threadIdx.x == 0 && flag[0] != 0u) out[0] += 1000.f; }
#ifndef PROBE_FLAGS
#define PROBE_FLAGS 0
#endif
static int g_grid = 0;
static void launch_mk(MkArgs a, int lo, int hi, int li, hipStream_t stream) {
    if (g_grid == 0) {
        int dev = 0, cus = 0, per_cu = 0;
        hipGetDevice(&dev);
        hipDeviceGetAttribute(&cus, hipDeviceAttributeMultiprocessorCount, dev);
        hipFuncSetAttribute((const void*)mk_fwd, hipFuncAttributeMaxDynamicSharedMemorySize, LDS_BYTES);
        hipOccupancyMaxActiveBlocksPerMultiprocessor(&per_cu, (const void*)mk_fwd, NTHREADS, LDS_BYTES);
        if (per_cu < 1) { fprintf(stderr, "kernel_launch: occupancy query says %d blocks/CU\n", per_cu); per_cu = 1; }
        g_grid = cus * per_cu;
        fprintf(stderr, "kernel_launch: grid %d (%d CUs x %d)\n", g_grid, cus, per_cu);
    }
    a.ph_lo = lo; a.ph_hi = hi; a.li = li;
    void* args[] = {&a};
#ifdef PLAIN_LAUNCH
    (void)args; hipLaunchKernelGGL(mk_fwd, dim3(g_grid), dim3(NTHREADS), LDS_BYTES, stream, a); hipError_t e = hipPeekAtLastError();
#else
    hipError_t e = hipLaunchCooperativeKernel((const void*)mk_fwd, dim3(g_grid), dim3(NTHREADS), args, LDS_BYTES, stream);
#endif
    if (e != hipSuccess) fprintf(stderr, "cooperative launch failed: %s (grid %d)\n", hipGetErrorString(e), g_grid);
}

extern "C" void kernel_launch(void* const* d_in, const int* in_sizes, int n_in, void* d_out, int out_size, void* d_ws, size_t ws_size, hipStream_t stream) {
    if (n_in != 22 || out_size != T_TOK * DM || ws_size < WS_END) { fprintf(stderr, "kernel_launch: unexpected shapes (n_in %d, out %d, ws %zu < %zu); nothing launched\n", n_in, out_size, ws_size, (size_t)WS_END); return; }
    MkArgs a{};
    for (int i = 0; i < 22; ++i) a.in[i] = (const float*)d_in[i];
    a.out = (float*)d_out; a.ws = (unsigned char*)d_ws;
    (void)hipMemsetAsync((char*)d_ws + WS_CTL, 0, 262144, stream);
    a.flags = 3 | PROBE_FLAGS;
    launch_mk(a, 0, 10, 0, stream);
#ifdef TRTEST
    n_trtest<<<1, 64, 0, stream>>>((unsigned*)((char*)d_ws + WS_CTL + 20480));
    n_poison<<<1, 64, 0, stream>>>((float*)d_out, (const unsigned*)((char*)d_ws + WS_CTL + 20480));
#endif
}
```
